# Optimizing an MI355X kernel written in HIP

```python
import math
import jax, jax.numpy as jnp
from jax import lax
import numpy as np

D_MODEL = 1024
BATCH = 2
SEQ = 8192
DEPTH = 2

MIX_WIDTH = D_MODEL
MLA_WIDTH = D_MODEL // 2
SGU_WIDTH = D_MODEL // 4
POOL_WIDTH = D_MODEL // 4

MLA_HEADS = 4
V_HEAD = MLA_WIDTH // MLA_HEADS
QK_NOPE = 64
QK_ROPE = 32
QK_HEAD = QK_NOPE + QK_ROPE
Q_LORA = D_MODEL // 4
KV_LORA = D_MODEL // 8
ROPE_THETA = 10000.0
Q_BLOCK = 128

SGU_HEADS = 4
SGU_HEAD_DIM = SGU_WIDTH // SGU_HEADS
CHUNK = 128

POOL_WINDOWS = (2, 4, 8, 16)
POOL_GROUPS = len(POOL_WINDOWS)
POOL_GROUP_DIM = POOL_WIDTH // POOL_GROUPS

IN_WIDTH = Q_LORA + KV_LORA + QK_ROPE + 2 * SGU_WIDTH + POOL_WIDTH
FFN_HIDDEN = -(-8 * D_MODEL // (3 * 256)) * 256
EPS = 1e-6

kernel_name = "hybrid_mla_sgu_pool_block"


def rms_norm(x, g):
    xf = x.astype(jnp.float32)
    y = xf * lax.rsqrt(jnp.mean(xf * xf, axis=-1, keepdims=True) + EPS)
    return (y * g.astype(jnp.float32)).astype(x.dtype)


def apply_rope(x, positions):
    half = x.shape[-1] // 2
    inv_freq = 1.0 / (ROPE_THETA ** (jnp.arange(half, dtype=jnp.float32) / half))
    ang = positions.astype(jnp.float32)[:, :, None, None] * inv_freq
    cos, sin = jnp.cos(ang), jnp.sin(ang)
    xf = x.astype(jnp.float32)
    x1, x2 = xf[..., :half], xf[..., half:]
    return jnp.concatenate([x1 * cos - x2 * sin, x2 * cos + x1 * sin], axis=-1).astype(x.dtype)


def mla_mixer(q_lat, kv_lat, k_rope, positions, g_q_lat, w_q_up, g_kv_lat, w_kv_up, g_q_head, g_k_head):
    B, S, _ = q_lat.shape
    q = (rms_norm(q_lat, g_q_lat) @ w_q_up).reshape(B, S, MLA_HEADS, QK_HEAD)
    kv = (rms_norm(kv_lat, g_kv_lat) @ w_kv_up).reshape(B, S, MLA_HEADS, QK_NOPE + V_HEAD)
    k_nope, v = kv[..., :QK_NOPE], kv[..., QK_NOPE:]
    k_pe = jnp.broadcast_to(k_rope[:, :, None, :], (B, S, MLA_HEADS, QK_ROPE))
    k = jnp.concatenate([k_nope, k_pe], axis=-1)
    q = rms_norm(q, g_q_head)
    k = rms_norm(k, g_k_head)
    q = jnp.concatenate([q[..., :QK_NOPE], apply_rope(q[..., QK_NOPE:], positions)], axis=-1)
    k = jnp.concatenate([k[..., :QK_NOPE], apply_rope(k[..., QK_NOPE:], positions)], axis=-1)

    n_blocks = S // Q_BLOCK
    scale = 1.0 / math.sqrt(QK_HEAD)
    qb = q.reshape(B, n_blocks, Q_BLOCK, MLA_HEADS, QK_HEAD).transpose(1, 0, 2, 3, 4)
    kpos = jnp.arange(S)

    def attend_block(args):
        qi, bi = args
        s = jnp.einsum('bqhd,bkhd->bhqk', qi, k).astype(jnp.float32) * scale
        qpos = bi * Q_BLOCK + jnp.arange(Q_BLOCK)
        causal = kpos[None, :] <= qpos[:, None]
        s = jnp.where(causal[None, None], s, jnp.finfo(jnp.float32).min)
        p = jax.nn.softmax(s, axis=-1)
        return jnp.einsum('bhqk,bkhd->bqhd', p.astype(v.dtype), v)

    o = lax.map(attend_block, (qb, jnp.arange(n_blocks)))
    return o.transpose(1, 0, 2, 3, 4).reshape(B, S, MLA_WIDTH)


def sgu_mixer(uv, g_v, w_spatial, b_spatial):
    B, S, _ = uv.shape
    u, v = uv[..., :SGU_WIDTH], uv[..., SGU_WIDTH:]
    v = rms_norm(v, g_v)
    vc = v.reshape(B, S // CHUNK, CHUNK, SGU_HEADS, SGU_HEAD_DIM)
    w = w_spatial * jnp.tril(jnp.ones((CHUNK, CHUNK), dtype=w_spatial.dtype))
    zc = jnp.einsum('hts,bcshd->bcthd', w, vc) + b_spatial.T[None, None, :, :, None]
    return u * zc.reshape(B, S, SGU_WIDTH)


def pool_mixer(p, w_pool, pool_scale):
    B, S, _ = p.shape
    pf = p.astype(jnp.float32).reshape(B, S, POOL_GROUPS, POOL_GROUP_DIM)
    t1 = jnp.arange(1, S + 1, dtype=jnp.float32)
    outs = []
    for g, win in enumerate(POOL_WINDOWS):
        xg = pf[:, :, g]
        cs = jnp.cumsum(xg, axis=1)
        cs_shift = jnp.pad(cs, ((0, 0), (win, 0), (0, 0)))[:, :S]
        count = jnp.minimum(t1, float(win))[None, :, None]
        outs.append((cs - cs_shift) / count - xg)
    m = jnp.stack(outs, axis=2).astype(p.dtype)
    y = jnp.einsum('bsgc,gcd->bsgd', m, w_pool).reshape(B, S, POOL_WIDTH)
    return y * pool_scale


def setup_inputs(seed: int = 0) -> dict:
    key = jax.random.key(seed)
    ks = jax.random.split(key, 24)
    f32 = jnp.float32

    def dense(k, shape, fan_in):
        return jax.random.normal(k, shape, f32) * fan_in ** -0.5

    def gain(k, shape):
        return 1.0 + 0.01 * jax.random.normal(k, shape, f32)

    x = jax.random.normal(ks[0], (BATCH, SEQ, D_MODEL), f32)
    start = jax.random.randint(ks[1], (BATCH, 1), 0, 4096, dtype=jnp.int32)
    positions = start + jnp.arange(SEQ, dtype=jnp.int32)[None, :]
    return {
        "x": x,
        "positions": positions,
        "g_mix_norm": gain(ks[2], (DEPTH, D_MODEL)),
        "w_in": dense(ks[3], (DEPTH, D_MODEL, IN_WIDTH), D_MODEL),
        "g_q_lat": gain(ks[4], (DEPTH, Q_LORA)),
        "w_q_up": dense(ks[5], (DEPTH, Q_LORA, MLA_HEADS * QK_HEAD), Q_LORA),
        "g_kv_lat": gain(ks[6], (DEPTH, KV_LORA)),
        "w_kv_up": dense(ks[7], (DEPTH, KV_LORA, MLA_HEADS * (QK_NOPE + V_HEAD)), KV_LORA),
        "g_q_head": gain(ks[8], (DEPTH, QK_HEAD)),
        "g_k_head": gain(ks[9], (DEPTH, QK_HEAD)),
        "g_sgu_v": gain(ks[10], (DEPTH, SGU_WIDTH)),
        "w_spatial": dense(ks[11], (DEPTH, SGU_HEADS, CHUNK, CHUNK), CHUNK),
        "b_spatial": 1.0 + 0.01 * jax.random.normal(ks[12], (DEPTH, SGU_HEADS, CHUNK), f32),
        "w_pool": dense(ks[13], (DEPTH, POOL_GROUPS, POOL_GROUP_DIM, POOL_GROUP_DIM), POOL_GROUP_DIM),
        "pool_scale": 1.0 + 0.1 * jax.random.normal(ks[14], (DEPTH, POOL_WIDTH), f32),
        "g_out_mla": gain(ks[15], (DEPTH, MLA_WIDTH)),
        "g_out_sgu": gain(ks[16], (DEPTH, SGU_WIDTH)),
        "g_out_pool": gain(ks[17], (DEPTH, POOL_WIDTH)),
        "w_out": dense(ks[18], (DEPTH, MIX_WIDTH, D_MODEL), MIX_WIDTH),
        "g_ffn_norm": gain(ks[19], (DEPTH, D_MODEL)),
        "w_gate": dense(ks[20], (DEPTH, D_MODEL, FFN_HIDDEN), D_MODEL),
        "w_up": dense(ks[21], (DEPTH, D_MODEL, FFN_HIDDEN), D_MODEL),
        "w_down": dense(ks[22], (DEPTH, FFN_HIDDEN, D_MODEL), FFN_HIDDEN),
    }


def reference(x, positions, g_mix_norm, w_in, g_q_lat, w_q_up, g_kv_lat, w_kv_up, g_q_head, g_k_head,
              g_sgu_v, w_spatial, b_spatial, w_pool, pool_scale, g_out_mla, g_out_sgu, g_out_pool,
              w_out, g_ffn_norm, w_gate, w_up, w_down):
    o1 = Q_LORA
    o2 = o1 + KV_LORA
    o3 = o2 + QK_ROPE
    o4 = o3 + 2 * SGU_WIDTH
    for l in range(DEPTH):
        h = rms_norm(x, g_mix_norm[l])
        z = h @ w_in[l]
        q_lat, kv_lat, k_rope = z[..., :o1], z[..., o1:o2], z[..., o2:o3]
        uv, pin = z[..., o3:o4], z[..., o4:]
        a = mla_mixer(q_lat, kv_lat, k_rope, positions, g_q_lat[l], w_q_up[l], g_kv_lat[l],
                      w_kv_up[l], g_q_head[l], g_k_head[l])
        gm = sgu_mixer(uv, g_sgu_v[l], w_spatial[l], b_spatial[l])
        po = pool_mixer(pin, w_pool[l], pool_scale[l])
        mix = jnp.concatenate([rms_norm(a, g_out_mla[l]), rms_norm(gm, g_out_sgu[l]),
                               rms_norm(po, g_out_pool[l])], axis=-1)
        x = x + mix @ w_out[l]
        h = rms_norm(x, g_ffn_norm[l])
        x = x + (jax.nn.silu(h @ w_gate[l]) * (h @ w_up[l])) @ w_down[l]
    return x
```

```cpp
#include <hip/hip_runtime.h>
#include <hip/hip_bf16.h>
#include <cstdio>
#include <cstdint>

namespace pg8 {
#define PG8_LAS __attribute__((address_space(3)))
typedef unsigned short bf16_t;
typedef short bf16x8 __attribute__((ext_vector_type(8)));
typedef float f32x4 __attribute__((ext_vector_type(4)));
typedef unsigned u32x4 __attribute__((ext_vector_type(4)));
constexpr int BM = 256, BK = 64, HALF = 128, HTB = HALF * BK * 2  , STAGE_BYTES = 8 * HTB, NXCD = 8, WGM = 8;

__host__ __device__ __forceinline__ int lds_byte(int r, int c) { const int st = (r >> 4) * 2 + (c >> 5), rr = r & 15, cc = c & 31, ob = rr * 64 + cc * 2; return st * 1024 + (ob ^ (((ob >> 9) & 1) << 5)); }
__host__ __device__ __forceinline__ void stage_rc(int b, int& R, int& C) { const int st = b / 1024, sb = b % 1024, swz = sb ^ (((sb >> 9) & 1) << 5); R = (st >> 1) * 16 + swz / 64; C = (st & 1) * 32 + (swz % 64) / 2; }
__host__ __device__ __forceinline__ int perm32(int rho) { const int n = rho >> 4, i = rho & 15; return 8 * (i >> 2) + 4 * n + (i & 3); }

struct Unit { int pm, pn; };
struct Gemm { const bf16_t* A; const bf16_t* Bt; int M, N, K; };

struct StaticOrder {
    int nM, nN, nwg, G, c;
    __host__ __device__ void init(int M, int N, int G_, int c_) { nM = M / BM; nN = N / BM; nwg = nM * nN; G = G_; c = c_; }
    __host__ __device__ bool next(int i, Unit& u) const {
        const long L = (long)i * G + c; if (L >= nwg) return false;
        int wgid = (int)L; { const int q = nwg / NXCD, r = nwg % NXCD, xcd = wgid % NXCD, off = wgid / NXCD; wgid = (xcd < r ? xcd * (q + 1) : r * (q + 1) + (xcd - r) * q) + off; }
        const int nig = WGM * nN, gid = wgid / nig, fm = gid * WGM, gsz = (nM - fm) < WGM ? (nM - fm) : WGM;
        u.pm = fm + ((wgid % nig) % gsz); u.pn = (wgid % nig) / gsz; return true;
    }
    __device__ __forceinline__ void a_ready(const Unit&) const {}
    __device__ __forceinline__ void done(const Unit&) const {}
};


__device__ __forceinline__ unsigned cvt_pk_bf16(float lo, float hi) { unsigned r; asm volatile("v_cvt_pk_bf16_f32 %0, %1, %2" : "=v"(r) : "v"(lo), "v"(hi)); return r; }
typedef float f32x2 __attribute__((ext_vector_type(2)));

typedef unsigned u32x2 __attribute__((ext_vector_type(2)));
struct EpiScaleBf16 {
    static constexpr bool PERM = true, AFTER_DRAIN = false;
    bf16_t* O; int ldc; const float* ssq; float inv_n, eps;
    __device__ __forceinline__ void operator()(const f32x4 (&acc)[2][2][4][2], const Unit& u, int wr, int wc, int fr, int fq) const {
        const int row0 = u.pm * BM + wr * 64 + fr, col0 = u.pn * BM + wc * 32 + 8 * fq;
#pragma unroll
        for (int ai = 0; ai < 2; ++ai)
#pragma unroll
            for (int m = 0; m < 4; ++m) { const int row = row0 + ai * HALF + m * 16; const float r = __builtin_amdgcn_rsqf(ssq[row] * inv_n + eps); bf16_t* rowp = O + (size_t)row * ldc + col0;
#pragma unroll
                for (int bj = 0; bj < 2; ++bj) { const f32x4 v0 = acc[ai][bj][m][0] * r, v1 = acc[ai][bj][m][1] * r;
                    u32x4 w; w.x = cvt_pk_bf16(v0[0], v0[1]); w.y = cvt_pk_bf16(v0[2], v0[3]); w.z = cvt_pk_bf16(v1[0], v1[1]); w.w = cvt_pk_bf16(v1[2], v1[3]);
                    *(u32x4*)(rowp + bj * HALF) = w; } }
    }
};
struct EpiSwiglu {
    static constexpr bool PERM = true, AFTER_DRAIN = false;
    bf16_t* H; int ldh; const float* ssq; float inv_n, eps;
    __device__ __forceinline__ static float swi(float g, float u) { return g * __builtin_amdgcn_rcpf(1.0f + __builtin_amdgcn_exp2f(g * -1.4426950408889634f)) * u; }
    __device__ __forceinline__ void operator()(const f32x4 (&acc)[2][2][4][2], const Unit& u, int wr, int wc, int fr, int fq) const {
        const int row0 = u.pm * BM + wr * 64 + fr, col0 = u.pn * HALF + wc * 32 + 8 * fq;
#pragma unroll
        for (int ai = 0; ai < 2; ++ai)
#pragma unroll
            for (int m = 0; m < 4; ++m) { const int row = row0 + ai * HALF + m * 16; const float r = __builtin_amdgcn_rsqf(ssq[row] * inv_n + eps);
                const f32x4 g0 = acc[ai][0][m][0] * r, g1 = acc[ai][0][m][1] * r, u0 = acc[ai][1][m][0] * r, u1 = acc[ai][1][m][1] * r;
                u32x4 w; w.x = cvt_pk_bf16(swi(g0[0], u0[0]), swi(g0[1], u0[1])); w.y = cvt_pk_bf16(swi(g0[2], u0[2]), swi(g0[3], u0[3]));
                w.z = cvt_pk_bf16(swi(g1[0], u1[0]), swi(g1[1], u1[1])); w.w = cvt_pk_bf16(swi(g1[2], u1[2]), swi(g1[3], u1[3]));
                *(u32x4*)(H + (size_t)row * ldh + col0) = w; }
    }
};
struct EpiResid {
    static constexpr bool PERM = false, AFTER_DRAIN = false;
    const float* base; float* out; bf16_t* xb; float* ssq; int ldc;
    __device__ __forceinline__ void operator()(const f32x4 (&acc)[2][2][4][2], const Unit& u, int wr, int wc, int fr, int fq) const {
        const int row0 = u.pm * BM + wr * 64 + fr, col0 = u.pn * BM + wc * 32 + 4 * fq;
#pragma unroll
        for (int ai = 0; ai < 2; ++ai)
#pragma unroll
            for (int m = 0; m < 4; ++m) { const int row = row0 + ai * HALF + m * 16; const size_t off = (size_t)row * ldc + col0; float s = 0.f;
#pragma unroll
                for (int bj = 0; bj < 2; ++bj)
#pragma unroll
                    for (int n = 0; n < 2; ++n) { const f32x4 o = *(const f32x4*)(base + off + bj * HALF + n * 16) + acc[ai][bj][m][n];
                        *(f32x4*)(out + off + bj * HALF + n * 16) = o; s += (o[0] * o[0] + o[1] * o[1]) + (o[2] * o[2] + o[3] * o[3]);
                        if (xb) { u32x2 w; w.x = cvt_pk_bf16(o[0], o[1]); w.y = cvt_pk_bf16(o[2], o[3]); *(u32x2*)(xb + off + bj * HALF + n * 16) = w; } }
                if (ssq) { s += __shfl_xor(s, 16); s += __shfl_xor(s, 32); if (fq == 0) atomicAdd(ssq + row, s); }
                if (m & 1) asm volatile("" ::: "memory"); }
    }
};


template <class Epi, class Sched, bool ALIGN_EPI = false, bool SP2 = false>
__device__ __forceinline__ void gemm_phase(PG8_LAS unsigned char* lds, const Gemm g, const Sched& S, const Epi& E) {
    int tid_ = threadIdx.x; asm volatile("" : "+v"(tid_));
    const int tid = tid_, wid = __builtin_amdgcn_readfirstlane(tid >> 6), lane = tid & 63, wr = wid >> 2, wc = wid & 3, fr = lane & 15, fq = lane >> 4;
    const int K = g.K, nt = K / BK;
    unsigned voffA[2], voffB[2];
#pragma unroll
    for (int i = 0; i < 2; ++i) { int R, C; stage_rc(tid * 16 + i * 8192, R, C); const int Rb = Epi::PERM ? ((R & ~31) + perm32(R & 31)) : R;
        voffA[i] = (unsigned)(R * K + C) * 2u; voffB[i] = (unsigned)(Rb * K + C) * 2u; }
    const size_t kstep = (size_t)(BK * 2);
    const size_t hstep = (size_t)HALF * K * 2;
    const size_t tstep = 2 * hstep;
    const unsigned ldsw = (unsigned)wid * 1024u;
    const int aoff = lds_byte(wr * 64 + fr, fq * 8), boff = lds_byte(wc * 32 + fr, fq * 8);
#define PG8_SA(b, h) (((b) * 2 + (h)) * HTB)
#define PG8_SB(b, h) ((4 + (b) * 2 + (h)) * HTB)
#define PG8_STAGE(bufoff, gbase, voff) do { _Pragma("unroll") for (int _i = 0; _i < 2; ++_i) \
        __builtin_amdgcn_global_load_lds((const unsigned*)((const char*)(gbase) + (voff)[_i]), (PG8_LAS unsigned*)(lds + (bufoff) + ldsw + _i * 8192), 16, 0, 0); } while (0)
#define PG8_LDA(dst, b, h) do { _Pragma("unroll") for (int m = 0; m < 4; ++m) _Pragma("unroll") for (int k = 0; k < 2; ++k) dst[m][k] = *(const PG8_LAS bf16x8*)(lds + PG8_SA(b, h) + aoff + m * 2048 + k * 1024); } while (0)
#define PG8_LDB(dst, b, h) do { _Pragma("unroll") for (int n = 0; n < 2; ++n) _Pragma("unroll") for (int k = 0; k < 2; ++k) dst[n][k] = *(const PG8_LAS bf16x8*)(lds + PG8_SB(b, h) + boff + n * 2048 + k * 1024); } while (0)
#define PG8_MMA(ai, bj, At, Bt) do { __builtin_amdgcn_s_setprio(1); _Pragma("unroll") for (int m = 0; m < 4; ++m) _Pragma("unroll") for (int n = 0; n < 2; ++n) _Pragma("unroll") for (int k = 0; k < 2; ++k) \
        acc[ai][bj][m][n] = __builtin_amdgcn_mfma_f32_16x16x32_bf16(Bt[n][k], At[m][k], acc[ai][bj][m][n], 0, 0, 0); __builtin_amdgcn_s_setprio(0); } while (0)
#define PG8_WAIT_V(n) asm volatile("s_waitcnt vmcnt(" #n ")" ::: "memory")
#define PG8_WAIT_L(n) asm volatile("s_waitcnt lgkmcnt(" #n ")" ::: "memory")
#define PG8_BAR __builtin_amdgcn_s_barrier()
#define PG8_SCHED __builtin_amdgcn_sched_barrier(0)
    Unit cur, nxt; int ui = 0;
    if (!S.next(0, cur)) return;
    f32x4 acc[2][2][4][2];
#pragma unroll
    for (int a = 0; a < 2; ++a)
#pragma unroll
        for (int b = 0; b < 2; ++b)
#pragma unroll
            for (int m = 0; m < 4; ++m)
#pragma unroll
                for (int n = 0; n < 2; ++n) acc[a][b][m][n] = (f32x4){0.f, 0.f, 0.f, 0.f};
    bf16x8 At[4][2], B0[2][2], B1[2][2];
    const char* cA = (const char*)g.A + (size_t)cur.pm * tstep; const char* cB = (const char*)g.Bt + (size_t)cur.pn * tstep;
    S.a_ready(cur);
    if constexpr (SP2) {
        PG8_STAGE(PG8_SB(0, 0), cB, voffB); PG8_STAGE(PG8_SB(0, 1), cB + hstep, voffB); PG8_STAGE(PG8_SA(0, 0), cA, voffA); PG8_STAGE(PG8_SA(0, 1), cA + hstep, voffA);
        if (wr == 1) PG8_BAR;
        PG8_WAIT_V(2); PG8_BAR;
        PG8_STAGE(PG8_SB(1, 0), cB + kstep, voffB); PG8_STAGE(PG8_SA(1, 0), cA + kstep, voffA); PG8_STAGE(PG8_SB(1, 1), cB + hstep + kstep, voffB);
        PG8_WAIT_V(6); PG8_BAR;
    } else {
        PG8_STAGE(PG8_SB(0, 0), cB, voffB); PG8_STAGE(PG8_SA(0, 0), cA, voffA); PG8_STAGE(PG8_SB(0, 1), cB + hstep, voffB); PG8_STAGE(PG8_SA(0, 1), cA + hstep, voffA);
        if (wr == 1) PG8_BAR;
        PG8_WAIT_V(4); PG8_BAR;
        PG8_STAGE(PG8_SB(1, 0), cB + kstep, voffB); PG8_STAGE(PG8_SA(1, 0), cA + kstep, voffA); PG8_STAGE(PG8_SB(1, 1), cB + hstep + kstep, voffB);
        PG8_WAIT_V(6); PG8_BAR;
    }
    for (;;) {
        const bool has_next = S.next(ui + 1, nxt);
        const char* nA = has_next ? (const char*)g.A + (size_t)nxt.pm * tstep : cA; const char* nB = has_next ? (const char*)g.Bt + (size_t)nxt.pn * tstep : cB;
        for (int t = 0; t < nt; t += 2) {
            const bool last = (t == nt - 2);
            const char* a1 = cA + (size_t)(t + 1) * kstep;
            const char* a2 = last ? nA : cA + (size_t)(t + 2) * kstep; const char* b2 = last ? nB : cB + (size_t)(t + 2) * kstep;
            const char* a3 = a2 + kstep; const char* b3 = b2 + kstep;
            if (last && has_next) S.a_ready(nxt);
            if constexpr (SP2) {
            PG8_LDB(B0, 0, 0); PG8_LDB(B1, 0, 1); PG8_SCHED; PG8_LDA(At, 0, 0); PG8_STAGE(PG8_SA(1, 1), a1 + hstep, voffA);
            PG8_WAIT_V(8); PG8_WAIT_L(0); PG8_BAR; PG8_MMA(0, 0, At, B0); PG8_MMA(0, 1, At, B1); PG8_BAR; PG8_SCHED;
            PG8_LDA(At, 0, 1); PG8_STAGE(PG8_SB(0, 0), b2, voffB); PG8_STAGE(PG8_SB(0, 1), b2 + hstep, voffB); PG8_STAGE(PG8_SA(0, 0), a2, voffA);
            PG8_WAIT_V(8); PG8_WAIT_L(0); PG8_BAR; PG8_MMA(1, 0, At, B0); PG8_MMA(1, 1, At, B1); PG8_BAR; PG8_SCHED;
            PG8_LDB(B0, 1, 0); PG8_LDB(B1, 1, 1); PG8_SCHED; PG8_LDA(At, 1, 0); PG8_STAGE(PG8_SA(0, 1), a2 + hstep, voffA);
            PG8_WAIT_V(8); PG8_WAIT_L(0); PG8_BAR; PG8_MMA(0, 0, At, B0); PG8_MMA(0, 1, At, B1); PG8_BAR; PG8_SCHED;
            PG8_LDA(At, 1, 1); PG8_STAGE(PG8_SB(1, 0), b3, voffB); PG8_STAGE(PG8_SB(1, 1), b3 + hstep, voffB); PG8_STAGE(PG8_SA(1, 0), a3, voffA);
            PG8_WAIT_V(8); PG8_WAIT_L(0); PG8_BAR; PG8_MMA(1, 0, At, B0); PG8_MMA(1, 1, At, B1); PG8_BAR; PG8_SCHED;
            } else {
            PG8_LDB(B0, 0, 0); PG8_SCHED; PG8_LDA(At, 0, 0); PG8_STAGE(PG8_SA(1, 1), a1 + hstep, voffA);
            PG8_WAIT_L(8); PG8_BAR; PG8_WAIT_L(0); PG8_MMA(0, 0, At, B0); PG8_BAR; PG8_SCHED;
            PG8_LDB(B1, 0, 1); PG8_STAGE(PG8_SB(0, 0), b2, voffB);
            PG8_BAR; PG8_WAIT_L(0); PG8_MMA(0, 1, At, B1); PG8_BAR;
            PG8_LDA(At, 0, 1); PG8_STAGE(PG8_SA(0, 0), a2, voffA);
            PG8_BAR; PG8_WAIT_L(0); PG8_MMA(1, 0, At, B0); PG8_BAR; PG8_SCHED;
            PG8_STAGE(PG8_SB(0, 1), b2 + hstep, voffB);
            PG8_WAIT_V(6); PG8_BAR; PG8_MMA(1, 1, At, B1); PG8_BAR;
            PG8_LDB(B0, 1, 0); PG8_SCHED; PG8_LDA(At, 1, 0); PG8_STAGE(PG8_SA(0, 1), a2 + hstep, voffA);
            PG8_WAIT_L(8); PG8_BAR; PG8_WAIT_L(0); PG8_MMA(0, 0, At, B0); PG8_BAR; PG8_SCHED;
            PG8_LDB(B1, 1, 1); PG8_STAGE(PG8_SB(1, 0), b3, voffB);
            PG8_BAR; PG8_WAIT_L(0); PG8_MMA(0, 1, At, B1); PG8_BAR;
            PG8_LDA(At, 1, 1); PG8_STAGE(PG8_SA(1, 0), a3, voffA);
            PG8_BAR; PG8_WAIT_L(0); PG8_MMA(1, 0, At, B0); PG8_BAR; PG8_SCHED;
            PG8_STAGE(PG8_SB(1, 1), b3 + hstep, voffB);
            PG8_WAIT_V(6); PG8_BAR; PG8_MMA(1, 1, At, B1); PG8_BAR;
            }
        }
        if constexpr (ALIGN_EPI) { if (wr == 0) PG8_BAR; }
        if constexpr (!Epi::AFTER_DRAIN) { E(acc, cur, wr, wc, fr, fq); S.done(cur); }
        if (!has_next) break;
#pragma unroll
        for (int a = 0; a < 2; ++a)
#pragma unroll
            for (int b = 0; b < 2; ++b)
#pragma unroll
                for (int m = 0; m < 4; ++m)
#pragma unroll
                    for (int n = 0; n < 2; ++n) acc[a][b][m][n] = (f32x4){0.f, 0.f, 0.f, 0.f};
        cur = nxt; cA = nA; cB = nB; ++ui;
        if constexpr (ALIGN_EPI) { if (wr == 1) PG8_BAR; }
    }
    PG8_WAIT_V(0);
    if constexpr (!ALIGN_EPI) { if (wr == 0) PG8_BAR; }
    PG8_BAR;
    if constexpr (Epi::AFTER_DRAIN) { E.fused(acc, cur, wr, wc, fr, fq, lds, wid, lane); S.done(cur); }
#undef PG8_SA
#undef PG8_SB
#undef PG8_STAGE
#undef PG8_LDA
#undef PG8_LDB
#undef PG8_MMA
#undef PG8_WAIT_V
#undef PG8_WAIT_L
#undef PG8_BAR
#undef PG8_SCHED
}
}

namespace attn {
constexpr int D = 128, NQD = 6;
constexpr float THR = 8.f;
constexpr bool WSKIP = false;
constexpr float SCALE = 0.10206207261596575f;
constexpr int NW = 8, QBLK = 32, KVBLK = 64, QB = NW * QBLK;
constexpr int SHM_V = KVBLK * D * 2, SHM_K = KVBLK * D * 2;
constexpr int LDS_BYTES = 2 * SHM_V + 2 * SHM_K + NW * 64 * 4;

using bf16 = __hip_bfloat16;
typedef short bf16x8 __attribute__((ext_vector_type(8)));
typedef short s16x4 __attribute__((ext_vector_type(4)));
typedef float f32x16 __attribute__((ext_vector_type(16)));
typedef float f32x4 __attribute__((ext_vector_type(4)));
typedef unsigned u32x4 __attribute__((ext_vector_type(4)));
template <class A, class Bt> struct same_t { static constexpr bool v = false; };
template <class A> struct same_t<A, A> { static constexpr bool v = true; };

#define KSWZ(row, colB) ((row) * 256 + ((colB) ^ (((row) & 7) << 4)))
#define SBAR() __builtin_amdgcn_sched_barrier(0)
__device__ __forceinline__ int v_st(int k, int c) { const int kk = (k & ~0xC) | ((k & 4) << 1) | ((k & 8) >> 1); return ((kk >> 3) * 4 + (c >> 5)) * 512 + ((kk & 7) * 32 + (c & 31)) * 2; }
__device__ __forceinline__ int v_rd_base(int lane) { return ((lane & 3) << 3) | (((lane >> 2) & 3) << 6) | (((lane >> 4) & 1) << 5) | (((lane >> 5) & 1) << 8); }
constexpr int v_rd_off(int d0, int ks, int half) { return d0 * 512 + ks * 4096 + half * 2048; }
__device__ __forceinline__ int crow(int r, int hi) { return (r & 3) + 8 * (r >> 2) + 4 * hi; }
__device__ __forceinline__ unsigned cvtpk(float lo, float hi) {
    unsigned r; asm volatile("v_cvt_pk_bf16_f32 %0, %1, %2" : "=v"(r) : "v"(lo), "v"(hi)); return r;
}
__device__ __forceinline__ bf16x8 pack8(f32x4 a, f32x4 b) {
    u32x4 w = {cvtpk(a[0], a[1]), cvtpk(a[2], a[3]), cvtpk(b[0], b[1]), cvtpk(b[2], b[3])};
    return *reinterpret_cast<bf16x8*>(&w);
}
template <class T> __device__ __forceinline__ bf16x8 load8(const T* p) {
    if constexpr (same_t<T, float>::v) { return pack8(*(const f32x4*)p, *(const f32x4*)(p + 4)); }
    else { return *reinterpret_cast<const bf16x8*>(p); }
}
__device__ __forceinline__ void mask_tile(f32x16& p0, f32x16& p1, int dq, unsigned W) {
    const float NEG = -__builtin_inff();
#pragma unroll
    for (int r = 0; r < 16; ++r) {
        const int c = (r & 3) + 8 * (r >> 2);
        if ((unsigned)(dq - c) >= W) p0[r] = NEG;
        if ((unsigned)(dq - c - 32) >= W) p1[r] = NEG;
    }
}
__device__ __forceinline__ void partialSM(f32x16& p0, f32x16& p1, float& m_reg, float& mn, float& alpha) {
    float pmax = p0[0]; for (int r = 1; r < 16; ++r) pmax = fmaxf(pmax, p0[r]); for (int r = 0; r < 16; ++r) pmax = fmaxf(pmax, p1[r]);
    { auto rr = __builtin_amdgcn_permlane32_swap(__float_as_uint(pmax), __float_as_uint(pmax), false, false);
      pmax = fmaxf(__uint_as_float(rr[0]), __uint_as_float(rr[1])); }
    constexpr float C2 = 1.4426950408889634f * SCALE;
    if (__builtin_expect(__all((pmax - m_reg) * SCALE <= THR), 1)) { mn = m_reg; alpha = 1.f; }
    else { mn = fmaxf(m_reg, pmax); alpha = __builtin_amdgcn_exp2f((m_reg - mn) * C2); m_reg = mn; }
    const float mnL = -mn * C2;
    for (int r = 0; r < 16; ++r) p0[r] = fmaf(p0[r], C2, mnL); for (int r = 0; r < 16; ++r) p1[r] = fmaf(p1[r], C2, mnL);
    for (int r = 0; r < 16; ++r) p0[r] = __builtin_amdgcn_exp2f(p0[r]);
}
__device__ __forceinline__ void finishSM(f32x16& p0, f32x16& p1, float alpha, float& l_reg, bf16x8& pa0, bf16x8& pa1, bf16x8& pa2, bf16x8& pa3) {
    for (int r = 0; r < 16; ++r) p1[r] = __builtin_amdgcn_exp2f(p1[r]);
    float ps = 0; for (int r = 0; r < 16; ++r) ps += p0[r]; for (int r = 0; r < 16; ++r) ps += p1[r];
    { auto rr = __builtin_amdgcn_permlane32_swap(__float_as_uint(ps), __float_as_uint(ps), false, false);
      ps = __uint_as_float(rr[0]) + __uint_as_float(rr[1]); }
    l_reg = l_reg * alpha + ps;
#define PK4(P, B_, OUT) do { unsigned a0 = cvtpk(P[B_+0], P[B_+1]), a1 = cvtpk(P[B_+2], P[B_+3]);                          \
        unsigned b0 = cvtpk(P[B_+4], P[B_+5]), b1 = cvtpk(P[B_+6], P[B_+7]);                                             \
        auto r0 = __builtin_amdgcn_permlane32_swap(a0, b0, false, false); auto r1 = __builtin_amdgcn_permlane32_swap(a1, b1, false, false); \
        u32x4 w = {r0[0], r1[0], r0[1], r1[1]}; OUT = *reinterpret_cast<bf16x8*>(&w); } while (0)
    PK4(p0, 0, pa0); PK4(p0, 8, pa1); PK4(p1, 0, pa2); PK4(p1, 8, pa3);
#undef PK4
}
template <int KB, bool SK>
__device__ __forceinline__ void qkt(f32x16& p0, f32x16& p1, const char* K_lds, int r32, int hi, const bf16x8* qr, bool act) {
    if (SK && !act) { const float NEG = -__builtin_inff();
#pragma unroll
        for (int r = 0; r < 16; ++r) { p0[r] = NEG; p1[r] = NEG; } return; }
    p0 = f32x16{}; p1 = f32x16{};
    const char* kb[4];
#pragma unroll
    for (int dd = 0; dd < 4; ++dd) kb[dd] = K_lds + KB * SHM_K + KSWZ(r32, (dd * 16 + hi * 8) * 2);
#pragma unroll
    for (int d0 = 0; d0 < NQD; ++d0) { const char* a = kb[d0 & 3] + (d0 >> 2) * 128;
        bf16x8 b0 = *reinterpret_cast<const bf16x8*>(a);
        bf16x8 b1 = *reinterpret_cast<const bf16x8*>(a + 32 * 256);
        p0 = __builtin_amdgcn_mfma_f32_32x32x16_bf16(b0, qr[d0], p0, 0, 0, 0);
        p1 = __builtin_amdgcn_mfma_f32_32x32x16_bf16(b1, qr[d0], p1, 0, 0, 0); }
}
template <int VB, bool SK>
__device__ __forceinline__ void pv_tile(f32x16* o, int vb0, bf16x8 pa0, bf16x8 pa1, bf16x8 pa2, bf16x8 pa3, bool act) {
    if (SK && !act) return;
#define TRRD(dst, off) asm volatile("ds_read_b64_tr_b16 %0, %1 offset:%2" : "=&v"(dst) : "v"(vb0), "i"(off) : "memory")
#define PV_D0(d0) do { s16x4 l0, l1, l2, l3, h0, h1, h2, h3; constexpr int b_ = VB * SHM_V + v_rd_off(d0, 0, 0);     \
        TRRD(l0, b_); TRRD(h0, b_ + 2048); TRRD(l1, b_ + 4096); TRRD(h1, b_ + 6144); TRRD(l2, b_ + 8192); TRRD(h2, b_ + 10240); TRRD(l3, b_ + 12288); TRRD(h3, b_ + 14336); \
        asm volatile("s_waitcnt lgkmcnt(0)" ::: "memory"); SBAR();                 \
        o[d0] = __builtin_amdgcn_mfma_f32_32x32x16_bf16(pa0, (bf16x8){l0[0], l0[1], l0[2], l0[3], h0[0], h0[1], h0[2], h0[3]}, o[d0], 0, 0, 0);   \
        o[d0] = __builtin_amdgcn_mfma_f32_32x32x16_bf16(pa1, (bf16x8){l1[0], l1[1], l1[2], l1[3], h1[0], h1[1], h1[2], h1[3]}, o[d0], 0, 0, 0);   \
        o[d0] = __builtin_amdgcn_mfma_f32_32x32x16_bf16(pa2, (bf16x8){l2[0], l2[1], l2[2], l2[3], h2[0], h2[1], h2[2], h2[3]}, o[d0], 0, 0, 0);   \
        o[d0] = __builtin_amdgcn_mfma_f32_32x32x16_bf16(pa3, (bf16x8){l3[0], l3[1], l3[2], l3[3], h3[0], h3[1], h3[2], h3[3]}, o[d0], 0, 0, 0); } while (0)
    PV_D0(0); PV_D0(1); PV_D0(2); PV_D0(3);
#undef PV_D0
#undef TRRD
}

template <class TIn, class TOut> struct BlockRef { const TIn* Q; const TIn* K; const TIn* V; TOut* O; float2* ML; int P0; int jlo; int jhi; };
template <class TIn> struct Seam {
    bf16x8 qr[NQD];
    bf16x8 st_v0, st_v1, st_k0, st_k1; f32x4 sf0, sf1, sf2, sf3;
    f32x4 tq[1];
};
__device__ __forceinline__ int swa_jlo(int P0, int W) { const int lowk = P0 - W + 1; return lowk > 0 ? lowk / KVBLK : 0; }
#define ROW(p, k0, rr) ((p) + (size_t)((k0) + (rr)) * D + sc)
#define VMW() asm volatile("s_waitcnt vmcnt(0)" ::: "memory")
#define VMWN(n) asm volatile("s_waitcnt vmcnt(%0)" :: "i"(n) : "memory")
#define SLOAD_H(Kp, Vp, k0) do { S.st_v0 = load8<TIn>(ROW(Vp, k0, sr)); S.st_v1 = load8<TIn>(ROW(Vp, k0, 32 + sr));              \
                         S.st_k0 = load8<TIn>(ROW(Kp, k0, sr)); S.st_k1 = load8<TIn>(ROW(Kp, k0, 32 + sr)); } while (0)
#define SWRITE_HK(bf) do { *(bf16x8*)(K_lds + (bf) * SHM_K + kws) = S.st_k0; *(bf16x8*)(K_lds + (bf) * SHM_K + kws + 32 * 256) = S.st_k1; } while (0)
#define SWRITE_HV(bf) do { *(bf16x8*)(V_lds + (bf) * SHM_V + vst0) = S.st_v0; *(bf16x8*)(V_lds + (bf) * SHM_V + vst1) = S.st_v1; } while (0)
#define SWRITE_H(bf) do { SWRITE_HV(bf); SWRITE_HK(bf); } while (0)
#define SLOAD_F(p, k0) do { S.sf0 = *(const f32x4*)ROW(p, k0, sr); S.sf1 = *(const f32x4*)(ROW(p, k0, sr) + 4);                \
                            S.sf2 = *(const f32x4*)ROW(p, k0, 32 + sr); S.sf3 = *(const f32x4*)(ROW(p, k0, 32 + sr) + 4); } while (0)
#define SWRITE_KF(bf) do { *(bf16x8*)(K_lds + (bf) * SHM_K + kws) = pack8(S.sf0, S.sf1); *(bf16x8*)(K_lds + (bf) * SHM_K + kws + 32 * 256) = pack8(S.sf2, S.sf3); } while (0)
#define SWRITE_VF(bf) do { *(bf16x8*)(V_lds + (bf) * SHM_V + vst0) = pack8(S.sf0, S.sf1); *(bf16x8*)(V_lds + (bf) * SHM_V + vst1) = pack8(S.sf2, S.sf3); } while (0)
template <class TIn, class TOut>
__device__ __forceinline__ void causal_swa_prime(const BlockRef<TIn, TOut>& cur, int W, char* lds, Seam<TIn>& S) {
    constexpr bool F32 = same_t<TIn, float>::v;
    int tid_ = threadIdx.x; asm volatile("" : "+v"(tid_));
    const int tid = tid_, wid = __builtin_amdgcn_readfirstlane(tid >> 6), lane = tid & 63, r32 = lane & 31, hi = lane >> 5;
    const int sr = tid >> 4, sc = (tid & 15) * 8, kws = KSWZ(sr, sc * 2); char* K_lds = lds + 2 * SHM_V;
    const int kb0 = cur.jlo * KVBLK;
    for (int d0 = 0; d0 < NQD; ++d0) S.qr[d0] = load8<TIn>(cur.Q + (size_t)(wid * QBLK + r32) * D + d0 * 16 + hi * 8);
    if constexpr (F32) { SLOAD_F((const float*)cur.K, kb0); VMW(); SWRITE_KF(0); SBAR(); SLOAD_F((const float*)cur.V, kb0); }
    else { SLOAD_H(cur.K, cur.V, kb0); VMW(); SWRITE_HK(0); }
    __syncthreads();
}
template <class TIn, class TOut>
__device__ __forceinline__ void causal_swa_block(const BlockRef<TIn, TOut>& cur, const BlockRef<TIn, TOut>& nxt, int skv, int W, char* lds, Seam<TIn>& S) {
    constexpr bool F32 = same_t<TIn, float>::v;
    int tid_ = threadIdx.x; asm volatile("" : "+v"(tid_));
    const int tid = tid_, wid = __builtin_amdgcn_readfirstlane(tid >> 6), lane = tid & 63, r32 = lane & 31, hi = lane >> 5;
    const int j_lo = cur.jlo; const int j_hi = cur.jhi; (void)skv;
    const int NT = j_hi - j_lo;
    const int kbn = nxt.jlo * KVBLK;
    const int qlo = cur.P0 + wid * QBLK, qm = qlo + r32 - 4 * hi;
    char* V_lds = lds; char* K_lds = lds + 2 * SHM_V;
    float* ws = (float*)(lds + 2 * SHM_V + 2 * SHM_K) + wid * 64; float* li_l = ws, * al_l = ws + 32;
    float m_reg = -1e30f, l_reg = 0; f32x16 o[4] = {};
    const int sr = tid >> 4, sc = (tid & 15) * 8, vst0 = v_st(sr, sc), vst1 = v_st(32 + sr, sc), kws = KSWZ(sr, sc * 2);
    const int vb0 = (int)(uintptr_t)V_lds + v_rd_base(lane);
    const TIn* Kh = cur.K; const TIn* Vh = cur.V;
#define RESC(a) do { if (__any((a) < 1.f)) { if (hi == 0) al_l[r32] = (a); asm volatile("s_waitcnt lgkmcnt(0)" ::: "memory");              \
                     for (int d_ = 0; d_ < 4; ++d_) for (int r = 0; r < 16; ++r) o[d_][r] *= al_l[crow(r, hi)]; } } while (0)
#define KBASE(t) ((j_lo + (t)) * KVBLK)
#define ACT(t) (KBASE(t) <= qlo + QBLK - 1 && KBASE(t) + KVBLK - 1 >= qlo - W + 1)
#define MASKT(P0_, P1_, t) do { const int kb_ = KBASE(t); if ((!SK || ACT(t)) && (kb_ + KVBLK - 1 > qlo || kb_ <= qlo + QBLK - 1 - W)) mask_tile(P0_, P1_, qm - kb_, (unsigned)W); } while (0)
    constexpr int NQL = F32 ? 16 : NQD;
    constexpr bool SK = WSKIP && !F32;
#define SEAM_K0() do { VMWN(NQL); if constexpr (F32) { SWRITE_KF(0); SBAR(); SLOAD_F((const float*)nxt.V, kbn); } else { SWRITE_HK(0); } SBAR(); } while (0)
    f32x16 pA0, pA1, pB0, pB1; float mnA, mnB, alA, alB; bf16x8 pa0, pa1, pa2, pa3;
    if constexpr (F32) { VMW(); SWRITE_VF(0); SBAR(); } else { SWRITE_HV(0); SBAR(); }
    if (NT > 1) { if constexpr (F32) SLOAD_F((const float*)Kh, KBASE(1)); else SLOAD_H(Kh, Vh, KBASE(1)); }
    SBAR(); qkt<0, SK>(pA0, pA1, K_lds, r32, hi, S.qr, ACT(0));
    if constexpr (F32) { if (NT > 1) { VMW(); SWRITE_KF(1); SBAR(); SLOAD_F((const float*)Vh, KBASE(1)); } }
    MASKT(pA0, pA1, 0); partialSM(pA0, pA1, m_reg, mnA, alA);
    if (NT > 1) { VMW(); if constexpr (F32) { SWRITE_VF(1); SBAR(); if (NT > 2) SLOAD_F((const float*)Kh, KBASE(2)); } else SWRITE_H(1); }
    __syncthreads();
#define HALF_STEP(PX0, PX1, mnX, alX, PY0, PY1, alY, t, KB, VB, SB) do {                                                      \
        SBAR(); qkt<KB, SK>(PX0, PX1, K_lds, r32, hi, S.qr, ACT(t));                                             \
        finishSM(PY0, PY1, alY, l_reg, pa0, pa1, pa2, pa3); SBAR();                                                           \
        if ((t) + 1 < NT) { if constexpr (F32) { VMW(); SWRITE_KF(SB); SBAR(); SLOAD_F((const float*)Vh, KBASE((t) + 1)); }  \
                            else { SLOAD_H(Kh, Vh, KBASE((t) + 1)); } SBAR(); }                                               \
        pv_tile<VB, SK>(o, vb0, pa0, pa1, pa2, pa3, ACT((t) - 1)); MASKT(PX0, PX1, (t)); partialSM(PX0, PX1, m_reg, mnX, alX);                                        \
        __syncthreads();                                                                                                      \
        if ((t) + 1 < NT) { VMW(); if constexpr (F32) { SWRITE_VF(SB); SBAR(); if ((t) + 2 < NT) SLOAD_F((const float*)Kh, KBASE((t) + 2)); } \
                            else { SWRITE_H(SB); } }                                                                          \
        RESC(alX); __syncthreads(); } while (0)
    for (int t = 1; t + 1 < NT; t += 2) {
        HALF_STEP(pB0, pB1, mnB, alB, pA0, pA1, alA, t, 1, 0, 0);
        HALF_STEP(pA0, pA1, mnA, alA, pB0, pB1, alB, t + 1, 0, 1, 1);
    }
    const bool even = (NT & 1) == 0;
    if (even) { SBAR(); qkt<1, SK>(pB0, pB1, K_lds, r32, hi, S.qr, ACT(NT - 1)); SBAR(); }
#define QROW(e) (nxt.Q + (size_t)(wid * QBLK + r32) * D + ((e) >> 1) * 16 + hi * 8 + ((e) & 1) * 4)
    if constexpr (F32) { SLOAD_F((const float*)nxt.K, kbn); SBAR();
#pragma unroll
        for (int e = 0; e < 8; ++e) S.tq[e] = *(const f32x4*)QROW(e); }
    else { SLOAD_H(nxt.K, nxt.V, kbn); SBAR();
#pragma unroll
        for (int d0 = 0; d0 < NQD; ++d0) S.qr[d0] = load8<TIn>(nxt.Q + (size_t)(wid * QBLK + r32) * D + d0 * 16 + hi * 8); }
    SBAR();
    finishSM(pA0, pA1, alA, l_reg, pa0, pa1, pa2, pa3); SBAR();
    if constexpr (F32) {
#pragma unroll
        for (int e = 8; e < 16; ++e) S.tq[e] = *(const f32x4*)QROW(e); SBAR(); }
#undef QROW
    pv_tile<0, SK>(o, vb0, pa0, pa1, pa2, pa3, ACT(even ? NT - 2 : NT - 1));
    if (even) { MASKT(pB0, pB1, NT - 1); partialSM(pB0, pB1, m_reg, mnB, alB); __syncthreads(); RESC(alB);
        finishSM(pB0, pB1, alB, l_reg, pa0, pa1, pa2, pa3); SBAR(); pv_tile<1, SK>(o, vb0, pa0, pa1, pa2, pa3, ACT(NT - 1)); }
    SBAR(); SEAM_K0();
    if (hi == 0) { li_l[r32] = l_reg; cur.ML[wid * QBLK + r32] = make_float2(m_reg, l_reg); } asm volatile("s_waitcnt lgkmcnt(0)" ::: "memory");
    float rli[16];
#pragma unroll
    for (int r = 0; r < 16; ++r) rli[r] = __builtin_amdgcn_rcpf(li_l[crow(r, hi)]);
    TOut* Ow = cur.O + (size_t)(wid * QBLK) * D;
#pragma unroll
    for (int r = 0; r < 16; ++r) { const int orow = crow(r, hi);
#pragma unroll
        for (int d0 = 0; d0 < 4; ++d0) { const float v = o[d0][r] * rli[r];
            if constexpr (same_t<TOut, float>::v) { Ow[(size_t)orow * D + d0 * 32 + r32] = v; }
            else { const float vn = __shfl_xor(v, 1);
                   if ((r32 & 1) == 0) *(unsigned*)(Ow + (size_t)orow * D + d0 * 32 + r32) = cvtpk(v, vn); } } }
    if constexpr (F32) {
#pragma unroll
        for (int d0 = 0; d0 < NQD; ++d0) S.qr[d0] = pack8(S.tq[2 * d0], S.tq[2 * d0 + 1]); }
    __syncthreads();
#undef RESC
#undef KBASE
#undef ACT
#undef MASKT
#undef SEAM_K0
#undef HALF_STEP
}
#undef ROW
#undef VMW
#undef VMWN
#undef SLOAD_H
#undef SWRITE_HK
#undef SWRITE_HV
#undef SWRITE_H
#undef SLOAD_F
#undef SWRITE_KF
#undef SWRITE_VF

struct Item { int bh, qb, jlo, jhi, chunk; };
struct Tensors { const bf16* Q; const bf16* K; const bf16* V; bf16* O; float2* ML; };
constexpr int SEQ = 8192, NBH = 8;
__device__ __forceinline__ BlockRef<bf16, bf16> mkref(const Tensors& T, const Item& it) {
    BlockRef<bf16, bf16> r; const size_t row0 = (size_t)it.bh * SEQ + (size_t)it.qb * QB;
    r.Q = T.Q + row0 * D; r.K = T.K + (size_t)it.bh * SEQ * D; r.V = T.V + (size_t)it.bh * SEQ * D;
    r.O = T.O + ((size_t)it.chunk * NBH * SEQ + row0) * D; r.ML = T.ML + (size_t)it.chunk * NBH * SEQ + row0; r.P0 = it.qb * QB; r.jlo = it.jlo; r.jhi = it.jhi;
    return r;
}
template <class Sched> __device__ __forceinline__ void attn_phase(char* lds, const Tensors& T, const Sched& S) {
    Item it, itn; if (!S.get(0, it)) return;
    BlockRef<bf16, bf16> cur = mkref(T, it);
    Seam<bf16> Sm;
    causal_swa_prime<bf16, bf16>(cur, 1 << 30, lds, Sm);
    for (int i = 0;; ++i) {
        const bool more = S.get(i + 1, itn);
        const BlockRef<bf16, bf16> nxt = more ? mkref(T, itn) : cur;
        causal_swa_block<bf16, bf16>(cur, nxt, SEQ, 1 << 30, lds, Sm);
        if (!more) break;
        cur = nxt;
    }
}
#undef KSWZ
#undef SBAR
}

constexpr int NWAVES = 8;
#ifndef MK_N_LAUNCHES
#define MK_N_LAUNCHES 15
#endif
constexpr int BATCH = 2, SEQ = 8192, DM = 1024, DEPTH = 2;
constexpr int M = BATCH * SEQ;
constexpr int Q_LORA = 256, KV_LORA = 128, QK_ROPE = 32, QK_NOPE = 64, QK_HEAD = 96, V_HEAD = 128, NHEAD = 4;
constexpr int SGU_W = 256, POOL_W = 256, CHUNK = 128;
constexpr int IN_W = 1184, ZLD = 1280;
constexpr int ZO_KV = 256, ZO_ROPE = 384, ZO_U = 416, ZO_V = 672, ZO_P = 928;
constexpr int FF = 2816, FF2 = 2 * FF;
constexpr float EPS = 1e-6f;
constexpr int PH_PER_LAYER = 7, NPH = 1 + DEPTH * PH_PER_LAYER;
constexpr int N_LAUNCHES = (MK_N_LAUNCHES == 1) ? 1 : NPH;

constexpr size_t MiB = 1u << 20;
constexpr size_t WS_CTL = 0, CTL_ZERO_BYTES = 1 * MiB;
constexpr size_t WS_SSQ = 64 * 1024;
constexpr size_t WS_W = 2 * MiB, LW = 22 * MiB;
constexpr size_t OW_IN = 0, OW_Q = OW_IN + (size_t)ZLD * DM * 2, OW_KV = OW_Q + (size_t)384 * Q_LORA * 2, OW_OUT = OW_KV + (size_t)768 * KV_LORA * 2,
                 OW_GU = OW_OUT + (size_t)DM * DM * 2, OW_DN = OW_GU + (size_t)FF2 * DM * 2, OW_POOL = OW_DN + (size_t)DM * FF * 2, OW_END = OW_POOL + (size_t)4 * 64 * 64 * 2;
static_assert(OW_END <= LW, "weight map");
constexpr size_t WS_CS = 46 * MiB;
constexpr size_t WS_XB = 48 * MiB;
constexpr size_t WS_MIX = 80 * MiB;
constexpr size_t WS_Z = 112 * MiB;
constexpr size_t WS_Q = 152 * MiB, WS_K = 168 * MiB, WS_V = 184 * MiB;
constexpr size_t WS_ML = 200 * MiB;
constexpr size_t WS_H = 112 * MiB;
constexpr size_t WS_END = 202 * MiB;
constexpr size_t OPART_BYTES = (size_t)8 * SEQ * 128 * 2;
static_assert(WS_W + DEPTH * LW <= WS_CS && WS_H + (size_t)M * FF * 2 <= WS_ML && WS_Z + (size_t)M * ZLD * 2 <= WS_Q, "d_ws map");
__host__ __device__ constexpr size_t opart_off(int chunk) { return chunk < 2 ? WS_XB + chunk * OPART_BYTES : WS_Z + (chunk - 2) * OPART_BYTES; }
constexpr int CW_TMO = 0, CW_CODE = 1;
constexpr int CW_BAR = 4096;

constexpr int RING_OFF = 0, RING_BYTES = 131072;
constexpr int LDSCTL_OFF = RING_BYTES, MISC_OFF = LDSCTL_OFF + 320;
constexpr int LDS_BYTES = 147456;
static_assert(MISC_OFF + 128 <= LDS_BYTES, "LDS map");

#define GAS __attribute__((address_space(1)))
#define LAS __attribute__((address_space(3)))
typedef unsigned short bf16;
typedef unsigned v4u __attribute__((ext_vector_type(4)));
typedef float f32x4 __attribute__((ext_vector_type(4)));
typedef short bf16x8 __attribute__((ext_vector_type(8)));
typedef GAS unsigned gu32;
typedef GAS unsigned long long gu64;
#define RLX_AGENT __ATOMIC_RELAXED, __HIP_MEMORY_SCOPE_AGENT
#define LDS_WAIT() asm volatile("s_waitcnt lgkmcnt(0)" ::: "memory")
#define VM_WAIT() asm volatile("s_waitcnt vmcnt(0)" ::: "memory")
__device__ __forceinline__ unsigned long long rt() { return __builtin_amdgcn_s_memrealtime(); }
__device__ __forceinline__ unsigned f2bf(float f) { unsigned u = __builtin_bit_cast(unsigned, f); return (u + 0x7fffu + ((u >> 16) & 1u)) >> 16; }
__device__ __forceinline__ unsigned pk2(float lo, float hi) { return f2bf(lo) | (f2bf(hi) << 16); }

#define XB_TMO      128
#define XB_XCNT(j)  (256  + 64 * (j))
#define XB_XSUB(j)  (1280 + 64 * (j))
#define XB_XGEN(j)  (2304 + 64 * (j))
#define XB_TOP      3328
#define XB_TOPGEN   3392
#define XCD_BAR_WORDS 3456
#define XB_SPIN_CAP (1u << 18)

__device__ __forceinline__ unsigned xb_ld(unsigned* p)              { return __hip_atomic_load(p, __ATOMIC_RELAXED, __HIP_MEMORY_SCOPE_AGENT); }
__device__ __forceinline__ unsigned xb_add(unsigned* p, unsigned v) { return __hip_atomic_fetch_add(p, v, __ATOMIC_RELAXED, __HIP_MEMORY_SCOPE_AGENT); }
__device__ __forceinline__ unsigned xb_xcc_id() { return (unsigned)__builtin_amdgcn_s_getreg((3 << 11) | 20) & 0xFu; }
#define XB_SPIN(cond, bar) do { unsigned _sp = 0; while (cond) { __builtin_amdgcn_s_sleep(1); \
    if ((++_sp & 255u) == 0u) { if (xb_ld(&(bar)[XB_TMO])) break; if (_sp > XB_SPIN_CAP) { atomicAdd(&(bar)[XB_TMO], 1u); break; } } } } while (0)

struct XcdBarrier {
    unsigned* bar; unsigned x;
    volatile LAS unsigned* st;
};

__device__ __forceinline__ XcdBarrier xcd_barrier_post(unsigned* bar, volatile LAS unsigned* st) {
    XcdBarrier b; b.bar = bar; b.x = xb_xcc_id(); b.st = st;
    if (threadIdx.x == 0) (void)xb_add(&bar[XB_XCNT(b.x)], 1u);
    return b;
}
__device__ __forceinline__ void xcd_barrier_complete(unsigned* bar, unsigned x, unsigned& nloc, unsigned& nx) {
    const unsigned G = gridDim.x * gridDim.y * gridDim.z;
    unsigned sum, cnt, mine, sp = 0u;
    for (;;) {
        sum = 0u; cnt = 0u; mine = 0u;
#pragma unroll
        for (unsigned j = 0; j < 16; ++j) { const unsigned c = xb_ld(&bar[XB_XCNT(j)]); sum += c; cnt += (c > 0u) ? 1u : 0u; mine = (j == x) ? c : mine; }
        if (sum == G) break;
        __builtin_amdgcn_s_sleep(1);
        if ((++sp & 255u) == 0u) { if (xb_ld(&bar[XB_TMO])) break; if (sp > XB_SPIN_CAP) { atomicAdd(&bar[XB_TMO], 1u); break; } }
    }
    nloc = mine > 0u ? mine : 1u; nx = cnt > 0u ? cnt : 1u;
}

__device__ __forceinline__ void xcd_barrier(const XcdBarrier& b) {
    asm volatile("s_waitcnt vmcnt(0)" ::: "memory");
    __syncthreads();
    if (threadIdx.x == 0) {
        unsigned* bar = b.bar;
        __builtin_amdgcn_s_waitcnt(0);
        unsigned nloc = b.st[0], nx = b.st[1];
        if (nloc == 0u) { xcd_barrier_complete(bar, b.x, nloc, nx); b.st[0] = nloc; b.st[1] = nx; }
        const unsigned old = xb_add(&bar[XB_XSUB(b.x)], 1u);
        const unsigned gen = old / nloc;
        if (old + 1u == (gen + 1u) * nloc) {
            __builtin_amdgcn_fence(__ATOMIC_RELEASE, "agent");
            asm volatile("s_waitcnt vmcnt(0)" ::: "memory");
            const unsigned og = xb_add(&bar[XB_TOP], 1u);
            const unsigned tg = og / nx;
            if (og + 1u == (tg + 1u) * nx) xb_add(&bar[XB_TOPGEN], 1u);
            else XB_SPIN(xb_ld(&bar[XB_TOPGEN]) == tg, bar);
            __builtin_amdgcn_fence(__ATOMIC_ACQUIRE, "agent");
            xb_add(&bar[XB_XGEN(b.x)], 1u);
            asm volatile("s_waitcnt vmcnt(0)" ::: "memory");
        } else {
            XB_SPIN(xb_ld(&bar[XB_XGEN(b.x)]) == gen, bar);
            __builtin_amdgcn_fence(__ATOMIC_ACQUIRE, "agent");
            asm volatile("s_waitcnt vmcnt(0)" ::: "memory");
        }
    }
    __syncthreads();
}

typedef unsigned u32x2 __attribute__((ext_vector_type(2)));
#define CAS __attribute__((address_space(4)))
struct Args { const float* in[23]; float* out; unsigned char* ws; int ph_lo, ph_hi, li, pad; };
struct Frame {
    LAS unsigned char* lds;
    const CAS Args* a;
    int lane, wave;
    int vcu, G;
};
__device__ __forceinline__ float wave_sum(float v) {
#pragma unroll
    for (int o = 1; o < 64; o <<= 1) v += __shfl_xor(v, o);
    return v;
}
__device__ __forceinline__ float quad_sum(float v) { v += __shfl_xor(v, 16); v += __shfl_xor(v, 32); return v; }
__device__ __forceinline__ float bf2f(unsigned short h) { return __builtin_bit_cast(float, (unsigned)h << 16); }
__device__ __forceinline__ float bflo(unsigned w) { return __builtin_bit_cast(float, w << 16); }
__device__ __forceinline__ float bfhi(unsigned w) { return __builtin_bit_cast(float, w & 0xffff0000u); }
__device__ __forceinline__ f32x4 mfma16(bf16x8 a, bf16x8 b, f32x4 c) { return __builtin_amdgcn_mfma_f32_16x16x32_bf16(a, b, c, 0, 0, 0); }
__device__ __forceinline__ u32x2 pk4(f32x4 v) { u32x2 w; w.x = pk2(v[0], v[1]); w.y = pk2(v[2], v[3]); return w; }
__device__ __forceinline__ bf16x8 pk8(const float* v) { v4u w; w.x = pk2(v[0], v[1]); w.y = pk2(v[2], v[3]); w.z = pk2(v[4], v[5]); w.w = pk2(v[6], v[7]); return __builtin_bit_cast(bf16x8, w); }

#define IN_F(i) ((const float*)F.a->in[i])
__device__ __forceinline__ bf16* wsp(const Frame& F, size_t off) { return (bf16*)(F.a->ws + off); }
__device__ __forceinline__ float* ssq_mix(const Frame& F, int l) { return (float*)(F.a->ws + WS_SSQ) + (size_t)(2 * l) * M; }
__device__ __forceinline__ float* ssq_ffn(const Frame& F, int l) { return (float*)(F.a->ws + WS_SSQ) + (size_t)(2 * l + 1) * M; }

__device__ __forceinline__ void p0_tr_item(const float* W, int ldw, int k0, int n0, const float* gain, bf16* WT, int ldt, int drow0, LAS float* scr, int lane) {
#pragma unroll 8
    for (int i = 0; i < 32; ++i) { const int kk = 2 * i + (lane >> 5); float v = W[(size_t)(k0 + kk) * ldw + n0 + (lane & 31)]; if (gain) v *= gain[k0 + kk]; scr[kk * 33 + (lane & 31)] = v; }
    LDS_WAIT(); asm volatile("" ::: "memory");
    const int c = lane & 7;
#pragma unroll
    for (int j = 0; j < 4; ++j) { const int n = (lane >> 3) + 8 * j; const LAS float* s = scr + (8 * c) * 33 + n;
        v4u o; o.x = pk2(s[0 * 33], s[1 * 33]); o.y = pk2(s[2 * 33], s[3 * 33]); o.z = pk2(s[4 * 33], s[5 * 33]); o.w = pk2(s[6 * 33], s[7 * 33]);
        *(GAS v4u*)(WT + (size_t)(drow0 + n) * ldt + k0 + 8 * c) = o; }
    LDS_WAIT(); asm volatile("" ::: "memory");
}
__device__ __forceinline__ void p0_prologue(Frame& F) {
    LAS float* scr = (LAS float*)(F.lds + RING_OFF + F.wave * 16384);
    const int gw = F.vcu * NWAVES + F.wave, NGW = F.G * NWAVES, lane = F.lane;
    constexpr int I_IN = (DM / 64) * (IN_W / 32), I_Q = (Q_LORA / 64) * (384 / 32), I_KV = (KV_LORA / 64) * (768 / 32), I_OUT = (DM / 64) * (DM / 32),
                  I_G = (DM / 64) * (FF / 32), I_DN = (FF / 64) * (DM / 32), I_LAYER = I_IN + I_Q + I_KV + I_OUT + 2 * I_G + I_DN;
    for (int it = gw; it < DEPTH * I_LAYER; it += NGW) {
        const int l = it / I_LAYER; int r = it - l * I_LAYER;
        unsigned char* wl = F.a->ws + WS_W + (size_t)l * LW;
        if (r < I_IN) { const int nb = IN_W / 32, kb = r / nb, n0 = 32 * (r % nb);
            p0_tr_item(IN_F(3) + (size_t)l * DM * IN_W, IN_W, 64 * kb, n0, IN_F(2) + l * DM, (bf16*)(wl + OW_IN), DM, n0, scr, lane); continue; } r -= I_IN;
        if (r < I_Q) { const int nb = 384 / 32, kb = r / nb, n0 = 32 * (r % nb);
            p0_tr_item(IN_F(5) + (size_t)l * Q_LORA * 384, 384, 64 * kb, n0, IN_F(4) + l * Q_LORA, (bf16*)(wl + OW_Q), Q_LORA, n0, scr, lane); continue; } r -= I_Q;
        if (r < I_KV) { const int nb = 768 / 32, kb = r / nb, n0 = 32 * (r % nb);
            p0_tr_item(IN_F(7) + (size_t)l * KV_LORA * 768, 768, 64 * kb, n0, IN_F(6) + l * KV_LORA, (bf16*)(wl + OW_KV), KV_LORA, n0, scr, lane); continue; } r -= I_KV;
        if (r < I_OUT) { const int nb = DM / 32, kb = r / nb, n0 = 32 * (r % nb), k0 = 64 * kb;
            const float* g = k0 < 512 ? IN_F(15) + l * 512 : k0 < 768 ? IN_F(16) + l * 256 - 512 : IN_F(17) + l * 256 - 768;
            p0_tr_item(IN_F(18) + (size_t)l * DM * DM, DM, k0, n0, g, (bf16*)(wl + OW_OUT), DM, n0, scr, lane); continue; } r -= I_OUT;
        if (r < 2 * I_G) { const int up = r >= I_G; if (up) r -= I_G; const int nb = FF / 32, kb = r / nb, n0 = 32 * (r % nb);
            p0_tr_item(IN_F(up ? 21 : 20) + (size_t)l * DM * FF, FF, 64 * kb, n0, IN_F(19) + l * DM, (bf16*)(wl + OW_GU), DM, (n0 >> 7) * 256 + (n0 & 127) + (up ? 128 : 0), scr, lane); continue; } r -= 2 * I_G;
        { const int nb = DM / 32, kb = r / nb, n0 = 32 * (r % nb);
            p0_tr_item(IN_F(22) + (size_t)l * FF * DM, DM, 64 * kb, n0, nullptr, (bf16*)(wl + OW_DN), FF, n0, scr, lane); }
    }
    { const int gt = gw * 64 + lane, NGT = NGW * 64;
        for (int i = gt; i < DEPTH * (ZLD - IN_W) * DM / 8; i += NGT) { const int l = i / ((ZLD - IN_W) * DM / 8), e = i % ((ZLD - IN_W) * DM / 8);
            *(GAS v4u*)(F.a->ws + WS_W + (size_t)l * LW + OW_IN + (size_t)IN_W * DM * 2 + (size_t)e * 16) = (v4u){0u, 0u, 0u, 0u}; }
        for (int i = gt; i < DEPTH * 4 * 64 * 64; i += NGT) { const int l = i >> 14, g = (i >> 12) & 3, d = (i >> 6) & 63, c = i & 63;
            ((bf16*)(F.a->ws + WS_W + (size_t)l * LW + OW_POOL))[(g * 64 + d) * 64 + c] = (bf16)f2bf(IN_F(13)[(size_t)l * 16384 + (g * 64 + c) * 64 + d]); }
        const int* pos = (const int*)IN_F(1);
        for (int i = gt; i < M * 16; i += NGT) { const int m = i >> 4, f = i & 15;
            const float inv = 1.0f / powf(10000.0f, (float)f * (1.0f / 16.0f));
            const float ang = (float)pos[m] * inv;
            const double a = (double)ang, n = rint(a * 0.15915494309189535), y = a - n * 6.283185307179586;
            const float yf = (float)y; ((float*)(F.a->ws + WS_CS))[(size_t)m * 32 + f] = cosf(yf); ((float*)(F.a->ws + WS_CS))[(size_t)m * 32 + 16 + f] = sinf(yf); }
    }
    float* ssq0 = ssq_mix(F, 0);
    for (int m = gw; m < M; m += NGW) {
        const GAS f32x4* xr = (const GAS f32x4*)(IN_F(0) + (size_t)m * DM) + lane; float s = 0.f;
        GAS unsigned long long* o8 = (GAS unsigned long long*)(wsp(F, WS_XB) + (size_t)m * DM) + lane;
#pragma unroll
        for (int j = 0; j < 4; ++j) { const f32x4 v = xr[64 * j]; s += (v.x * v.x + v.y * v.y) + (v.z * v.z + v.w * v.w);
            o8[64 * j] = (unsigned long long)pk2(v.x, v.y) | ((unsigned long long)pk2(v.z, v.w) << 32); }
        s = wave_sum(s); if (lane == 0) ssq0[m] = s;
    }
}

__device__ __forceinline__ void p2_upproj_unit(Frame& F, int l, int chunk) {
    const int lane = F.lane, tl = lane & 15, kq = lane >> 4;
    const int m = chunk * CHUNK + F.wave * 16 + tl, b = m >> 13, s = m & (SEQ - 1);
    const bf16* zrow = wsp(F, WS_Z) + (size_t)m * ZLD;
    const unsigned char* wl = F.a->ws + WS_W + (size_t)l * LW;
    const bf16* Wq = (const bf16*)(wl + OW_Q); const bf16* Wkv = (const bf16*)(wl + OW_KV);
    bf16x8 zq[8], zkv[4];
#pragma unroll
    for (int ks = 0; ks < 8; ++ks) zq[ks] = *(const bf16x8*)(zrow + ks * 32 + kq * 8);
#pragma unroll
    for (int ks = 0; ks < 4; ++ks) zkv[ks] = *(const bf16x8*)(zrow + ZO_KV + ks * 32 + kq * 8);
    float sq = 0.f, skv = 0.f;
#pragma unroll
    for (int ks = 0; ks < 8; ++ks)
#pragma unroll
        for (int j = 0; j < 8; ++j) { const float v = bf2f((unsigned short)zq[ks][j]); sq += v * v; }
#pragma unroll
    for (int ks = 0; ks < 4; ++ks)
#pragma unroll
        for (int j = 0; j < 8; ++j) { const float v = bf2f((unsigned short)zkv[ks][j]); skv += v * v; }
    const float r_q = __builtin_amdgcn_rsqf(quad_sum(sq) * (1.0f / Q_LORA) + EPS), r_kv = __builtin_amdgcn_rsqf(quad_sum(skv) * (1.0f / KV_LORA) + EPS);
    const u32x2 kw0 = *(const u32x2*)(zrow + ZO_ROPE + 4 * kq), kw1 = *(const u32x2*)(zrow + ZO_ROPE + 16 + 4 * kq);
    const f32x4 kr0 = {bflo(kw0.x), bfhi(kw0.x), bflo(kw0.y), bfhi(kw0.y)}, kr1 = {bflo(kw1.x), bfhi(kw1.x), bflo(kw1.y), bfhi(kw1.y)};
    float skr = (kr0[0] * kr0[0] + kr0[1] * kr0[1]) + (kr0[2] * kr0[2] + kr0[3] * kr0[3]) + (kr1[0] * kr1[0] + kr1[1] * kr1[1]) + (kr1[2] * kr1[2] + kr1[3] * kr1[3]);
    skr = quad_sum(skr);
    const float* csr = (const float*)(F.a->ws + WS_CS) + (size_t)m * 32;
    const f32x4 cs = *(const f32x4*)(csr + 4 * kq), sn = *(const f32x4*)(csr + 16 + 4 * kq);
    const float* gq = IN_F(8) + l * QK_HEAD; const float* gk = IN_F(9) + l * QK_HEAD;
    const f32x4 gk_a = *(const f32x4*)(gk + 64 + 4 * kq), gk_b = *(const f32x4*)(gk + 80 + 4 * kq);
#pragma unroll 1
    for (int h = 0; h < NHEAD; ++h) {
        const size_t orow = ((size_t)(b * NHEAD + h) * SEQ + s) * 128;
        {
            f32x4 acc[6];
#pragma unroll
            for (int nb = 0; nb < 6; ++nb) acc[nb] = (f32x4){0.f, 0.f, 0.f, 0.f};
#pragma unroll
            for (int ks = 0; ks < 8; ++ks)
#pragma unroll
                for (int nb = 0; nb < 6; ++nb) { const bf16x8 a = *(const bf16x8*)(Wq + (size_t)(h * QK_HEAD + nb * 16 + tl) * Q_LORA + ks * 32 + kq * 8); acc[nb] = mfma16(a, zq[ks], acc[nb]); }
            float ss = 0.f;
#pragma unroll
            for (int nb = 0; nb < 6; ++nb) { acc[nb] = acc[nb] * r_q; ss += (acc[nb][0] * acc[nb][0] + acc[nb][1] * acc[nb][1]) + (acc[nb][2] * acc[nb][2] + acc[nb][3] * acc[nb][3]); }
            const float rh = __builtin_amdgcn_rsqf(quad_sum(ss) * (1.0f / QK_HEAD) + EPS);
#pragma unroll
            for (int nb = 0; nb < 6; ++nb) acc[nb] = acc[nb] * rh * *(const f32x4*)(gq + nb * 16 + 4 * kq);
            const f32x4 x1 = acc[4], x2 = acc[5]; acc[4] = x1 * cs - x2 * sn; acc[5] = x2 * cs + x1 * sn;
            bf16* qo = wsp(F, WS_Q) + orow + 4 * kq;
#pragma unroll
            for (int nb = 0; nb < 6; ++nb) *(u32x2*)(qo + nb * 16) = pk4(acc[nb]);
            *(u32x2*)(qo + 96) = (u32x2){0u, 0u}; *(u32x2*)(qo + 112) = (u32x2){0u, 0u};
        }
        {
            f32x4 acc[12];
#pragma unroll
            for (int nb = 0; nb < 12; ++nb) acc[nb] = (f32x4){0.f, 0.f, 0.f, 0.f};
#pragma unroll
            for (int ks = 0; ks < 4; ++ks)
#pragma unroll
                for (int nb = 0; nb < 12; ++nb) { const bf16x8 a = *(const bf16x8*)(Wkv + (size_t)(h * 192 + nb * 16 + tl) * KV_LORA + ks * 32 + kq * 8); acc[nb] = mfma16(a, zkv[ks], acc[nb]); }
            float ss = 0.f;
#pragma unroll
            for (int nb = 0; nb < 4; ++nb) { acc[nb] = acc[nb] * r_kv; ss += (acc[nb][0] * acc[nb][0] + acc[nb][1] * acc[nb][1]) + (acc[nb][2] * acc[nb][2] + acc[nb][3] * acc[nb][3]); }
            const float rh = __builtin_amdgcn_rsqf((quad_sum(ss) + skr) * (1.0f / QK_HEAD) + EPS);
            bf16* ko = wsp(F, WS_K) + orow + 4 * kq;
#pragma unroll
            for (int nb = 0; nb < 4; ++nb) *(u32x2*)(ko + nb * 16) = pk4(acc[nb] * rh * *(const f32x4*)(gk + nb * 16 + 4 * kq));
            const f32x4 x1 = kr0 * rh * gk_a, x2 = kr1 * rh * gk_b;
            *(u32x2*)(ko + 64) = pk4(x1 * cs - x2 * sn); *(u32x2*)(ko + 80) = pk4(x2 * cs + x1 * sn);
            *(u32x2*)(ko + 96) = (u32x2){0u, 0u}; *(u32x2*)(ko + 112) = (u32x2){0u, 0u};
            bf16* vo = wsp(F, WS_V) + orow + 4 * kq;
#pragma unroll
            for (int nb = 0; nb < 8; ++nb) *(u32x2*)(vo + nb * 16) = pk4(acc[4 + nb] * r_kv);
        }
    }
}

constexpr int VS = 136;
__device__ __forceinline__ void p2_sgu_pool_unit(Frame& F, int l, int chunk) {
    const int lane = F.lane, tl = lane & 15, kq = lane >> 4, w = F.wave;
    LAS bf16* vnT = (LAS bf16*)(F.lds + RING_OFF);
    const bf16* Z = wsp(F, WS_Z);
    { const f32x4 g = *(const f32x4*)(IN_F(10) + l * SGU_W + 4 * lane);
      for (int i = 0; i < 16; ++i) { const int sl = w * 16 + i; const u32x2 vw = *(const u32x2*)(Z + (size_t)(chunk * CHUNK + sl) * ZLD + ZO_V + 4 * lane);
          const f32x4 v = {bflo(vw.x), bfhi(vw.x), bflo(vw.y), bfhi(vw.y)};
          const float r = __builtin_amdgcn_rsqf(wave_sum((v[0] * v[0] + v[1] * v[1]) + (v[2] * v[2] + v[3] * v[3])) * (1.0f / SGU_W) + EPS);
#pragma unroll
          for (int j = 0; j < 4; ++j) vnT[(4 * lane + j) * VS + sl] = (bf16)f2bf(v[j] * r * g[j]); } }
    __syncthreads();
    const int t = w * 16 + tl, m = chunk * CHUNK + t, s = m & (SEQ - 1);
    const bf16* zrow = Z + (size_t)m * ZLD;
    bf16* mixrow = wsp(F, WS_MIX) + (size_t)m * DM;
    {
        f32x4 acc[4][4];
#pragma unroll
        for (int h = 0; h < 4; ++h)
#pragma unroll
            for (int db = 0; db < 4; ++db) acc[h][db] = (f32x4){0.f, 0.f, 0.f, 0.f};
        const int nks = (w * 16 + 15) / 32 + 1;
        for (int ks = 0; ks < nks; ++ks) {
#pragma unroll
            for (int h = 0; h < 4; ++h) {
                const float* wr_ = IN_F(11) + ((size_t)(l * 4 + h) * CHUNK + t) * CHUNK + ks * 32 + kq * 8;
                const f32x4 w0 = *(const f32x4*)wr_, w1 = *(const f32x4*)(wr_ + 4); float wv[8] = {w0[0], w0[1], w0[2], w0[3], w1[0], w1[1], w1[2], w1[3]};
#pragma unroll
                for (int j = 0; j < 8; ++j) if (ks * 32 + kq * 8 + j > t) wv[j] = 0.f;
                const bf16x8 bfrag = pk8(wv);
#pragma unroll
                for (int db = 0; db < 4; ++db) { const bf16x8 a = *(const LAS bf16x8*)(vnT + (h * 64 + db * 16 + tl) * VS + ks * 32 + kq * 8); acc[h][db] = mfma16(a, bfrag, acc[h][db]); }
            }
        }
        float ss = 0.f;
#pragma unroll
        for (int h = 0; h < 4; ++h) { const float bsp = IN_F(12)[(size_t)(l * 4 + h) * CHUNK + t];
#pragma unroll
            for (int db = 0; db < 4; ++db) { const u32x2 uw = *(const u32x2*)(zrow + ZO_U + h * 64 + db * 16 + 4 * kq);
                const f32x4 u = {bflo(uw.x), bfhi(uw.x), bflo(uw.y), bfhi(uw.y)}; const f32x4 g = u * (acc[h][db] + bsp); acc[h][db] = g;
                ss += (g[0] * g[0] + g[1] * g[1]) + (g[2] * g[2] + g[3] * g[3]); } }
        const float rB = __builtin_amdgcn_rsqf(quad_sum(ss) * (1.0f / SGU_W) + EPS);
#pragma unroll
        for (int h = 0; h < 4; ++h)
#pragma unroll
            for (int db = 0; db < 4; ++db) *(u32x2*)(mixrow + 512 + h * 64 + db * 16 + 4 * kq) = pk4(acc[h][db] * rB);
    }
    {
        f32x4 acc[4][4];
#pragma unroll
        for (int g = 0; g < 4; ++g)
#pragma unroll
            for (int db = 0; db < 4; ++db) acc[g][db] = (f32x4){0.f, 0.f, 0.f, 0.f};
        const bf16* wp = (const bf16*)(F.a->ws + WS_W + (size_t)l * LW + OW_POOL);
#pragma unroll
        for (int g = 0; g < 4; ++g) { const int win = 2 << g; const int cnt = (s + 1 < win) ? s + 1 : win; const float rc = 1.0f / (float)cnt;
#pragma unroll
            for (int ks = 0; ks < 2; ++ks) {
                const bf16* p0 = zrow + ZO_P + g * 64 + ks * 32 + kq * 8; float sum[8], cur[8];
                { const v4u pw = *(const v4u*)p0; const unsigned ww[4] = {pw.x, pw.y, pw.z, pw.w};
#pragma unroll
                  for (int j = 0; j < 4; ++j) { cur[2 * j] = bflo(ww[j]); cur[2 * j + 1] = bfhi(ww[j]); sum[2 * j] = cur[2 * j]; sum[2 * j + 1] = cur[2 * j + 1]; } }
                for (int jj = 1; jj < cnt; ++jj) { const v4u pw = *(const v4u*)(p0 - (size_t)jj * ZLD); const unsigned ww[4] = {pw.x, pw.y, pw.z, pw.w};
#pragma unroll
                  for (int j = 0; j < 4; ++j) { sum[2 * j] += bflo(ww[j]); sum[2 * j + 1] += bfhi(ww[j]); } }
                float mv[8];
#pragma unroll
                for (int j = 0; j < 8; ++j) mv[j] = sum[j] * rc - cur[j];
                const bf16x8 bfrag = pk8(mv);
#pragma unroll
                for (int db = 0; db < 4; ++db) { const bf16x8 a = *(const bf16x8*)(wp + (size_t)(g * 64 + db * 16 + tl) * 64 + ks * 32 + kq * 8); acc[g][db] = mfma16(a, bfrag, acc[g][db]); }
            } }
        float ss = 0.f;
#pragma unroll
        for (int g = 0; g < 4; ++g)
#pragma unroll
            for (int db = 0; db < 4; ++db) { const f32x4 y = acc[g][db] * *(const f32x4*)(IN_F(14) + l * POOL_W + g * 64 + db * 16 + 4 * kq); acc[g][db] = y;
                ss += (y[0] * y[0] + y[1] * y[1]) + (y[2] * y[2] + y[3] * y[3]); }
        const float rC = __builtin_amdgcn_rsqf(quad_sum(ss) * (1.0f / POOL_W) + EPS);
#pragma unroll
        for (int g = 0; g < 4; ++g)
#pragma unroll
            for (int db = 0; db < 4; ++db) *(u32x2*)(mixrow + 768 + g * 64 + db * 16 + 4 * kq) = pk4(acc[g][db] * rC);
    }
    __syncthreads();
}

__host__ __device__ constexpr int att_nsplit(int qb) {
#if defined(ATT_SPLIT) && ATT_SPLIT
    return (4 * (qb + 1) + 31) / 32;
#else
    return (void)qb, 1;
#endif
}
__device__ __forceinline__ void p4_combine(Frame& F) {
    const int gw = F.vcu * NWAVES + F.wave, NGW = F.G * NWAVES, lane = F.lane, h = lane >> 4, d0 = (lane & 15) * 8;
    constexpr float C2 = 1.4426950408889634f * attn::SCALE;
    const float2* ML = (const float2*)(F.a->ws + WS_ML);
    for (int m = gw; m < M; m += NGW) {
        const int b = m >> 13, s = m & (SEQ - 1), bh = b * NHEAD + h, nsp = att_nsplit(s >> 8);
        const size_t row = (size_t)bh * SEQ + s;
        float mi[4], li[4], mx = -3.0e38f;
#pragma unroll
        for (int i = 0; i < 4; ++i) if (i < nsp) { const float2 v = ML[(size_t)i * 8 * SEQ + row]; mi[i] = v.x; li[i] = v.y; mx = fmaxf(mx, v.x); }
        float a[8] = {0.f, 0.f, 0.f, 0.f, 0.f, 0.f, 0.f, 0.f}, wsum = 0.f;
#pragma unroll
        for (int i = 0; i < 4; ++i) if (i < nsp) { const float wgt = li[i] * __builtin_amdgcn_exp2f((mi[i] - mx) * C2); wsum += wgt;
            const v4u ow = *(const v4u*)(F.a->ws + opart_off(i) + (row * 128 + d0) * 2); const unsigned ww[4] = {ow.x, ow.y, ow.z, ow.w};
#pragma unroll
            for (int j = 0; j < 4; ++j) { a[2 * j] += wgt * bflo(ww[j]); a[2 * j + 1] += wgt * bfhi(ww[j]); } }
        const float rw = 1.0f / wsum; float ss = 0.f;
#pragma unroll
        for (int j = 0; j < 8; ++j) { a[j] *= rw; ss += a[j] * a[j]; }
        const float rA = __builtin_amdgcn_rsqf(wave_sum(ss) * (1.0f / 512.0f) + EPS);
#pragma unroll
        for (int j = 0; j < 8; ++j) a[j] *= rA;
        *(bf16x8*)(wsp(F, WS_MIX) + (size_t)m * DM + h * 128 + d0) = pk8(a);
    }
}

struct AttnSchedPaired {
    int bh, idx;
    __device__ __forceinline__ bool get(int i, attn::Item& it) const {
        if (idx >= 16 || i >= 2) return false;
        it.bh = bh; it.qb = (i == 0) ? idx : 31 - idx; it.jlo = 0; it.jhi = 4 * (it.qb + 1); it.chunk = 0; return true;
    }
};

__device__ __forceinline__ void grid_bar(const Frame& F) {
    XcdBarrier b; b.bar = (unsigned*)(F.a->ws + WS_CTL) + CW_BAR; b.x = xb_xcc_id(); b.st = (volatile LAS unsigned*)(F.lds + MISC_OFF) + 8;
    xcd_barrier(b);
}
__global__ void __launch_bounds__(NWAVES * 64, 2) hybrid_fwd(Args args_) {
    extern __shared__ __attribute__((aligned(16))) unsigned char lds[];
    (void)args_;
    const CAS Args* ap0 = (const CAS Args*)__builtin_amdgcn_kernarg_segment_ptr();
    { const int tid = threadIdx.x;
      for (int u = tid; u < (LDS_BYTES - LDSCTL_OFF) / 4; u += NWAVES * 64) ((LAS unsigned*)((LAS unsigned char*)lds + LDSCTL_OFF))[u] = 0u;
      __syncthreads();
      if (N_LAUNCHES == 1) (void)xcd_barrier_post((unsigned*)(ap0->ws + WS_CTL) + CW_BAR, (volatile LAS unsigned*)((LAS unsigned char*)lds + MISC_OFF) + 8); }
    const int p_lo = ap0->ph_lo;
#pragma unroll 1
    for (int p = p_lo;; ++p) {
        const CAS Args* ap = ap0; asm volatile("" : "+s"(ap));
        if (p >= ap->ph_hi) break;
        Frame F; F.lds = (LAS unsigned char*)lds; F.a = ap;
        { int tid = threadIdx.x; asm volatile("" : "+v"(tid)); F.lane = tid & 63; F.wave = __builtin_amdgcn_readfirstlane(tid >> 6); }
        F.G = gridDim.x; { const int bx = blockIdx.x; F.vcu = (F.G % 8 == 0) ? (bx % 8) * (F.G / 8) + bx / 8 : bx; }
        const int l = (p - 1) / PH_PER_LAYER, q = (p == 0) ? -1 : (p - 1) % PH_PER_LAYER;
        unsigned char* wl = F.a->ws + WS_W + (size_t)l * LW;
        if (q == -1) p0_prologue(F);
        else if (q == 0) {
            pg8::Gemm g{wsp(F, WS_XB), (const bf16*)(wl + OW_IN), M, ZLD, DM}; pg8::StaticOrder S; S.init(M, ZLD, F.G, (int)blockIdx.x);
            pg8::EpiScaleBf16 E{wsp(F, WS_Z), ZLD, ssq_mix(F, l), 1.0f / DM, EPS};
            pg8::gemm_phase<pg8::EpiScaleBf16, pg8::StaticOrder, true, true>(F.lds + RING_OFF, g, S, E);
        } else if (q == 1) {
            for (int u = F.vcu; u < M / CHUNK; u += F.G) p2_upproj_unit(F, l, u);
            for (int u = F.vcu + ((M / CHUNK - F.vcu + F.G - 1) / F.G) * F.G; u < 2 * (M / CHUNK); u += F.G) p2_sgu_pool_unit(F, l, u - M / CHUNK);
        } else if (q == 2) {
            const attn::Tensors AT{(const attn::bf16*)wsp(F, WS_Q), (const attn::bf16*)wsp(F, WS_K), (const attn::bf16*)wsp(F, WS_V), (attn::bf16*)(F.a->ws + opart_off(0)), (float2*)(F.a->ws + WS_ML)};
            const AttnSchedPaired S{(int)(blockIdx.x & 7), (int)(blockIdx.x >> 3)};
            attn::attn_phase<AttnSchedPaired>((char*)lds + RING_OFF, AT, S);
        } else if (q == 3) p4_combine(F);
        else if (q == 5) {
            pg8::Gemm g{wsp(F, WS_XB), (const bf16*)(wl + OW_GU), M, FF2, DM}; pg8::StaticOrder S; S.init(M, FF2, F.G, (int)blockIdx.x);
            pg8::EpiSwiglu E{wsp(F, WS_H), FF, ssq_ffn(F, l), 1.0f / DM, EPS};
            pg8::gemm_phase<pg8::EpiSwiglu, pg8::StaticOrder, true, true>(F.lds + RING_OFF, g, S, E);
        } else {
            const bool dn = q == 6, nx = l + 1 < DEPTH;
            pg8::Gemm g{dn ? wsp(F, WS_H) : wsp(F, WS_MIX), (const bf16*)(wl + (dn ? OW_DN : OW_OUT)), M, DM, dn ? FF : DM}; pg8::StaticOrder S; S.init(M, DM, F.G, (int)blockIdx.x);
            pg8::EpiResid E{(!dn && l == 0) ? (const float*)F.a->in[0] : (const float*)F.a->out, F.a->out, (dn && !nx) ? nullptr : wsp(F, WS_XB), dn ? (nx ? ssq_mix(F, l + 1) : nullptr) : ssq_ffn(F, l), DM};
            pg8::gemm_phase<pg8::EpiResid, pg8::StaticOrder, true, true>(F.lds + RING_OFF, g, S, E);
        }
        if (N_LAUNCHES == 1 && p + 1 < F.a->ph_hi) grid_bar(F);
    }
}

extern "C" void kernel_launch(void* const* d_in, const int* in_sizes, int n_in, void* d_out, int out_size, void* d_ws, size_t ws_size, hipStream_t stream) {
    static int grid = 0;
    if (grid == 0) {
        if (n_in != 23 || in_sizes[0] != M * DM || out_size != M * DM || ws_size < WS_END) { fprintf(stderr, "kernel_launch: shape mismatch (n_in %d, in0 %d, out %d, ws %zu)\n", n_in, n_in > 0 ? in_sizes[0] : -1, out_size, ws_size); grid = -1; return; }
        int dev = 0, cus = 0, per_cu = 0;
        if (hipGetDevice(&dev) != hipSuccess || hipDeviceGetAttribute(&cus, hipDeviceAttributeMultiprocessorCount, dev) != hipSuccess) { fprintf(stderr, "kernel_launch: device query failed\n"); grid = -1; return; }
        if (hipFuncSetAttribute((const void*)hybrid_fwd, hipFuncAttributeMaxDynamicSharedMemorySize, LDS_BYTES) != hipSuccess) { fprintf(stderr, "kernel_launch: hipFuncSetAttribute failed\n"); grid = -1; return; }
        if (hipOccupancyMaxActiveBlocksPerMultiprocessor(&per_cu, (const void*)hybrid_fwd, NWAVES * 64, LDS_BYTES) != hipSuccess || per_cu < 1)
            fprintf(stderr, "kernel_launch: note: occupancy query reports %d workgroups per CU\n", per_cu);
        (void)hipGetLastError();
        grid = cus;
        if (grid != 256) fprintf(stderr, "kernel_launch: note: %d CUs (tuned for 256)\n", grid);
    }
    if (grid < 0) return;
    if (hipMemsetAsync((char*)d_ws + WS_CTL, 0, CTL_ZERO_BYTES, stream) != hipSuccess) { fprintf(stderr, "kernel_launch: hipMemsetAsync failed\n"); return; }
    Args a{};
    for (int i = 0; i < 23; ++i) a.in[i] = (const float*)d_in[i];
    a.out = (float*)d_out; a.ws = (unsigned char*)d_ws;
    for (int li = 0; li < N_LAUNCHES; ++li) {
        a.ph_lo = (N_LAUNCHES == 1) ? 0 : li; a.ph_hi = (N_LAUNCHES == 1) ? NPH : li + 1; a.li = li;
        hipLaunchKernelGGL(hybrid_fwd, dim3(grid), dim3(NWAVES * 64), LDS_BYTES, stream, a);
        const hipError_t le = hipPeekAtLastError();
        if (le != hipSuccess) { fprintf(stderr, "kernel_launch: launch %d failed: %s\n", li, hipGetErrorName(le)); break; }
    }
}
```

```cpp
#include <hip/hip_runtime.h>
#include <hip/hip_bf16.h>
#include <cstdio>
#include <cstdint>
#ifndef PG8_WGM
#define PG8_WGM 8
#endif

namespace pg8 {
#define PG8_LAS __attribute__((address_space(3)))
typedef unsigned short bf16_t;
typedef short bf16x8 __attribute__((ext_vector_type(8)));
typedef float f32x4 __attribute__((ext_vector_type(4)));
typedef unsigned u32x4 __attribute__((ext_vector_type(4)));
constexpr int BM = 256, BK = 64, HALF = 128, HTB = HALF * BK * 2  , STAGE_BYTES = 8 * HTB, NXCD = 8, WGM = PG8_WGM;

__host__ __device__ __forceinline__ int lds_byte(int r, int c) { const int st = (r >> 4) * 2 + (c >> 5), rr = r & 15, cc = c & 31, ob = rr * 64 + cc * 2; return st * 1024 + (ob ^ (((ob >> 9) & 1) << 5)); }
__host__ __device__ __forceinline__ void stage_rc(int b, int& R, int& C) { const int st = b / 1024, sb = b % 1024, swz = sb ^ (((sb >> 9) & 1) << 5); R = (st >> 1) * 16 + swz / 64; C = (st & 1) * 32 + (swz % 64) / 2; }
__host__ __device__ __forceinline__ int perm32(int rho) { const int n = rho >> 4, i = rho & 15; return 8 * (i >> 2) + 4 * n + (i & 3); }

struct Unit { int pm, pn; };
struct Gemm { const bf16_t* A; const bf16_t* Bt; int M, N, K; };

struct StaticOrder {
    int nM, nN, nwg, G, c;
    __host__ __device__ void init(int M, int N, int G_, int c_) { nM = M / BM; nN = N / BM; nwg = nM * nN; G = G_; c = c_; }
    __host__ __device__ bool next(int i, Unit& u) const {
        const long L = (long)i * G + c; if (L >= nwg) return false;
        int wgid = (int)L; { const int q = nwg / NXCD, r = nwg % NXCD, xcd = wgid % NXCD, off = wgid / NXCD; wgid = (xcd < r ? xcd * (q + 1) : r * (q + 1) + (xcd - r) * q) + off; }
        const int nig = WGM * nN, gid = wgid / nig, fm = gid * WGM, gsz = (nM - fm) < WGM ? (nM - fm) : WGM;
        u.pm = fm + ((wgid % nig) % gsz); u.pn = (wgid % nig) / gsz; return true;
    }
    __device__ __forceinline__ void a_ready(const Unit&) const {}
    __device__ __forceinline__ void done(const Unit&) const {}
};


__device__ __forceinline__ unsigned cvt_pk_bf16(float lo, float hi) { unsigned r; asm volatile("v_cvt_pk_bf16_f32 %0, %1, %2" : "=v"(r) : "v"(lo), "v"(hi)); return r; }
typedef float f32x2 __attribute__((ext_vector_type(2)));

typedef unsigned u32x2 __attribute__((ext_vector_type(2)));
#ifndef EPI_WT
#define EPI_WT 0
#endif
#ifndef RESID_FENCE
#define RESID_FENCE(m) ((m) & 1)
#endif
#ifndef EPI_PRE
#define EPI_PRE true
#endif
__device__ __forceinline__ void st16(void* p, u32x4 v) {
#if EPI_WT
    asm volatile("global_store_dwordx4 %0, %1, off sc1\n\ts_nop 1" :: "v"(p), "v"(v) : "memory");
#else
    *(u32x4*)p = v;
#endif
}
__device__ __forceinline__ void st16f(void* p, f32x4 v) { st16(p, __builtin_bit_cast(u32x4, v)); }
__device__ __forceinline__ void st8(void* p, u32x2 v) {
#if EPI_WT
    asm volatile("global_store_dwordx2 %0, %1, off sc1\n\ts_nop 1" :: "v"(p), "v"(v) : "memory");
#else
    *(u32x2*)p = v;
#endif
}
struct EpiScaleBf16 {
    static constexpr bool PERM = true, AFTER_DRAIN = false, PRE = EPI_PRE;
    bf16_t* O; int ldc; const float* ssq; float inv_n, eps;
    __device__ __forceinline__ void operator()(const f32x4 (&acc)[2][2][4][2], const Unit& u, int wr, int wc, int fr, int fq, const PG8_LAS float* ssl = nullptr) const {
        const int row0 = u.pm * BM + wr * 64 + fr, col0 = u.pn * BM + wc * 32 + 8 * fq;
        float rr[2][4];
#pragma unroll
        for (int ai = 0; ai < 2; ++ai)
#pragma unroll
            for (int m = 0; m < 4; ++m) rr[ai][m] = PRE ? ssl[wr * 64 + fr + ai * HALF + m * 16] : ssq[row0 + ai * HALF + m * 16];
#pragma unroll
        for (int ai = 0; ai < 2; ++ai)
#pragma unroll
            for (int m = 0; m < 4; ++m) { const int row = row0 + ai * HALF + m * 16; const float r = __builtin_amdgcn_rsqf(rr[ai][m] * inv_n + eps); bf16_t* rowp = O + (size_t)row * ldc + col0;
#pragma unroll
                for (int bj = 0; bj < 2; ++bj) { const f32x4 v0 = acc[ai][bj][m][0] * r, v1 = acc[ai][bj][m][1] * r;
                    u32x4 w; w.x = cvt_pk_bf16(v0[0], v0[1]); w.y = cvt_pk_bf16(v0[2], v0[3]); w.z = cvt_pk_bf16(v1[0], v1[1]); w.w = cvt_pk_bf16(v1[2], v1[3]);
                    st16(rowp + bj * HALF, w); } }
    }
};
struct EpiSwiglu {
    static constexpr bool PERM = true, AFTER_DRAIN = false, PRE = EPI_PRE;
    bf16_t* H; int ldh; const float* ssq; float inv_n, eps;
    __device__ __forceinline__ static float swi(float g, float u) { return g * __builtin_amdgcn_rcpf(1.0f + __builtin_amdgcn_exp2f(g * -1.4426950408889634f)) * u; }
    __device__ __forceinline__ void operator()(const f32x4 (&acc)[2][2][4][2], const Unit& u, int wr, int wc, int fr, int fq, const PG8_LAS float* ssl = nullptr) const {
        const int row0 = u.pm * BM + wr * 64 + fr, col0 = u.pn * HALF + wc * 32 + 8 * fq;
#ifdef PROBE_DRYEPI
        if (!H) { asm volatile("" :: "v"(acc[0][0][0][0]), "v"(acc[1][1][3][1])); return; }
#endif
        float rr[2][4];
#pragma unroll
        for (int ai = 0; ai < 2; ++ai)
#pragma unroll
            for (int m = 0; m < 4; ++m) rr[ai][m] = PRE ? ssl[wr * 64 + fr + ai * HALF + m * 16] : ssq[row0 + ai * HALF + m * 16];
#pragma unroll
        for (int ai = 0; ai < 2; ++ai)
#pragma unroll
            for (int m = 0; m < 4; ++m) { const int row = row0 + ai * HALF + m * 16; const float r = __builtin_amdgcn_rsqf(rr[ai][m] * inv_n + eps);
                const f32x4 g0 = acc[ai][0][m][0] * r, g1 = acc[ai][0][m][1] * r, u0 = acc[ai][1][m][0] * r, u1 = acc[ai][1][m][1] * r;
                u32x4 w; w.x = cvt_pk_bf16(swi(g0[0], u0[0]), swi(g0[1], u0[1])); w.y = cvt_pk_bf16(swi(g0[2], u0[2]), swi(g0[3], u0[3]));
                w.z = cvt_pk_bf16(swi(g1[0], u1[0]), swi(g1[1], u1[1])); w.w = cvt_pk_bf16(swi(g1[2], u1[2]), swi(g1[3], u1[3]));
                st16(H + (size_t)row * ldh + col0, w); }
    }
};
struct EpiResid {
    static constexpr bool PERM = true, AFTER_DRAIN = false, PRE = false;
    const bf16_t* base16; float* out; bf16_t* xb; float* ssq; int ldc;
    __device__ __forceinline__ void operator()(const f32x4 (&acc)[2][2][4][2], const Unit& u, int wr, int wc, int fr, int fq) const {
        const int row0 = u.pm * BM + wr * 64 + fr, col0 = u.pn * BM + wc * 32 + 8 * fq;
#pragma unroll
        for (int ai = 0; ai < 2; ++ai) {
            u32x4 bw[4][2];
#pragma unroll
            for (int m = 0; m < 4; ++m)
#pragma unroll
                for (int bj = 0; bj < 2; ++bj) bw[m][bj] = *(const u32x4*)(base16 + (size_t)(row0 + ai * HALF + m * 16) * ldc + col0 + bj * HALF);
            asm volatile("" ::: "memory");
#pragma unroll
            for (int m = 0; m < 4; ++m) { const int row = row0 + ai * HALF + m * 16; const size_t off = (size_t)row * ldc + col0; float s = 0.f;
#pragma unroll
                for (int bj = 0; bj < 2; ++bj) { const u32x4 w4 = bw[m][bj];
                    f32x4 o0 = (f32x4){__builtin_bit_cast(float, w4.x << 16), __builtin_bit_cast(float, w4.x & 0xffff0000u), __builtin_bit_cast(float, w4.y << 16), __builtin_bit_cast(float, w4.y & 0xffff0000u)};
                    f32x4 o1 = (f32x4){__builtin_bit_cast(float, w4.z << 16), __builtin_bit_cast(float, w4.z & 0xffff0000u), __builtin_bit_cast(float, w4.w << 16), __builtin_bit_cast(float, w4.w & 0xffff0000u)};
                    o0 = o0 + acc[ai][bj][m][0]; o1 = o1 + acc[ai][bj][m][1];
                    if (out) { *(f32x4*)(out + off + bj * HALF) = o0; *(f32x4*)(out + off + bj * HALF + 4) = o1; }
                    s += ((o0[0] * o0[0] + o0[1] * o0[1]) + (o0[2] * o0[2] + o0[3] * o0[3])) + ((o1[0] * o1[0] + o1[1] * o1[1]) + (o1[2] * o1[2] + o1[3] * o1[3]));
                    if (xb) { u32x4 w; w.x = cvt_pk_bf16(o0[0], o0[1]); w.y = cvt_pk_bf16(o0[2], o0[3]); w.z = cvt_pk_bf16(o1[0], o1[1]); w.w = cvt_pk_bf16(o1[2], o1[3]); *(u32x4*)(xb + off + bj * HALF) = w; } }
                if (ssq) { s += __shfl_xor(s, 16); s += __shfl_xor(s, 32); if (fq == 0) atomicAdd(ssq + row, s); } }
            asm volatile("" ::: "memory");
        }
    }
};


template <class Epi, class Sched, bool ALIGN_EPI = false, bool SP2 = false>
__device__ __forceinline__ void gemm_phase(PG8_LAS unsigned char* lds, const Gemm g, const Sched& S, const Epi& E) {
    int tid_ = threadIdx.x; asm volatile("" : "+v"(tid_));
    const int tid = tid_, wid = __builtin_amdgcn_readfirstlane(tid >> 6), lane = tid & 63, wr = wid >> 2, wc = wid & 3, fr = lane & 15, fq = lane >> 4;
    const int K = g.K, nt = K / BK;
    unsigned voffA[2], voffB[2];
#pragma unroll
    for (int i = 0; i < 2; ++i) { int R, C; stage_rc(tid * 16 + i * 8192, R, C); const int Rb = Epi::PERM ? ((R & ~31) + perm32(R & 31)) : R;
        voffA[i] = (unsigned)(R * K + C) * 2u; voffB[i] = (unsigned)(Rb * K + C) * 2u; }
    const size_t kstep = (size_t)(BK * 2);
    const size_t hstep = (size_t)HALF * K * 2;
    const size_t tstep = 2 * hstep;
    const unsigned ldsw = (unsigned)wid * 1024u;
    const int aoff = lds_byte(wr * 64 + fr, fq * 8), boff = lds_byte(wc * 32 + fr, fq * 8);
#define PG8_SA(b, h) (((b) * 2 + (h)) * HTB)
#define PG8_SB(b, h) ((4 + (b) * 2 + (h)) * HTB)
#define PG8_STAGE(bufoff, gbase, voff) do { _Pragma("unroll") for (int _i = 0; _i < 2; ++_i) \
        __builtin_amdgcn_global_load_lds((const unsigned*)((const char*)(gbase) + (voff)[_i]), (PG8_LAS unsigned*)(lds + (bufoff) + ldsw + _i * 8192), 16, 0, 0); } while (0)
#define PG8_LDA(dst, b, h) do { _Pragma("unroll") for (int m = 0; m < 4; ++m) _Pragma("unroll") for (int k = 0; k < 2; ++k) dst[m][k] = *(const PG8_LAS bf16x8*)(lds + PG8_SA(b, h) + aoff + m * 2048 + k * 1024); } while (0)
#define PG8_LDB(dst, b, h) do { _Pragma("unroll") for (int n = 0; n < 2; ++n) _Pragma("unroll") for (int k = 0; k < 2; ++k) dst[n][k] = *(const PG8_LAS bf16x8*)(lds + PG8_SB(b, h) + boff + n * 2048 + k * 1024); } while (0)
#ifdef PROBE_NOMMA
#define PG8_MMA_ON (g.M != 0)
#else
#define PG8_MMA_ON true
#endif
#define PG8_MMA(ai, bj, At, Bt) do { if (!PG8_MMA_ON) break; __builtin_amdgcn_s_setprio(1); _Pragma("unroll") for (int m = 0; m < 4; ++m) _Pragma("unroll") for (int n = 0; n < 2; ++n) _Pragma("unroll") for (int k = 0; k < 2; ++k) \
        acc[ai][bj][m][n] = __builtin_amdgcn_mfma_f32_16x16x32_bf16(Bt[n][k], At[m][k], acc[ai][bj][m][n], 0, 0, 0); __builtin_amdgcn_s_setprio(0); } while (0)
#define PG8_WAIT_V(n) asm volatile("s_waitcnt vmcnt(" #n ")" ::: "memory")
#define PG8_WAIT_L(n) asm volatile("s_waitcnt lgkmcnt(" #n ")" ::: "memory")
#define PG8_BAR __builtin_amdgcn_s_barrier()
#define PG8_SCHED __builtin_amdgcn_sched_barrier(0)
    PG8_LAS unsigned char* const ssl_base = lds + STAGE_BYTES;
#define PG8_PRE(u, i) do { if constexpr (Epi::PRE) __builtin_amdgcn_global_load_lds((const unsigned*)(E.ssq + (size_t)(u).pm * BM + (wid & 3) * 64 + lane), \
        (PG8_LAS unsigned*)(ssl_base + ((i) & 1) * 2048 + wid * 256), 4, 0, 0); } while (0)
    Unit cur, nxt; int ui = 0;
    if (!S.next(0, cur)) return;
    f32x4 acc[2][2][4][2];
#pragma unroll
    for (int a = 0; a < 2; ++a)
#pragma unroll
        for (int b = 0; b < 2; ++b)
#pragma unroll
            for (int m = 0; m < 4; ++m)
#pragma unroll
                for (int n = 0; n < 2; ++n) acc[a][b][m][n] = (f32x4){0.f, 0.f, 0.f, 0.f};
    bf16x8 At[4][2], B0[2][2], B1[2][2];
    const char* cA = (const char*)g.A + (size_t)cur.pm * tstep; const char* cB = (const char*)g.Bt + (size_t)cur.pn * tstep;
    S.a_ready(cur);
    PG8_PRE(cur, 0);
    if constexpr (SP2) {
        PG8_STAGE(PG8_SB(0, 0), cB, voffB); PG8_STAGE(PG8_SB(0, 1), cB + hstep, voffB); PG8_STAGE(PG8_SA(0, 0), cA, voffA); PG8_STAGE(PG8_SA(0, 1), cA + hstep, voffA);
        if (wr == 1) PG8_BAR;
        PG8_WAIT_V(2); PG8_BAR;
        PG8_STAGE(PG8_SB(1, 0), cB + kstep, voffB); PG8_STAGE(PG8_SA(1, 0), cA + kstep, voffA); PG8_STAGE(PG8_SB(1, 1), cB + hstep + kstep, voffB);
        PG8_WAIT_V(6); PG8_BAR;
    } else {
        PG8_STAGE(PG8_SB(0, 0), cB, voffB); PG8_STAGE(PG8_SA(0, 0), cA, voffA); PG8_STAGE(PG8_SB(0, 1), cB + hstep, voffB); PG8_STAGE(PG8_SA(0, 1), cA + hstep, voffA);
        if (wr == 1) PG8_BAR;
        PG8_WAIT_V(4); PG8_BAR;
        PG8_STAGE(PG8_SB(1, 0), cB + kstep, voffB); PG8_STAGE(PG8_SA(1, 0), cA + kstep, voffA); PG8_STAGE(PG8_SB(1, 1), cB + hstep + kstep, voffB);
        PG8_WAIT_V(6); PG8_BAR;
    }
    for (;;) {
        const bool has_next = S.next(ui + 1, nxt);
        const char* nA = has_next ? (const char*)g.A + (size_t)nxt.pm * tstep : cA; const char* nB = has_next ? (const char*)g.Bt + (size_t)nxt.pn * tstep : cB;
        for (int t = 0; t < nt; t += 2) {
            const bool last = (t == nt - 2);
            const char* a1 = cA + (size_t)(t + 1) * kstep;
            const char* a2 = last ? nA : cA + (size_t)(t + 2) * kstep; const char* b2 = last ? nB : cB + (size_t)(t + 2) * kstep;
            const char* a3 = a2 + kstep; const char* b3 = b2 + kstep;
            if (last && has_next) S.a_ready(nxt);
            if constexpr (SP2) {
            PG8_LDB(B0, 0, 0); PG8_LDB(B1, 0, 1); PG8_SCHED; PG8_LDA(At, 0, 0); PG8_STAGE(PG8_SA(1, 1), a1 + hstep, voffA);
            PG8_WAIT_V(8); PG8_WAIT_L(0); PG8_BAR; PG8_MMA(0, 0, At, B0); PG8_MMA(0, 1, At, B1); PG8_BAR; PG8_SCHED;
            PG8_LDA(At, 0, 1); PG8_STAGE(PG8_SB(0, 0), b2, voffB); PG8_STAGE(PG8_SB(0, 1), b2 + hstep, voffB); PG8_STAGE(PG8_SA(0, 0), a2, voffA);
            PG8_WAIT_V(8); PG8_WAIT_L(0); PG8_BAR; PG8_MMA(1, 0, At, B0); PG8_MMA(1, 1, At, B1); PG8_BAR; PG8_SCHED;
            PG8_LDB(B0, 1, 0); PG8_LDB(B1, 1, 1); PG8_SCHED; PG8_LDA(At, 1, 0); PG8_STAGE(PG8_SA(0, 1), a2 + hstep, voffA);
            PG8_WAIT_V(8); PG8_WAIT_L(0); PG8_BAR; PG8_MMA(0, 0, At, B0); PG8_MMA(0, 1, At, B1); PG8_BAR; PG8_SCHED;
            PG8_LDA(At, 1, 1); PG8_STAGE(PG8_SB(1, 0), b3, voffB); PG8_STAGE(PG8_SB(1, 1), b3 + hstep, voffB); PG8_STAGE(PG8_SA(1, 0), a3, voffA);
            PG8_WAIT_V(8); PG8_WAIT_L(0); PG8_BAR; PG8_MMA(1, 0, At, B0); PG8_MMA(1, 1, At, B1); PG8_BAR; PG8_SCHED;
            } else {
            PG8_LDB(B0, 0, 0); PG8_SCHED; PG8_LDA(At, 0, 0); PG8_STAGE(PG8_SA(1, 1), a1 + hstep, voffA);
            PG8_WAIT_L(8); PG8_BAR; PG8_WAIT_L(0); PG8_MMA(0, 0, At, B0); PG8_BAR; PG8_SCHED;
            PG8_LDB(B1, 0, 1); PG8_STAGE(PG8_SB(0, 0), b2, voffB);
            PG8_BAR; PG8_WAIT_L(0); PG8_MMA(0, 1, At, B1); PG8_BAR;
            PG8_LDA(At, 0, 1); PG8_STAGE(PG8_SA(0, 0), a2, voffA);
            PG8_BAR; PG8_WAIT_L(0); PG8_MMA(1, 0, At, B0); PG8_BAR; PG8_SCHED;
            PG8_STAGE(PG8_SB(0, 1), b2 + hstep, voffB);
            PG8_WAIT_V(6); PG8_BAR; PG8_MMA(1, 1, At, B1); PG8_BAR;
            PG8_LDB(B0, 1, 0); PG8_SCHED; PG8_LDA(At, 1, 0); PG8_STAGE(PG8_SA(0, 1), a2 + hstep, voffA);
            PG8_WAIT_L(8); PG8_BAR; PG8_WAIT_L(0); PG8_MMA(0, 0, At, B0); PG8_BAR; PG8_SCHED;
            PG8_LDB(B1, 1, 1); PG8_STAGE(PG8_SB(1, 0), b3, voffB);
            PG8_BAR; PG8_WAIT_L(0); PG8_MMA(0, 1, At, B1); PG8_BAR;
            PG8_LDA(At, 1, 1); PG8_STAGE(PG8_SA(1, 0), a3, voffA);
            PG8_BAR; PG8_WAIT_L(0); PG8_MMA(1, 0, At, B0); PG8_BAR; PG8_SCHED;
            PG8_STAGE(PG8_SB(1, 1), b3 + hstep, voffB);
            PG8_WAIT_V(6); PG8_BAR; PG8_MMA(1, 1, At, B1); PG8_BAR;
            }
        }
        if constexpr (ALIGN_EPI) { if (wr == 0) PG8_BAR; }
        if constexpr (Epi::PRE) { E(acc, cur, wr, wc, fr, fq, (const PG8_LAS float*)(ssl_base + (ui & 1) * 2048)); S.done(cur); }
        else if constexpr (!Epi::AFTER_DRAIN) { E(acc, cur, wr, wc, fr, fq); S.done(cur); }
        if (!has_next) break;
#pragma unroll
        for (int a = 0; a < 2; ++a)
#pragma unroll
            for (int b = 0; b < 2; ++b)
#pragma unroll
                for (int m = 0; m < 4; ++m)
#pragma unroll
                    for (int n = 0; n < 2; ++n) acc[a][b][m][n] = (f32x4){0.f, 0.f, 0.f, 0.f};
        cur = nxt; cA = nA; cB = nB; ++ui;
        PG8_PRE(cur, ui);
        if constexpr (ALIGN_EPI) { if (wr == 1) PG8_BAR; }
    }
    PG8_WAIT_V(0);
    if constexpr (!ALIGN_EPI) { if (wr == 0) PG8_BAR; }
    PG8_BAR;
    if constexpr (Epi::AFTER_DRAIN) { E.fused(acc, cur, wr, wc, fr, fq, lds, wid, lane); S.done(cur); }
#undef PG8_SA
#undef PG8_SB
#undef PG8_STAGE
#undef PG8_LDA
#undef PG8_LDB
#undef PG8_MMA
#undef PG8_WAIT_V
#undef PG8_WAIT_L
#undef PG8_BAR
#undef PG8_SCHED
#undef PG8_PRE
}
}

namespace attn {
constexpr int D = 128, NQD = 6;
constexpr float THR = 8.f;
#ifndef ATT_WSKIP
#define ATT_WSKIP false
#endif
constexpr bool WSKIP = ATT_WSKIP;
constexpr float SCALE = 0.10206207261596575f;
constexpr int NW = 8, QBLK = 32, KVBLK = 64, QB = NW * QBLK;
constexpr int SHM_V = KVBLK * D * 2, SHM_K = KVBLK * D * 2;
constexpr int LDS_BYTES = 2 * SHM_V + 2 * SHM_K + NW * 64 * 4;

using bf16 = __hip_bfloat16;
typedef short bf16x8 __attribute__((ext_vector_type(8)));
typedef short s16x4 __attribute__((ext_vector_type(4)));
typedef float f32x16 __attribute__((ext_vector_type(16)));
typedef float f32x4 __attribute__((ext_vector_type(4)));
typedef unsigned u32x4 __attribute__((ext_vector_type(4)));
template <class A, class Bt> struct same_t { static constexpr bool v = false; };
template <class A> struct same_t<A, A> { static constexpr bool v = true; };

#define KSWZ(row, colB) ((row) * 256 + ((colB) ^ (((row) & 7) << 4)))
#define SBAR() __builtin_amdgcn_sched_barrier(0)
__device__ __forceinline__ int v_st(int k, int c) { const int kk = (k & ~0xC) | ((k & 4) << 1) | ((k & 8) >> 1); return ((kk >> 3) * 4 + (c >> 5)) * 512 + ((kk & 7) * 32 + (c & 31)) * 2; }
__device__ __forceinline__ int v_rd_base(int lane) { return ((lane & 3) << 3) | (((lane >> 2) & 3) << 6) | (((lane >> 4) & 1) << 5) | (((lane >> 5) & 1) << 8); }
constexpr int v_rd_off(int d0, int ks, int half) { return d0 * 512 + ks * 4096 + half * 2048; }
__device__ __forceinline__ int crow(int r, int hi) { return (r & 3) + 8 * (r >> 2) + 4 * hi; }
__device__ __forceinline__ unsigned cvtpk(float lo, float hi) {
    unsigned r; asm volatile("v_cvt_pk_bf16_f32 %0, %1, %2" : "=v"(r) : "v"(lo), "v"(hi)); return r;
}
__device__ __forceinline__ bf16x8 pack8(f32x4 a, f32x4 b) {
    u32x4 w = {cvtpk(a[0], a[1]), cvtpk(a[2], a[3]), cvtpk(b[0], b[1]), cvtpk(b[2], b[3])};
    return *reinterpret_cast<bf16x8*>(&w);
}
template <class T> __device__ __forceinline__ bf16x8 load8(const T* p) {
    if constexpr (same_t<T, float>::v) { return pack8(*(const f32x4*)p, *(const f32x4*)(p + 4)); }
    else { return *reinterpret_cast<const bf16x8*>(p); }
}
__device__ __forceinline__ void mask_tile(f32x16& p0, f32x16& p1, int dq, unsigned W) {
    const float NEG = -__builtin_inff();
#pragma unroll
    for (int r = 0; r < 16; ++r) {
        const int c = (r & 3) + 8 * (r >> 2);
        if ((unsigned)(dq - c) >= W) p0[r] = NEG;
        if ((unsigned)(dq - c - 32) >= W) p1[r] = NEG;
    }
}
__device__ __forceinline__ void partialSM(f32x16& p0, f32x16& p1, float& m_reg, float& mn, float& alpha, float cshift) {
    (void)m_reg; mn = 0.f; alpha = 1.f;
    if (__builtin_expect(cshift != 0.f, 0)) { for (int r = 0; r < 16; ++r) { p0[r] -= cshift; p1[r] -= cshift; } }
    for (int r = 0; r < 16; ++r) p0[r] = __builtin_amdgcn_exp2f(p0[r]);
}
__device__ __forceinline__ void finishSM(f32x16& p0, f32x16& p1, float alpha, float& l_reg, bf16x8& pa0, bf16x8& pa1, bf16x8& pa2, bf16x8& pa3) {
    for (int r = 0; r < 16; ++r) p1[r] = __builtin_amdgcn_exp2f(p1[r]);
    float ps = 0; for (int r = 0; r < 16; ++r) ps += p0[r]; for (int r = 0; r < 16; ++r) ps += p1[r];
    { auto rr = __builtin_amdgcn_permlane32_swap(__float_as_uint(ps), __float_as_uint(ps), false, false);
      ps = __uint_as_float(rr[0]) + __uint_as_float(rr[1]); }
    l_reg += ps; (void)alpha;
#define PK4(P, B_, OUT) do { unsigned a0 = cvtpk(P[B_+0], P[B_+1]), a1 = cvtpk(P[B_+2], P[B_+3]);                          \
        unsigned b0 = cvtpk(P[B_+4], P[B_+5]), b1 = cvtpk(P[B_+6], P[B_+7]);                                             \
        auto r0 = __builtin_amdgcn_permlane32_swap(a0, b0, false, false); auto r1 = __builtin_amdgcn_permlane32_swap(a1, b1, false, false); \
        u32x4 w = {r0[0], r1[0], r0[1], r1[1]}; OUT = *reinterpret_cast<bf16x8*>(&w); } while (0)
    PK4(p0, 0, pa0); PK4(p0, 8, pa1); PK4(p1, 0, pa2); PK4(p1, 8, pa3);
#undef PK4
}
template <int KB, bool SK>
__device__ __forceinline__ void qkt(f32x16& p0, f32x16& p1, const char* K_lds, int r32, int hi, const bf16x8* qr, bool act) {
    if (SK && !act) { const float NEG = -__builtin_inff();
#pragma unroll
        for (int r = 0; r < 16; ++r) { p0[r] = NEG; p1[r] = NEG; } return; }
    p0 = f32x16{}; p1 = f32x16{};
    const char* kb[4];
#pragma unroll
    for (int dd = 0; dd < 4; ++dd) kb[dd] = K_lds + KB * SHM_K + KSWZ(r32, (dd * 16 + hi * 8) * 2);
#pragma unroll
    for (int d0 = 0; d0 < NQD; ++d0) { const char* a = kb[d0 & 3] + (d0 >> 2) * 128;
        bf16x8 b0 = *reinterpret_cast<const bf16x8*>(a);
        bf16x8 b1 = *reinterpret_cast<const bf16x8*>(a + 32 * 256);
        p0 = __builtin_amdgcn_mfma_f32_32x32x16_bf16(b0, qr[d0], p0, 0, 0, 0);
        p1 = __builtin_amdgcn_mfma_f32_32x32x16_bf16(b1, qr[d0], p1, 0, 0, 0); }
}
template <int VB, bool SK>
__device__ __forceinline__ void pv_tile(f32x16* o, int vb0, bf16x8 pa0, bf16x8 pa1, bf16x8 pa2, bf16x8 pa3, bool act) {
    if (SK && !act) return;
#define TRRD(dst, off) asm volatile("ds_read_b64_tr_b16 %0, %1 offset:%2" : "=&v"(dst) : "v"(vb0), "i"(off) : "memory")
#define PV_D0(d0) do { s16x4 l0, l1, l2, l3, h0, h1, h2, h3; constexpr int b_ = VB * SHM_V + v_rd_off(d0, 0, 0);     \
        TRRD(l0, b_); TRRD(h0, b_ + 2048); TRRD(l1, b_ + 4096); TRRD(h1, b_ + 6144); TRRD(l2, b_ + 8192); TRRD(h2, b_ + 10240); TRRD(l3, b_ + 12288); TRRD(h3, b_ + 14336); \
        asm volatile("s_waitcnt lgkmcnt(0)" ::: "memory"); SBAR();                 \
        o[d0] = __builtin_amdgcn_mfma_f32_32x32x16_bf16(pa0, (bf16x8){l0[0], l0[1], l0[2], l0[3], h0[0], h0[1], h0[2], h0[3]}, o[d0], 0, 0, 0);   \
        o[d0] = __builtin_amdgcn_mfma_f32_32x32x16_bf16(pa1, (bf16x8){l1[0], l1[1], l1[2], l1[3], h1[0], h1[1], h1[2], h1[3]}, o[d0], 0, 0, 0);   \
        o[d0] = __builtin_amdgcn_mfma_f32_32x32x16_bf16(pa2, (bf16x8){l2[0], l2[1], l2[2], l2[3], h2[0], h2[1], h2[2], h2[3]}, o[d0], 0, 0, 0);   \
        o[d0] = __builtin_amdgcn_mfma_f32_32x32x16_bf16(pa3, (bf16x8){l3[0], l3[1], l3[2], l3[3], h3[0], h3[1], h3[2], h3[3]}, o[d0], 0, 0, 0); } while (0)
    PV_D0(0); PV_D0(1); PV_D0(2); PV_D0(3);
#undef PV_D0
#undef TRRD
}

template <class TIn, class TOut> struct BlockRef { const TIn* Q; const TIn* K; const TIn* V; TOut* O; float2* ML; int P0; int jlo; int jhi; float cshift; };
template <class TIn> struct Seam {
    bf16x8 qr[NQD];
    bf16x8 st_v0, st_v1, st_k0, st_k1; f32x4 sf0, sf1, sf2, sf3;
    f32x4 tq[1];
};
__device__ __forceinline__ int swa_jlo(int P0, int W) { const int lowk = P0 - W + 1; return lowk > 0 ? lowk / KVBLK : 0; }
#define ROW(p, k0, rr) ((p) + (size_t)((k0) + (rr)) * D + sc)
#define VMW() asm volatile("s_waitcnt vmcnt(0)" ::: "memory")
#define VMWN(n) asm volatile("s_waitcnt vmcnt(%0)" :: "i"(n) : "memory")
#define SLOAD_H(Kp, Vp, k0) do { S.st_v0 = load8<TIn>(ROW(Vp, k0, sr)); S.st_v1 = load8<TIn>(ROW(Vp, k0, 32 + sr));              \
                         S.st_k0 = load8<TIn>(ROW(Kp, k0, sr)); S.st_k1 = load8<TIn>(ROW(Kp, k0, 32 + sr)); } while (0)
#define SWRITE_HK(bf) do { *(bf16x8*)(K_lds + (bf) * SHM_K + kws) = S.st_k0; *(bf16x8*)(K_lds + (bf) * SHM_K + kws + 32 * 256) = S.st_k1; } while (0)
#define SWRITE_HV(bf) do { *(bf16x8*)(V_lds + (bf) * SHM_V + vst0) = S.st_v0; *(bf16x8*)(V_lds + (bf) * SHM_V + vst1) = S.st_v1; } while (0)
#define SWRITE_H(bf) do { SWRITE_HV(bf); SWRITE_HK(bf); } while (0)
#define SLOAD_F(p, k0) do { S.sf0 = *(const f32x4*)ROW(p, k0, sr); S.sf1 = *(const f32x4*)(ROW(p, k0, sr) + 4);                \
                            S.sf2 = *(const f32x4*)ROW(p, k0, 32 + sr); S.sf3 = *(const f32x4*)(ROW(p, k0, 32 + sr) + 4); } while (0)
#define SWRITE_KF(bf) do { *(bf16x8*)(K_lds + (bf) * SHM_K + kws) = pack8(S.sf0, S.sf1); *(bf16x8*)(K_lds + (bf) * SHM_K + kws + 32 * 256) = pack8(S.sf2, S.sf3); } while (0)
#define SWRITE_VF(bf) do { *(bf16x8*)(V_lds + (bf) * SHM_V + vst0) = pack8(S.sf0, S.sf1); *(bf16x8*)(V_lds + (bf) * SHM_V + vst1) = pack8(S.sf2, S.sf3); } while (0)
template <class TIn, class TOut>
__device__ __forceinline__ void causal_swa_prime(const BlockRef<TIn, TOut>& cur, int W, char* lds, Seam<TIn>& S) {
    constexpr bool F32 = same_t<TIn, float>::v;
    int tid_ = threadIdx.x; asm volatile("" : "+v"(tid_));
    const int tid = tid_, wid = __builtin_amdgcn_readfirstlane(tid >> 6), lane = tid & 63, r32 = lane & 31, hi = lane >> 5;
    const int sr = tid >> 4, sc = (tid & 15) * 8, kws = KSWZ(sr, sc * 2); char* K_lds = lds + 2 * SHM_V;
    const int kb0 = cur.jlo * KVBLK;
    for (int d0 = 0; d0 < NQD; ++d0) S.qr[d0] = load8<TIn>(cur.Q + (size_t)(wid * QBLK + r32) * D + d0 * 16 + hi * 8);
    if constexpr (F32) { SLOAD_F((const float*)cur.K, kb0); VMW(); SWRITE_KF(0); SBAR(); SLOAD_F((const float*)cur.V, kb0); }
    else { SLOAD_H(cur.K, cur.V, kb0); VMW(); SWRITE_HK(0); }
    __syncthreads();
}
template <class TIn, class TOut>
__device__ __forceinline__ void causal_swa_block(const BlockRef<TIn, TOut>& cur, const BlockRef<TIn, TOut>& nxt, int skv, int W, char* lds, Seam<TIn>& S) {
    constexpr bool F32 = same_t<TIn, float>::v;
    int tid_ = threadIdx.x; asm volatile("" : "+v"(tid_));
    const int tid = tid_, wid = __builtin_amdgcn_readfirstlane(tid >> 6), lane = tid & 63, r32 = lane & 31, hi = lane >> 5;
    const int j_lo = cur.jlo; const int j_hi = cur.jhi; (void)skv;
    const int NT = j_hi - j_lo;
    const int kbn = nxt.jlo * KVBLK;
    const int qlo = cur.P0 + wid * QBLK, qm = qlo + r32 - 4 * hi;
    char* V_lds = lds; char* K_lds = lds + 2 * SHM_V;
    float* ws = (float*)(lds + 2 * SHM_V + 2 * SHM_K) + wid * 64; float* li_l = ws, * al_l = ws + 32;
    float m_reg = -1e30f, l_reg = 0; f32x16 o[4] = {};
    const int sr = tid >> 4, sc = (tid & 15) * 8, vst0 = v_st(sr, sc), vst1 = v_st(32 + sr, sc), kws = KSWZ(sr, sc * 2);
    const int vb0 = (int)(uintptr_t)V_lds + v_rd_base(lane);
    const TIn* Kh = cur.K; const TIn* Vh = cur.V;
#define RESC(a) do { (void)(a); (void)al_l; } while (0)
#define KBASE(t) ((j_lo + (t)) * KVBLK)
#define ACT(t) (KBASE(t) <= qlo + QBLK - 1 && KBASE(t) + KVBLK - 1 >= qlo - W + 1)
#define MASKT(P0_, P1_, t) do { const int kb_ = KBASE(t); if ((!SK || ACT(t)) && (kb_ + KVBLK - 1 > qlo || kb_ <= qlo + QBLK - 1 - W)) mask_tile(P0_, P1_, qm - kb_, (unsigned)W); } while (0)
    constexpr int NQL = F32 ? 16 : NQD;
    constexpr bool SK = WSKIP && !F32;
#define SEAM_K0() do { VMWN(NQL); if constexpr (F32) { SWRITE_KF(0); SBAR(); SLOAD_F((const float*)nxt.V, kbn); } else { SWRITE_HK(0); } SBAR(); } while (0)
    f32x16 pA0, pA1, pB0, pB1; float mnA, mnB, alA, alB; bf16x8 pa0, pa1, pa2, pa3;
    if constexpr (F32) { VMW(); SWRITE_VF(0); SBAR(); } else { SWRITE_HV(0); SBAR(); }
    if (NT > 1) { if constexpr (F32) SLOAD_F((const float*)Kh, KBASE(1)); else SLOAD_H(Kh, Vh, KBASE(1)); }
    SBAR(); qkt<0, SK>(pA0, pA1, K_lds, r32, hi, S.qr, ACT(0));
    if constexpr (F32) { if (NT > 1) { VMW(); SWRITE_KF(1); SBAR(); SLOAD_F((const float*)Vh, KBASE(1)); } }
    MASKT(pA0, pA1, 0); partialSM(pA0, pA1, m_reg, mnA, alA, cur.cshift);
    if (NT > 1) { VMW(); if constexpr (F32) { SWRITE_VF(1); SBAR(); if (NT > 2) SLOAD_F((const float*)Kh, KBASE(2)); } else SWRITE_H(1); }
    __syncthreads();
#define HALF_STEP(PX0, PX1, mnX, alX, PY0, PY1, alY, t, KB, VB, SB) do {                                                      \
        SBAR(); qkt<KB, SK>(PX0, PX1, K_lds, r32, hi, S.qr, ACT(t));                                             \
        finishSM(PY0, PY1, alY, l_reg, pa0, pa1, pa2, pa3); SBAR();                                                           \
        if ((t) + 1 < NT) { if constexpr (F32) { VMW(); SWRITE_KF(SB); SBAR(); SLOAD_F((const float*)Vh, KBASE((t) + 1)); }  \
                            else { SLOAD_H(Kh, Vh, KBASE((t) + 1)); } SBAR(); }                                               \
        pv_tile<VB, SK>(o, vb0, pa0, pa1, pa2, pa3, ACT((t) - 1)); MASKT(PX0, PX1, (t)); partialSM(PX0, PX1, m_reg, mnX, alX, cur.cshift);                                        \
        __syncthreads();                                                                                                      \
        if ((t) + 1 < NT) { VMW(); if constexpr (F32) { SWRITE_VF(SB); SBAR(); if ((t) + 2 < NT) SLOAD_F((const float*)Kh, KBASE((t) + 2)); } \
                            else { SWRITE_H(SB); } }                                                                          \
        RESC(alX); __syncthreads(); } while (0)
    for (int t = 1; t + 1 < NT; t += 2) {
        HALF_STEP(pB0, pB1, mnB, alB, pA0, pA1, alA, t, 1, 0, 0);
        HALF_STEP(pA0, pA1, mnA, alA, pB0, pB1, alB, t + 1, 0, 1, 1);
    }
    const bool even = (NT & 1) == 0;
    if (even) { SBAR(); qkt<1, SK>(pB0, pB1, K_lds, r32, hi, S.qr, ACT(NT - 1)); SBAR(); }
#define QROW(e) (nxt.Q + (size_t)(wid * QBLK + r32) * D + ((e) >> 1) * 16 + hi * 8 + ((e) & 1) * 4)
    if constexpr (F32) { SLOAD_F((const float*)nxt.K, kbn); SBAR();
#pragma unroll
        for (int e = 0; e < 8; ++e) S.tq[e] = *(const f32x4*)QROW(e); }
    else { SLOAD_H(nxt.K, nxt.V, kbn); SBAR();
#pragma unroll
        for (int d0 = 0; d0 < NQD; ++d0) S.qr[d0] = load8<TIn>(nxt.Q + (size_t)(wid * QBLK + r32) * D + d0 * 16 + hi * 8); }
    SBAR();
    finishSM(pA0, pA1, alA, l_reg, pa0, pa1, pa2, pa3); SBAR();
    if constexpr (F32) {
#pragma unroll
        for (int e = 8; e < 16; ++e) S.tq[e] = *(const f32x4*)QROW(e); SBAR(); }
#undef QROW
    pv_tile<0, SK>(o, vb0, pa0, pa1, pa2, pa3, ACT(even ? NT - 2 : NT - 1));
    if (even) { MASKT(pB0, pB1, NT - 1); partialSM(pB0, pB1, m_reg, mnB, alB, cur.cshift); __syncthreads(); RESC(alB);
        finishSM(pB0, pB1, alB, l_reg, pa0, pa1, pa2, pa3); SBAR(); pv_tile<1, SK>(o, vb0, pa0, pa1, pa2, pa3, ACT(NT - 1)); }
    SBAR(); SEAM_K0();
    if (hi == 0) { li_l[r32] = l_reg; cur.ML[wid * QBLK + r32] = make_float2(0.f, l_reg); } asm volatile("s_waitcnt lgkmcnt(0)" ::: "memory");
    float rli[16];
#pragma unroll
    for (int r = 0; r < 16; ++r) rli[r] = __builtin_amdgcn_rcpf(li_l[crow(r, hi)]);
    TOut* Ow = cur.O + (size_t)(wid * QBLK) * D;
#pragma unroll
    for (int r = 0; r < 16; ++r) { const int orow = crow(r, hi);
#pragma unroll
        for (int d0 = 0; d0 < 4; ++d0) { const float v = o[d0][r] * rli[r];
            if constexpr (same_t<TOut, float>::v) { Ow[(size_t)orow * D + d0 * 32 + r32] = v; }
            else { *(unsigned short*)(lds + LDS_BYTES + wid * 8704 + orow * 272 + (d0 * 32 + r32) * 2) = (unsigned short)(cvtpk(v, v) & 0xffffu); } } }
    if constexpr (!same_t<TOut, float>::v) {
#pragma unroll
        for (int i = 0; i < 8; ++i) { const int row = 4 * i + (lane >> 4), c16 = lane & 15;
            *(u32x4*)((char*)Ow + (size_t)row * (D * 2) + c16 * 16) = *(const u32x4*)(lds + LDS_BYTES + wid * 8704 + row * 272 + c16 * 16); } }
    if constexpr (F32) {
#pragma unroll
        for (int d0 = 0; d0 < NQD; ++d0) S.qr[d0] = pack8(S.tq[2 * d0], S.tq[2 * d0 + 1]); }
    if constexpr (!F32) {
#pragma unroll
        for (int d0 = 0; d0 < NQD; ++d0) asm volatile("" : "+v"(S.qr[d0]));
        asm volatile("" : "+v"(S.st_v0), "+v"(S.st_v1)); }
    __syncthreads();
#undef RESC
#undef KBASE
#undef ACT
#undef MASKT
#undef SEAM_K0
#undef HALF_STEP
}
#undef ROW
#undef VMW
#undef VMWN
#undef SLOAD_H
#undef SWRITE_HK
#undef SWRITE_HV
#undef SWRITE_H
#undef SLOAD_F
#undef SWRITE_KF
#undef SWRITE_VF

struct Item { int bh, qb, jlo, jhi, chunk; };
#ifdef PROBE_RACY
#endif
struct Tensors { const bf16* Q; const bf16* K; const bf16* V; bf16* O01; bf16* O23; float2* ML; float cshift;
#if defined(PROBE_RACY) || defined(PROBE_HALF)
    int racy;
#endif
};
constexpr int SEQ = 8192, NBH = 8;
__device__ __forceinline__ BlockRef<bf16, bf16> mkref(const Tensors& T, const Item& it) {
    BlockRef<bf16, bf16> r; const size_t row0 = (size_t)it.bh * SEQ + (size_t)it.qb * QB;
    r.Q = T.Q + row0 * D; r.K = T.K + (size_t)it.bh * SEQ * D; r.V = T.V + (size_t)it.bh * SEQ * D;
    r.O = (it.chunk < 2 ? T.O01 + (size_t)it.chunk * NBH * SEQ * D : T.O23 + (size_t)(it.chunk - 2) * NBH * SEQ * D) + row0 * D; r.ML = T.ML + (size_t)it.chunk * NBH * SEQ + row0; r.P0 = it.qb * QB; r.jlo = it.jlo; r.jhi = it.jhi; r.cshift = T.cshift;
#ifdef PROBE_RACY
    r.racy = T.racy;
#endif
#ifdef PROBE_HALF
#ifdef PROBE_ONE
    if (T.racy) r.jhi = r.jlo + PROBE_ONE;
#else
    if (T.racy) r.jhi = r.jlo + (r.jhi - r.jlo + 1) / 2;
#endif
#endif
    return r;
}
template <class Sched> __device__ __forceinline__ void attn_phase(char* lds, const Tensors& T, const Sched& S) {
    Item it, itn; if (!S.get(0, it)) return;
    BlockRef<bf16, bf16> cur = mkref(T, it);
    Seam<bf16> Sm;
    causal_swa_prime<bf16, bf16>(cur, 1 << 30, lds, Sm);
    for (int i = 0;; ++i) {
        const bool more = S.get(i + 1, itn);
        const BlockRef<bf16, bf16> nxt = more ? mkref(T, itn) : cur;
        causal_swa_block<bf16, bf16>(cur, nxt, SEQ, 1 << 30, lds, Sm);
        if (!more) break;
        cur = nxt;
    }
}
#undef KSWZ
#undef SBAR
}

constexpr int NWAVES = 8;
#ifndef MK_N_LAUNCHES
#define MK_N_LAUNCHES 1
#endif
#ifndef SPLIT_BAR
#define SPLIT_BAR 0
#endif
#ifndef GROUP_BAR
#define GROUP_BAR 1
#endif
#ifndef CONV_DOWN_LATE
#define CONV_DOWN_LATE (!GROUP_BAR)
#endif
#ifndef CONV_TAIL
#define CONV_TAIL 0
#endif
#ifndef GEMM_ALIGN
#define GEMM_ALIGN true
#endif
#ifndef GEMM_SP2
#define GEMM_SP2 true
#endif
constexpr int BATCH = 2, SEQ = 8192, DM = 1024, DEPTH = 2;
constexpr int M = BATCH * SEQ;
constexpr int Q_LORA = 256, KV_LORA = 128, QK_ROPE = 32, QK_NOPE = 64, QK_HEAD = 96, V_HEAD = 128, NHEAD = 4;
constexpr int SGU_W = 256, POOL_W = 256, CHUNK = 128;
constexpr int IN_W = 1184, ZLD = 1280;
constexpr int ZO_KV = 256, ZO_ROPE = 384, ZO_U = 416, ZO_V = 672, ZO_P = 928;
constexpr int FF = 2816, FF2 = 2 * FF;
constexpr float EPS = 1e-6f;
constexpr float QPRESCALE = 1.4426950408889634f * 0.10206207261596575f;
constexpr int PH_PER_LAYER = 7, NPH = 1 + DEPTH * PH_PER_LAYER;
constexpr int N_LAUNCHES = (MK_N_LAUNCHES == 1) ? 1 : NPH;

constexpr size_t MiB = 1u << 20;
constexpr size_t WS_CTL = 0, CTL_ZERO_BYTES = 64 * 1024 + (size_t)4 * 16384 * 4;
constexpr size_t WS_SSQ = 64 * 1024;
constexpr size_t WS_W = 2 * MiB, LW = 22 * MiB;
constexpr size_t OW_IN = 0, OW_Q = OW_IN + (size_t)ZLD * DM * 2, OW_KV = OW_Q + (size_t)384 * Q_LORA * 2, OW_OUT = OW_KV + (size_t)768 * KV_LORA * 2,
                 OW_GU = OW_OUT + (size_t)DM * DM * 2, OW_DN = OW_GU + (size_t)FF2 * DM * 2, OW_POOL = OW_DN + (size_t)DM * FF * 2, OW_SP = OW_POOL + (size_t)4 * 64 * 64 * 2, OW_END = OW_SP + (size_t)4 * CHUNK * CHUNK * 2;
static_assert(OW_END + 64 <= LW, "weight map");
constexpr size_t WS_CS = 46 * MiB;
constexpr size_t WS_XB = 48 * MiB;
constexpr size_t WS_Z = 80 * MiB;
constexpr size_t WS_MIX = 120 * MiB;
constexpr size_t WS_Q = 152 * MiB, WS_K = 168 * MiB, WS_V = 184 * MiB;
constexpr size_t WS_ML = 200 * MiB;
constexpr size_t WS_H = 152 * MiB;
constexpr size_t WS_END = 240 * MiB;
constexpr size_t OPART_BYTES = (size_t)8 * SEQ * 128 * 2;
constexpr size_t WS_OP01 = 202 * MiB;
static_assert(WS_W + DEPTH * LW <= WS_CS && WS_H + (size_t)M * FF * 2 <= WS_END && WS_END <= 256 * MiB && WS_Z + (size_t)M * ZLD * 2 <= WS_MIX && WS_Z + 2 * OPART_BYTES <= WS_MIX && WS_OP01 + 2 * OPART_BYTES <= 256 * MiB, "d_ws map");
__host__ __device__ constexpr size_t opart_off(int chunk) { return chunk < 2 ? WS_OP01 + (size_t)chunk * OPART_BYTES : WS_Z + (size_t)(chunk - 2) * OPART_BYTES; }
constexpr int CW_TMO = 0, CW_CODE = 1;
constexpr int CW_BAR = 4096;
constexpr int CW_GB = 8192;

constexpr int RING_OFF = 0, RING_BYTES = 163584;
constexpr int LDSCTL_OFF = RING_BYTES, MISC_OFF = LDSCTL_OFF;
constexpr int LDS_BYTES = 163840;
static_assert(MISC_OFF + 64 <= LDS_BYTES, "LDS map");

#define GAS __attribute__((address_space(1)))
#define LAS __attribute__((address_space(3)))
typedef unsigned short bf16;
typedef unsigned v4u __attribute__((ext_vector_type(4)));
typedef float f32x4 __attribute__((ext_vector_type(4)));
typedef short bf16x8 __attribute__((ext_vector_type(8)));
typedef GAS unsigned gu32;
typedef GAS unsigned long long gu64;
#define RLX_AGENT __ATOMIC_RELAXED, __HIP_MEMORY_SCOPE_AGENT
#define LDS_WAIT() asm volatile("s_waitcnt lgkmcnt(0)" ::: "memory")
#define VM_WAIT() asm volatile("s_waitcnt vmcnt(0)" ::: "memory")
__device__ __forceinline__ unsigned long long rt() { return __builtin_amdgcn_s_memrealtime(); }
__device__ __forceinline__ unsigned f2bf(float f) { unsigned u = __builtin_bit_cast(unsigned, f); return (u + 0x7fffu + ((u >> 16) & 1u)) >> 16; }
typedef float f32x2_t __attribute__((ext_vector_type(2))); typedef __bf16 bf16x2_t __attribute__((ext_vector_type(2)));
__device__ __forceinline__ unsigned pk2(float lo, float hi) { f32x2_t v = {lo, hi}; bf16x2_t b = __builtin_convertvector(v, bf16x2_t); return __builtin_bit_cast(unsigned, b); }

#ifndef XB_EARLY_INV
#define XB_EARLY_INV 1
#endif
#ifndef XB_EARLY_WB
#define XB_EARLY_WB 0
#endif
#ifndef XB_FLAT_RELEASE
#define XB_FLAT_RELEASE 1
#endif
#define XB_TMO      128
#define XB_XCNT(j)  (256  + 64 * (j))
#define XB_XSUB(j)  (1280 + 64 * (j))
#define XB_XGEN(j)  (2304 + 64 * (j))
#define XB_TOP      3328
#define XB_TOPGEN   3392
#define XCD_BAR_WORDS 3456
#define XB_SPIN_CAP (1u << 18)

__device__ __forceinline__ unsigned xb_ld(unsigned* p)              { return __hip_atomic_load(p, __ATOMIC_RELAXED, __HIP_MEMORY_SCOPE_AGENT); }
__device__ __forceinline__ unsigned xb_add(unsigned* p, unsigned v) { return __hip_atomic_fetch_add(p, v, __ATOMIC_RELAXED, __HIP_MEMORY_SCOPE_AGENT); }
__device__ __forceinline__ unsigned xb_xcc_id() { return (unsigned)__builtin_amdgcn_s_getreg((3 << 11) | 20) & 0xFu; }
#define XB_SPIN(cond, bar) do { unsigned _sp = 0; while (cond) { __builtin_amdgcn_s_sleep(1); \
    if ((++_sp & 255u) == 0u) { if (xb_ld(&(bar)[XB_TMO])) break; if (_sp > XB_SPIN_CAP) { atomicAdd(&(bar)[XB_TMO], 1u); break; } } } } while (0)

struct XcdBarrier {
    unsigned* bar; unsigned x;
    volatile LAS unsigned* st;
};

__device__ __forceinline__ XcdBarrier xcd_barrier_post(unsigned* bar, volatile LAS unsigned* st) {
    XcdBarrier b; b.bar = bar; b.x = xb_xcc_id(); b.st = st;
    if (threadIdx.x == 0) (void)xb_add(&bar[XB_XCNT(b.x)], 1u);
    return b;
}
__device__ __forceinline__ void xcd_barrier_complete(unsigned* bar, unsigned x, unsigned& nloc, unsigned& nx) {
    const unsigned G = gridDim.x * gridDim.y * gridDim.z;
    unsigned sum, cnt, mine, sp = 0u;
    for (;;) {
        sum = 0u; cnt = 0u; mine = 0u;
#pragma unroll
        for (unsigned j = 0; j < 16; ++j) { const unsigned c = xb_ld(&bar[XB_XCNT(j)]); sum += c; cnt += (c > 0u) ? 1u : 0u; mine = (j == x) ? c : mine; }
        if (sum == G) break;
        __builtin_amdgcn_s_sleep(1);
        if ((++sp & 255u) == 0u) { if (xb_ld(&bar[XB_TMO])) break; if (sp > XB_SPIN_CAP) { atomicAdd(&bar[XB_TMO], 1u); break; } }
    }
    nloc = mine > 0u ? mine : 1u; nx = cnt > 0u ? cnt : 1u;
}

__device__ __forceinline__ void xcd_barrier(const XcdBarrier& b) {
    asm volatile("s_waitcnt vmcnt(0)" ::: "memory");
    __syncthreads();
    if (threadIdx.x == 0) {
        unsigned* bar = b.bar;
        __builtin_amdgcn_s_waitcnt(0);
        unsigned nloc = b.st[0], nx = b.st[1];
        if (nloc == 0u) { xcd_barrier_complete(bar, b.x, nloc, nx); b.st[0] = nloc; b.st[1] = nx; }
        const unsigned old = xb_add(&bar[XB_XSUB(b.x)], 1u);
        const unsigned gen = old / nloc;
        if (old + 1u == (gen + 1u) * nloc) {
            __builtin_amdgcn_fence(__ATOMIC_RELEASE, "agent");
            asm volatile("s_waitcnt vmcnt(0)" ::: "memory");
            const unsigned og = xb_add(&bar[XB_TOP], 1u);
            const unsigned tg = og / nx;
#if XB_EARLY_INV
            if (og + 1u == (tg + 1u) * nx) { xb_add(&bar[XB_TOPGEN], 1u);
                __builtin_amdgcn_fence(__ATOMIC_ACQUIRE, "agent"); }
            else { __builtin_amdgcn_fence(__ATOMIC_ACQUIRE, "agent");
                   XB_SPIN(xb_ld(&bar[XB_TOPGEN]) == tg, bar); }
#else
            if (og + 1u == (tg + 1u) * nx) xb_add(&bar[XB_TOPGEN], 1u);
            else XB_SPIN(xb_ld(&bar[XB_TOPGEN]) == tg, bar);
            __builtin_amdgcn_fence(__ATOMIC_ACQUIRE, "agent");
#endif
#if !(XB_EARLY_INV && XB_FLAT_RELEASE)
            xb_add(&bar[XB_XGEN(b.x)], 1u);
#endif
            asm volatile("s_waitcnt vmcnt(0)" ::: "memory");
        } else {
#if XB_EARLY_WB
            if (old == gen * nloc) { __builtin_amdgcn_fence(__ATOMIC_RELEASE, "agent"); asm volatile("s_waitcnt vmcnt(0)" ::: "memory"); }
#endif
#if XB_EARLY_INV
            __builtin_amdgcn_fence(__ATOMIC_ACQUIRE, "agent");
            asm volatile("s_waitcnt vmcnt(0)" ::: "memory");
#if XB_FLAT_RELEASE
            XB_SPIN(xb_ld(&bar[XB_TOPGEN]) == gen, bar);
#else
            XB_SPIN(xb_ld(&bar[XB_XGEN(b.x)]) == gen, bar);
#endif
#else
            XB_SPIN(xb_ld(&bar[XB_XGEN(b.x)]) == gen, bar);
            __builtin_amdgcn_fence(__ATOMIC_ACQUIRE, "agent");
            asm volatile("s_waitcnt vmcnt(0)" ::: "memory");
#endif
        }
    }
    __syncthreads();
}

__device__ __forceinline__ void xcd_barrier_arrive(const XcdBarrier& b) {
    asm volatile("s_waitcnt vmcnt(0)" ::: "memory");
    __syncthreads();
    if (threadIdx.x == 0) {
        unsigned* bar = b.bar;
        __builtin_amdgcn_s_waitcnt(0);
        const unsigned nloc = b.st[0], nx = b.st[1];
        const unsigned old = xb_add(&bar[XB_XSUB(b.x)], 1u);
        const unsigned gen = old / nloc;
        b.st[2] = gen;
        if (old + 1u == (gen + 1u) * nloc) {
            __builtin_amdgcn_fence(__ATOMIC_RELEASE, "agent");
            asm volatile("s_waitcnt vmcnt(0)" ::: "memory");
            const unsigned og = xb_add(&bar[XB_TOP], 1u);
            const unsigned tg = og / nx;
            if (og + 1u == (tg + 1u) * nx) xb_add(&bar[XB_TOPGEN], 1u);
        }
    }
    __syncthreads();
}
__device__ __forceinline__ void xcd_barrier_wait(const XcdBarrier& b) {
    asm volatile("s_waitcnt vmcnt(0)" ::: "memory");
    __syncthreads();
    if (threadIdx.x == 0) {
        const unsigned gen = b.st[2];
        __builtin_amdgcn_fence(__ATOMIC_ACQUIRE, "agent");
        asm volatile("s_waitcnt vmcnt(0)" ::: "memory");
        XB_SPIN(xb_ld(&b.bar[XB_TOPGEN]) == gen, b.bar);
    }
    __syncthreads();
}

typedef unsigned u32x2 __attribute__((ext_vector_type(2)));
#define CAS __attribute__((address_space(4)))
struct Args { const float* in[23]; float* out; unsigned char* ws; int ph_lo, ph_hi, li, pad; };
struct Frame {
    LAS unsigned char* lds;
    const CAS Args* a;
    int lane, wave;
    int vcu, G;
};
__device__ __forceinline__ float wave_sum(float v) {
#pragma unroll
    for (int o = 1; o < 64; o <<= 1) v += __shfl_xor(v, o);
    return v;
}
__device__ __forceinline__ float wave_sum_dpp(float v) {
#define WS_DPP(ctrl, rmask) v += __builtin_bit_cast(float, __builtin_amdgcn_update_dpp(0, __builtin_bit_cast(int, v), ctrl, rmask, 0xf, false))
    WS_DPP(0x111, 0xf); WS_DPP(0x112, 0xf); WS_DPP(0x114, 0xf); WS_DPP(0x118, 0xf); WS_DPP(0x142, 0xa); WS_DPP(0x143, 0xc);
#undef WS_DPP
    return __builtin_bit_cast(float, __builtin_amdgcn_readlane(__builtin_bit_cast(int, v), 63));
}
__device__ __forceinline__ float quad_sum(float v) { v += __shfl_xor(v, 16); v += __shfl_xor(v, 32); return v; }
__device__ __forceinline__ float bf2f(unsigned short h) { return __builtin_bit_cast(float, (unsigned)h << 16); }
__device__ __forceinline__ float bflo(unsigned w) { return __builtin_bit_cast(float, w << 16); }
__device__ __forceinline__ float bfhi(unsigned w) { return __builtin_bit_cast(float, w & 0xffff0000u); }
__device__ __forceinline__ f32x4 mfma16(bf16x8 a, bf16x8 b, f32x4 c) { return __builtin_amdgcn_mfma_f32_16x16x32_bf16(a, b, c, 0, 0, 0); }
__device__ __forceinline__ u32x2 pk4(f32x4 v) { u32x2 w; w.x = pk2(v[0], v[1]); w.y = pk2(v[2], v[3]); return w; }
__device__ __forceinline__ bf16x8 pk8(const float* v) { v4u w; w.x = pk2(v[0], v[1]); w.y = pk2(v[2], v[3]); w.z = pk2(v[4], v[5]); w.w = pk2(v[6], v[7]); return __builtin_bit_cast(bf16x8, w); }

#define IN_F(i) ((const float*)F.a->in[i])
__device__ __forceinline__ bf16* wsp(const Frame& F, size_t off) { return (bf16*)(F.a->ws + off); }
__device__ __forceinline__ float* ssq_mix(const Frame& F, int l) { return (float*)(F.a->ws + WS_SSQ) + (size_t)(2 * l) * M; }
__device__ __forceinline__ float* ssq_ffn(const Frame& F, int l) { return (float*)(F.a->ws + WS_SSQ) + (size_t)(2 * l + 1) * M; }

__device__ __forceinline__ void p0_tr_item64(const float* W, int ldw, int k0, int n0, int nv, const float* gain, bf16* WT, int ldt, int drow0, LAS float* scr, int lane) {
    const int c4 = 4 * (lane & 15), rr = lane >> 4;
    f32x4 v[16]; float gg[16];
#pragma unroll
    for (int i = 0; i < 16; ++i) gg[i] = gain ? gain[k0 + rr + 4 * i] : 1.0f;
#pragma unroll
    for (int i = 0; i < 16; ++i) { v[i] = (f32x4){0.f, 0.f, 0.f, 0.f}; if (c4 < nv) v[i] = *(const GAS f32x4*)(W + (size_t)(k0 + rr + 4 * i) * ldw + n0 + c4); }
#pragma unroll
    for (int i = 0; i < 16; ++i) { const int kk = rr + 4 * i; const float g = gg[i];
#pragma unroll
        for (int e = 0; e < 4; ++e) scr[kk * 65 + c4 + e] = v[i][e] * g; }
    LDS_WAIT(); asm volatile("" ::: "memory");
    const int c = lane & 7;
#pragma unroll
    for (int j = 0; j < 8; ++j) { const int n = (lane >> 3) + 8 * j; const LAS float* sp = scr + (8 * c) * 65 + n;
        if (n < nv) { v4u o; o.x = pk2(sp[0 * 65], sp[1 * 65]); o.y = pk2(sp[2 * 65], sp[3 * 65]); o.z = pk2(sp[4 * 65], sp[5 * 65]); o.w = pk2(sp[6 * 65], sp[7 * 65]);
            *(GAS v4u*)(WT + (size_t)(drow0 + n) * ldt + k0 + 8 * c) = o; } }
    LDS_WAIT(); asm volatile("" ::: "memory");
}
constexpr int CI_IN = (DM / 64) * ((IN_W + 63) / 64), CI_Q = (Q_LORA / 64) * (384 / 64), CI_KV = (KV_LORA / 64) * (768 / 64), CI_SET0 = CI_IN + CI_Q + CI_KV;
constexpr int CI_OUT = (DM / 64) * (DM / 64), CI_G = (DM / 64) * (FF / 64), CI_DN = (FF / 64) * (DM / 64), CI_SET1 = CI_OUT + 2 * CI_G + CI_DN;
__device__ __forceinline__ void conv_item(Frame& F, int l, int set, int r, LAS float* scr, int lane) {
    unsigned char* wl = F.a->ws + WS_W + (size_t)l * LW;
    if (set == 0) {
        if (r < CI_IN) { const int nb = (IN_W + 63) / 64, kb = r / nb, n0 = 64 * (r % nb);
            p0_tr_item64(IN_F(3) + (size_t)l * DM * IN_W, IN_W, 64 * kb, n0, IN_W - n0 < 64 ? IN_W - n0 : 64, IN_F(2) + l * DM, (bf16*)(wl + OW_IN), DM, n0, scr, lane); return; } r -= CI_IN;
        if (r < CI_Q) { const int nb = 384 / 64, kb = r / nb, n0 = 64 * (r % nb);
            p0_tr_item64(IN_F(5) + (size_t)l * Q_LORA * 384, 384, 64 * kb, n0, 64, IN_F(4) + l * Q_LORA, (bf16*)(wl + OW_Q), Q_LORA, n0, scr, lane); return; } r -= CI_Q;
        { const int nb = 768 / 64, kb = r / nb, n0 = 64 * (r % nb);
            p0_tr_item64(IN_F(7) + (size_t)l * KV_LORA * 768, 768, 64 * kb, n0, 64, IN_F(6) + l * KV_LORA, (bf16*)(wl + OW_KV), KV_LORA, n0, scr, lane); return; }
    }
    if (r < CI_OUT) { const int nb = DM / 64, kb = r / nb, n0 = 64 * (r % nb), k0 = 64 * kb;
        const float* g = k0 < 512 ? IN_F(15) + l * 512 : k0 < 768 ? IN_F(16) + l * 256 - 512 : IN_F(17) + l * 256 - 768;
        p0_tr_item64(IN_F(18) + (size_t)l * DM * DM, DM, k0, n0, 64, g, (bf16*)(wl + OW_OUT), DM, n0, scr, lane); return; } r -= CI_OUT;
    if (r < 2 * CI_G) { const int up = r >= CI_G; if (up) r -= CI_G; const int nb = FF / 64, kb = r / nb, n0 = 64 * (r % nb);
        p0_tr_item64(IN_F(up ? 21 : 20) + (size_t)l * DM * FF, FF, 64 * kb, n0, 64, IN_F(19) + l * DM, (bf16*)(wl + OW_GU), DM, (n0 >> 7) * 256 + (n0 & 127) + (up ? 128 : 0), scr, lane); return; } r -= 2 * CI_G;
    { const int nb = DM / 64, kb = r / nb, n0 = 64 * (r % nb);
        p0_tr_item64(IN_F(22) + (size_t)l * FF * DM, DM, 64 * kb, n0, 64, nullptr, (bf16*)(wl + OW_DN), FF, n0, scr, lane); }
}
__device__ __forceinline__ void conv_set(Frame& F, int l, int set, int wk, int nwk, int first = 0, int last = 1 << 30) {
    LAS float* scr = (LAS float*)(F.lds + RING_OFF + F.wave * 16640);
    const int n = set == 0 ? CI_SET0 : CI_SET1, hi = last < n ? last : n;
    for (int it = first + wk; it < hi; it += nwk) conv_item(F, l, set, it, scr, F.lane);
}
constexpr int CI_SPLIT = 1184;
#ifndef CONV_DEFER
#define CONV_DEFER 1
#endif
__device__ __forceinline__ void p0_prologue(Frame& F) {
    const int gw = F.vcu * NWAVES + F.wave, NGW = F.G * NWAVES, lane = F.lane;
    { const int wk0 = F.wave * F.G + F.vcu;
      for (int l = 0; l < DEPTH; ++l) { conv_set(F, l, 0, (wk0 + NGW - (l * CI_SET0) % NGW) % NGW, NGW); if (!CONV_DEFER) conv_set(F, l, 1, gw, NGW); } }
    { const int gt = gw * 64 + lane, NGT = NGW * 64;
        constexpr int NPAD = DEPTH * (ZLD - IN_W) * DM / 8, NPOOL = DEPTH * 4 * 64 * 64, NTRIL = DEPTH * 4 * CHUNK * CHUNK / 8, NROPE = M * 16;
        const int* pos = (const int*)IN_F(1);
        auto pad_body = [&](int i) { const int l = i / ((ZLD - IN_W) * DM / 8), e = i % ((ZLD - IN_W) * DM / 8);
            *(GAS v4u*)(F.a->ws + WS_W + (size_t)l * LW + OW_IN + (size_t)IN_W * DM * 2 + (size_t)e * 16) = (v4u){0u, 0u, 0u, 0u}; };
        auto pool_ld = [&](int i, float& w, float& sc) { const int l = i >> 14, g = (i >> 12) & 3, d = (i >> 6) & 63, c = i & 63; w = IN_F(13)[(size_t)l * 16384 + (g * 64 + c) * 64 + d]; sc = IN_F(14)[l * POOL_W + g * 64 + d]; };
        auto pool_body = [&](int i, float w, float sc) { const int l = i >> 14, g = (i >> 12) & 3, d = (i >> 6) & 63, c = i & 63;
            ((bf16*)(F.a->ws + WS_W + (size_t)l * LW + OW_POOL))[(g * 64 + d) * 64 + c] = (bf16)f2bf(w * sc); };
        auto tril_ld = [&](int i, f32x4& a, f32x4& b) { const int l = i >> 13, e = (i & 8191) * 8; const float* src = IN_F(11) + (size_t)l * 4 * CHUNK * CHUNK + e; a = *(const f32x4*)src; b = *(const f32x4*)(src + 4); };
        auto tril_body = [&](int i, f32x4 a, f32x4 b) { const int l = i >> 13, e = (i & 8191) * 8, t = (e >> 7) & 127, s0 = e & 127;
            float v[8] = {a[0], a[1], a[2], a[3], b[0], b[1], b[2], b[3]};
#pragma unroll
            for (int j = 0; j < 8; ++j) if (s0 + j > t) v[j] = 0.f;
            *(bf16x8*)(F.a->ws + WS_W + (size_t)l * LW + OW_SP + (size_t)e * 2) = pk8(v); };
        auto rope_body = [&](int i, int pv) { const int m = i >> 4, f = i & 15;
            const float inv = 1.0f / powf(10000.0f, (float)f * (1.0f / 16.0f));
            const float ang = (float)pv * inv;
            const double a = (double)ang, n = rint(a * 0.15915494309189535), y = a - n * 6.283185307179586;
            const float yf = (float)y; ((float*)(F.a->ws + WS_CS))[(size_t)m * 32 + f] = cosf(yf); ((float*)(F.a->ws + WS_CS))[(size_t)m * 32 + 16 + f] = sinf(yf); };
        { float pw = 0.f, psc = 0.f; f32x4 ta = {0.f, 0.f, 0.f, 0.f}, tb = ta; int pv0 = 0, pv1 = 0;
          if (gt < NPOOL) pool_ld(gt, pw, psc);
          if (gt < NTRIL) tril_ld(gt, ta, tb);
          if (gt < NROPE) pv0 = pos[gt >> 4];
          if (gt + NGT < NROPE) pv1 = pos[(gt + NGT) >> 4];
          if (gt < NPAD) pad_body(gt);
          if (gt < NPOOL) pool_body(gt, pw, psc);
          if (gt < NTRIL) tril_body(gt, ta, tb);
          if (gt < NROPE) rope_body(gt, pv0);
          if (gt + NGT < NROPE) rope_body(gt + NGT, pv1); }
        for (int i = gt + NGT; i < NPAD; i += NGT) pad_body(i);
        for (int i = gt + NGT; i < NPOOL; i += NGT) { float w, sc; pool_ld(i, w, sc); pool_body(i, w, sc); }
        for (int i = gt + NGT; i < NTRIL; i += NGT) { f32x4 a, b; tril_ld(i, a, b); tril_body(i, a, b); }
        for (int i = gt + 2 * NGT; i < NROPE; i += NGT) rope_body(i, pos[i >> 4]);
    }
    if (gw < DEPTH) { const int l = gw; float gqm = 0.f, gkm = 0.f; const float* gq = IN_F(8) + l * QK_HEAD; const float* gk = IN_F(9) + l * QK_HEAD;
        for (int i = lane; i < QK_HEAD; i += 64) { gqm = fmaxf(gqm, fabsf(gq[i])); gkm = fmaxf(gkm, fabsf(gk[i])); }
#pragma unroll
        for (int o = 1; o < 64; o <<= 1) { gqm = fmaxf(gqm, __shfl_xor(gqm, o)); gkm = fmaxf(gkm, __shfl_xor(gkm, o)); }
        if (lane == 0) *(float*)(F.a->ws + WS_W + (size_t)l * LW + OW_END) = fmaxf(0.f, 1.4426950408889634f * 9.797958971132712f * gqm * gkm - 64.0f); }
    float* ssq0 = ssq_mix(F, 0);
#ifdef PROBE_TWICE
    for (int i = gw * 64 + lane; i < 3 * M; i += NGW * 64) ssq0[M + i] = 0.f;
#endif
    static_assert(M % (64 * 256) == 0, "x pass: 64 rows per workgroup and round");
    for (int mb = F.vcu * 64; mb < M; mb += F.G * 64)
    for (int j = F.wave >= 3 ? F.wave - 3 : 13 + F.wave; j < (F.wave >= 3 ? 13 : 16); j += (F.wave >= 3 ? 5 : 16)) {
        const int m0 = mb + 4 * j;
        f32x4 v[4][4];
#pragma unroll
        for (int r = 0; r < 4; ++r) { const GAS f32x4* xr = (const GAS f32x4*)(IN_F(0) + (size_t)(m0 + r) * DM) + 2 * lane;
#pragma unroll
            for (int j = 0; j < 2; ++j) { v[r][2 * j] = xr[128 * j]; v[r][2 * j + 1] = xr[128 * j + 1]; } }
#pragma unroll
        for (int r = 0; r < 4; ++r) { float s = 0.f; GAS v4u* o16 = (GAS v4u*)(wsp(F, WS_XB) + (size_t)(m0 + r) * DM) + lane;
#pragma unroll
            for (int j = 0; j < 2; ++j) { const f32x4 x = v[r][2 * j], y = v[r][2 * j + 1];
                s += ((x.x * x.x + x.y * x.y) + (x.z * x.z + x.w * x.w)) + ((y.x * y.x + y.y * y.y) + (y.z * y.z + y.w * y.w));
                o16[64 * j] = (v4u){pk2(x.x, x.y), pk2(x.z, x.w), pk2(y.x, y.y), pk2(y.z, y.w)}; }
            s = wave_sum_dpp(s); if (lane == 0) ssq0[m0 + r] = s; }
    }
}

__device__ __forceinline__ void p2_upproj_unit(Frame& F, int l, int chunk, bool dry = false) {
    int lane_ = F.lane; asm volatile("" : "+v"(lane_));
    const int lane = lane_, tl = lane & 15, kq = lane >> 4;
    const int m0w = chunk * CHUNK + F.wave * 16, m = m0w + tl, b = m >> 13, s0w = m0w & (SEQ - 1);
    const bf16* zrow = wsp(F, WS_Z) + (size_t)m * ZLD;
    const unsigned char* wl = F.a->ws + WS_W + (size_t)l * LW;
    const bf16* Wq = (const bf16*)(wl + OW_Q); const bf16* Wkv = (const bf16*)(wl + OW_KV);
    LAS unsigned char* buf0 = F.lds + RING_OFF; LAS unsigned char* buf1 = F.lds + RING_OFF + 49152;
    LAS unsigned char* stg = F.lds + RING_OFF + 98304 + F.wave * 4352;
#define UP_DMAQ(h_) do { _Pragma("unroll") for (int i = 0; i < 6; ++i) { const int j = F.wave * 6 + i, row = 2 * j + (lane >> 5), slot = lane & 31; \
        __builtin_amdgcn_global_load_lds((const unsigned*)((const unsigned char*)Wq + (size_t)((h_) * QK_HEAD + row) * (Q_LORA * 2) + ((slot ^ (row & 15)) * 16)), (LAS unsigned*)(buf0 + j * 1024), 16, 0, 0); } } while (0)
#define UP_DMAKV(h_) do { _Pragma("unroll") for (int i = 0; i < 6; ++i) { const int j = F.wave * 6 + i, row = 4 * j + (lane >> 4), slot = lane & 15; \
        __builtin_amdgcn_global_load_lds((const unsigned*)((const unsigned char*)Wkv + (size_t)((h_) * 192 + row) * (KV_LORA * 2) + ((slot ^ (row & 15)) * 16)), (LAS unsigned*)(buf1 + j * 1024), 16, 0, 0); } } while (0)
    UP_DMAQ(0);
    bf16x8 zq[8], zkv[4];
#pragma unroll
    for (int ks = 0; ks < 8; ++ks) zq[ks] = *(const bf16x8*)(zrow + ks * 32 + kq * 8);
#pragma unroll
    for (int ks = 0; ks < 4; ++ks) zkv[ks] = *(const bf16x8*)(zrow + ZO_KV + ks * 32 + kq * 8);
    const u32x2 kw0 = *(const u32x2*)(zrow + ZO_ROPE + 4 * kq), kw1 = *(const u32x2*)(zrow + ZO_ROPE + 16 + 4 * kq);
    const float* csr = (const float*)(F.a->ws + WS_CS) + (size_t)m * 32;
    const f32x4 cs = *(const f32x4*)(csr + 4 * kq), sn = *(const f32x4*)(csr + 16 + 4 * kq);
    const float* gq = IN_F(8) + l * QK_HEAD; const float* gk = IN_F(9) + l * QK_HEAD;
    LAS float* gtab = (LAS float*)(F.lds + RING_OFF + 98304 + 8 * 4352);
    if (F.wave == 0) { for (int i = lane; i < 2 * QK_HEAD; i += 64) gtab[i] = i < QK_HEAD ? gq[i] : gk[i - QK_HEAD]; }
#define gqv(nb_) (*(const LAS f32x4*)(gtab + (nb_) * 16 + 4 * kq))
#define gkv(nb_) (*(const LAS f32x4*)(gtab + QK_HEAD + (nb_) * 16 + 4 * kq))
    float sq = 0.f, skv = 0.f;
#pragma unroll
    for (int ks = 0; ks < 8; ++ks)
#pragma unroll
        for (int j = 0; j < 8; ++j) { const float v = bf2f((unsigned short)zq[ks][j]); sq += v * v; }
#pragma unroll
    for (int ks = 0; ks < 4; ++ks)
#pragma unroll
        for (int j = 0; j < 8; ++j) { const float v = bf2f((unsigned short)zkv[ks][j]); skv += v * v; }
    const float r_q = __builtin_amdgcn_rsqf(quad_sum(sq) * (1.0f / Q_LORA) + EPS), r_kv = __builtin_amdgcn_rsqf(quad_sum(skv) * (1.0f / KV_LORA) + EPS);
    const f32x4 kr0 = {bflo(kw0.x), bfhi(kw0.x), bflo(kw0.y), bfhi(kw0.y)}, kr1 = {bflo(kw1.x), bfhi(kw1.x), bflo(kw1.y), bfhi(kw1.y)};
    float skr = (kr0[0] * kr0[0] + kr0[1] * kr0[1]) + (kr0[2] * kr0[2] + kr0[3] * kr0[3]) + (kr1[0] * kr1[0] + kr1[1] * kr1[1]) + (kr1[2] * kr1[2] + kr1[3] * kr1[3]);
    skr = quad_sum(skr);
#define UP_RD(dst_, ad_, OFF_) asm volatile("ds_read_b128 %0, %1 offset:%2" : "=v"(dst_) : "v"(ad_), "i"(OFF_) : "memory")
    const unsigned qbase = (unsigned)(uintptr_t)buf0 + tl * 512, kbase = (unsigned)(uintptr_t)buf1 + tl * 256;
#define UP_RDQ(d_, ks_) do { const unsigned ad_ = qbase + ((((ks_) * 4 + kq) ^ tl) << 4); UP_RD(d_[0], ad_, 0); UP_RD(d_[1], ad_, 8192); UP_RD(d_[2], ad_, 16384); UP_RD(d_[3], ad_, 24576); UP_RD(d_[4], ad_, 32768); UP_RD(d_[5], ad_, 40960); } while (0)
#define UP_RDKV(d_, ks_) do { const unsigned ad_ = kbase + ((((ks_) * 4 + kq) ^ tl) << 4); UP_RD(d_[0], ad_, 0); UP_RD(d_[1], ad_, 4096); UP_RD(d_[2], ad_, 8192); UP_RD(d_[3], ad_, 12288); UP_RD(d_[4], ad_, 16384); UP_RD(d_[5], ad_, 20480); \
        UP_RD(d_[6], ad_, 24576); UP_RD(d_[7], ad_, 28672); UP_RD(d_[8], ad_, 32768); UP_RD(d_[9], ad_, 36864); UP_RD(d_[10], ad_, 40960); UP_RD(d_[11], ad_, 45056); } while (0)
#define UP_PUT(nb_, v_) (*(LAS u32x2*)(stg + tl * 272 + (nb_) * 32 + kq * 8) = pk4(v_))
#ifdef PROBE_DRYSTORE
#define UP_DRY dry
#else
#define UP_DRY false
#endif
#define UP_FLUSH(dst_) do { if (!UP_DRY) { unsigned char* d_ = (unsigned char*)(dst_) + (size_t)(lane >> 4) * 256 + (lane & 15) * 16; _Pragma("unroll") for (int i = 0; i < 4; ++i) \
        *(GAS v4u*)(d_ + i * 1024) = *(const LAS v4u*)(stg + (4 * i + (lane >> 4)) * 272 + (lane & 15) * 16); } } while (0)
    __syncthreads();
#pragma unroll 1
    for (int h = 0; h < NHEAD; ++h) {
        const size_t orow0 = ((size_t)(b * NHEAD + h) * SEQ + s0w) * 128;
#ifdef PROBE_NODMA
        if (!dry)
#endif
        UP_DMAKV(h); asm volatile("" ::: "memory");
        {
            f32x4 acc[6];
#pragma unroll
            for (int nb = 0; nb < 6; ++nb) acc[nb] = (f32x4){0.f, 0.f, 0.f, 0.f};
            {
                bf16x8 fa[6], fb[6];
                UP_RDQ(fa, 0);
#define UP_QSTEP(cur_, nxt_, ks_) do { asm volatile("s_waitcnt lgkmcnt(0)" ::: "memory"); __builtin_amdgcn_sched_barrier(0); if ((ks_) + 1 < 8) UP_RDQ(nxt_, (ks_) + 1); \
                    _Pragma("unroll") for (int nb = 0; nb < 6; ++nb) acc[nb] = mfma16(cur_[nb], zq[ks_], acc[nb]); __builtin_amdgcn_sched_barrier(0); } while (0)
                UP_QSTEP(fa, fb, 0); UP_QSTEP(fb, fa, 1); UP_QSTEP(fa, fb, 2); UP_QSTEP(fb, fa, 3); UP_QSTEP(fa, fb, 4); UP_QSTEP(fb, fa, 5); UP_QSTEP(fa, fb, 6); UP_QSTEP(fb, fa, 7);
#undef UP_QSTEP
            }
            float ss = 0.f;
#pragma unroll
            for (int nb = 0; nb < 6; ++nb) { acc[nb] = acc[nb] * r_q; ss += (acc[nb][0] * acc[nb][0] + acc[nb][1] * acc[nb][1]) + (acc[nb][2] * acc[nb][2] + acc[nb][3] * acc[nb][3]); }
            const float rh = __builtin_amdgcn_rsqf(quad_sum(ss) * (1.0f / QK_HEAD) + EPS);
#pragma unroll
            for (int nb = 0; nb < 6; ++nb) acc[nb] = acc[nb] * (rh * QPRESCALE) * gqv(nb);
            const f32x4 x1 = acc[4], x2 = acc[5]; acc[4] = x1 * cs - x2 * sn; acc[5] = x2 * cs + x1 * sn;
#pragma unroll
            for (int nb = 0; nb < 6; ++nb) UP_PUT(nb, acc[nb]);
            UP_PUT(6, ((f32x4){0.f, 0.f, 0.f, 0.f})); UP_PUT(7, ((f32x4){0.f, 0.f, 0.f, 0.f}));
            UP_FLUSH(wsp(F, WS_Q) + orow0);
        }
        asm volatile("s_waitcnt vmcnt(4) lgkmcnt(0)" ::: "memory"); __builtin_amdgcn_s_barrier(); asm volatile("" ::: "memory");
#ifdef PROBE_NODMA
        if (!dry)
#endif
        if (h + 1 < NHEAD) UP_DMAQ(h + 1);
        asm volatile("" ::: "memory");
        {
            f32x4 acc[12];
#pragma unroll
            for (int nb = 0; nb < 12; ++nb) acc[nb] = (f32x4){0.f, 0.f, 0.f, 0.f};
            {
                bf16x8 fa[12], fb[12];
                UP_RDKV(fa, 0);
#define UP_KSTEP(cur_, nxt_, ks_) do { asm volatile("s_waitcnt lgkmcnt(0)" ::: "memory"); __builtin_amdgcn_sched_barrier(0); if ((ks_) + 1 < 4) UP_RDKV(nxt_, (ks_) + 1); \
                    _Pragma("unroll") for (int nb = 0; nb < 12; ++nb) acc[nb] = mfma16(cur_[nb], zkv[ks_], acc[nb]); __builtin_amdgcn_sched_barrier(0); } while (0)
                UP_KSTEP(fa, fb, 0); UP_KSTEP(fb, fa, 1); UP_KSTEP(fa, fb, 2); UP_KSTEP(fb, fa, 3);
#undef UP_KSTEP
            }
            float ss = 0.f;
#pragma unroll
            for (int nb = 0; nb < 4; ++nb) { acc[nb] = acc[nb] * r_kv; ss += (acc[nb][0] * acc[nb][0] + acc[nb][1] * acc[nb][1]) + (acc[nb][2] * acc[nb][2] + acc[nb][3] * acc[nb][3]); }
            const float rh = __builtin_amdgcn_rsqf((quad_sum(ss) + skr) * (1.0f / QK_HEAD) + EPS);
#pragma unroll
            for (int nb = 0; nb < 4; ++nb) UP_PUT(nb, acc[nb] * rh * gkv(nb));
            const f32x4 x1 = kr0 * rh * gkv(4), x2 = kr1 * rh * gkv(5);
            UP_PUT(4, x1 * cs - x2 * sn); UP_PUT(5, x2 * cs + x1 * sn);
            UP_PUT(6, ((f32x4){0.f, 0.f, 0.f, 0.f})); UP_PUT(7, ((f32x4){0.f, 0.f, 0.f, 0.f}));
            UP_FLUSH(wsp(F, WS_K) + orow0);
#pragma unroll
            for (int nb = 0; nb < 8; ++nb) UP_PUT(nb, acc[4 + nb] * r_kv);
            UP_FLUSH(wsp(F, WS_V) + orow0);
        }
        asm volatile("s_waitcnt vmcnt(8) lgkmcnt(0)" ::: "memory"); __builtin_amdgcn_s_barrier(); asm volatile("" ::: "memory");
    }
#undef gqv
#undef gkv
#undef UP_DMAQ
#undef UP_DMAKV
#undef UP_PUT
#undef UP_RD
#undef UP_RDQ
#undef UP_RDKV
#undef UP_FLUSH
}

constexpr int VS = 136;
__device__ __forceinline__ void p2_sgu_pool_unit(Frame& F, int l, int chunk, int cut = 0) {
    int lane_ = F.lane; asm volatile("" : "+v"(lane_));
    const int lane = lane_, tl = lane & 15, kq = lane >> 4, w = F.wave;
    LAS bf16* vnT = (LAS bf16*)(F.lds + RING_OFF);
    LAS unsigned char* pt = F.lds + RING_OFF + 69632;
    LAS unsigned char* stg = F.lds + RING_OFF + 145152 + w * 2304;
    const bf16* Z = wsp(F, WS_Z);
    const unsigned char* wl = F.a->ws + WS_W + (size_t)l * LW;
    const int t = w * 16 + tl, m = chunk * CHUNK + t, s = m & (SEQ - 1);
    const bf16* zrow = Z + (size_t)m * ZLD;
    v4u pv[9];
    { const int tid = w * 64 + lane, m0 = chunk * CHUNK, s0 = m0 & (SEQ - 1);
#pragma unroll
      for (int i = 0; i < 9; ++i) { const int c = tid + 512 * i, r = c >> 5, k = c & 31; pv[i] = (v4u){0u, 0u, 0u, 0u};
          if (c < 143 * 32 && s0 + r >= 15) pv[i] = *(const GAS v4u*)(Z + (size_t)(m0 - 15 + r) * ZLD + ZO_P + k * 8); } }
    u32x2 vws[16];
#pragma unroll
    for (int i = 0; i < 16; ++i) vws[i] = *(const u32x2*)(Z + (size_t)(chunk * CHUNK + w * 16 + i) * ZLD + ZO_V + 4 * lane);
    const f32x4 gv = *(const f32x4*)(IN_F(10) + l * SGU_W + 4 * lane);
    bf16x8 bfr[4][4];
#pragma unroll
    for (int ks = 0; ks < 4; ++ks)
#pragma unroll
        for (int h = 0; h < 4; ++h) bfr[ks][h] = *(const bf16x8*)(wl + OW_SP + ((size_t)(h * CHUNK + t) * CHUNK + ks * 32 + kq * 8) * 2);
    { float vv[4][16];
#pragma unroll
      for (int i = 0; i < 16; ++i) { const f32x4 v = {bflo(vws[i].x), bfhi(vws[i].x), bflo(vws[i].y), bfhi(vws[i].y)};
          const float r = __builtin_amdgcn_rsqf(wave_sum_dpp((v[0] * v[0] + v[1] * v[1]) + (v[2] * v[2] + v[3] * v[3])) * (1.0f / SGU_W) + EPS);
#pragma unroll
          for (int j = 0; j < 4; ++j) vv[j][i] = v[j] * r * gv[j]; }
#pragma unroll
      for (int j = 0; j < 4; ++j) { *(LAS bf16x8*)(vnT + (j * 64 + lane) * VS + w * 16) = pk8(&vv[j][0]); *(LAS bf16x8*)(vnT + (j * 64 + lane) * VS + w * 16 + 8) = pk8(&vv[j][8]); } }
    { const int tid = w * 64 + lane;
#pragma unroll
      for (int i = 0; i < 9; ++i) { const int c = tid + 512 * i, r = c >> 5, k = c & 31; if (c < 143 * 32) *(LAS v4u*)(pt + r * 528 + k * 16) = pv[i]; } }
    __syncthreads();
#ifdef PROBE_CUT
    if (cut == 1) { __syncthreads(); return; }
#endif
    unsigned char* mixw = (unsigned char*)(wsp(F, WS_MIX) + (size_t)(chunk * CHUNK + w * 16) * DM);
    {
        v4u uw[4][2]; float bsp[4];
#pragma unroll
        for (int h = 0; h < 4; ++h) { bsp[h] = IN_F(12)[(size_t)(l * 4 + h) * CHUNK + t];
#pragma unroll
            for (int e = 0; e < 2; ++e) uw[h][e] = *(const v4u*)(zrow + ZO_U + h * 64 + 16 * kq + 8 * e); }
        f32x4 acc[4][4];
#pragma unroll
        for (int h = 0; h < 4; ++h)
#pragma unroll
            for (int db = 0; db < 4; ++db) acc[h][db] = (f32x4){0.f, 0.f, 0.f, 0.f};
#pragma unroll
        for (int ks = 0; ks < 4; ++ks) {
#pragma unroll
            for (int h = 0; h < 4; ++h)
#pragma unroll
                for (int db = 0; db < 4; ++db) { const bf16x8 a = *(const LAS bf16x8*)(vnT + (db * 64 + h * 16 + tl) * VS + ks * 32 + kq * 8); acc[h][db] = mfma16(a, bfr[ks][h], acc[h][db]); }
            __builtin_amdgcn_sched_barrier(0);
        }
        float ss = 0.f;
#pragma unroll
        for (int h = 0; h < 4; ++h) { const unsigned uu[8] = {uw[h][0].x, uw[h][0].y, uw[h][0].z, uw[h][0].w, uw[h][1].x, uw[h][1].y, uw[h][1].z, uw[h][1].w};
#pragma unroll
            for (int r = 0; r < 4; ++r)
#pragma unroll
                for (int db = 0; db < 4; ++db) { const int c = 4 * r + db; const float u = (c & 1) ? bfhi(uu[c >> 1]) : bflo(uu[c >> 1]); const float g = u * (acc[h][db][r] + bsp[h]); acc[h][db][r] = g; ss += g * g; } }
        const float rB = __builtin_amdgcn_rsqf(quad_sum(ss) * (1.0f / SGU_W) + EPS);
#pragma unroll
        for (int h = 0; h < 4; ++h) { float o[16];
#pragma unroll
            for (int r = 0; r < 4; ++r)
#pragma unroll
                for (int db = 0; db < 4; ++db) o[4 * r + db] = acc[h][db][r] * rB;
            unsigned char* dst = mixw + (size_t)tl * (DM * 2) + (512 + h * 64 + 16 * kq) * 2;
            *(GAS bf16x8*)dst = pk8(&o[0]); *(GAS bf16x8*)(dst + 16) = pk8(&o[8]); }
    }
#ifdef PROBE_CUT
    if (cut == 2) { __syncthreads(); return; }
#endif
    {
        f32x4 acc[4][4];
#pragma unroll
        for (int g = 0; g < 4; ++g)
#pragma unroll
            for (int db = 0; db < 4; ++db) acc[g][db] = (f32x4){0.f, 0.f, 0.f, 0.f};
        const bf16* wp = (const bf16*)(wl + OW_POOL);
        const LAS unsigned char* pb = pt + (15 + t) * 528 + kq * 16;
        bf16x8 wa[2][4], wn[2][4];
#pragma unroll
        for (int ks = 0; ks < 2; ++ks)
#pragma unroll
            for (int db = 0; db < 4; ++db) wa[ks][db] = *(const bf16x8*)(wp + (size_t)(db * 16 + tl) * 64 + ks * 32 + kq * 8);
#pragma unroll
        for (int g = 0; g < 4; ++g) { const int win = 2 << g; const int cnt = (s + 1 < win) ? s + 1 : win; const float rc = 1.0f / (float)cnt;
            if (g < 3) {
#pragma unroll
                for (int ks = 0; ks < 2; ++ks)
#pragma unroll
                    for (int db = 0; db < 4; ++db) wn[ks][db] = *(const bf16x8*)(wp + (size_t)((g + 1) * 64 + db * 16 + tl) * 64 + ks * 32 + kq * 8); }
#pragma unroll
            for (int ks = 0; ks < 2; ++ks) {
                float sum[8], cur[8];
                { const v4u pw = *(const LAS v4u*)(pb + (g * 64 + ks * 32) * 2); const unsigned ww[4] = {pw.x, pw.y, pw.z, pw.w};
#pragma unroll
                  for (int j = 0; j < 4; ++j) { cur[2 * j] = bflo(ww[j]); cur[2 * j + 1] = bfhi(ww[j]); sum[2 * j] = cur[2 * j]; sum[2 * j + 1] = cur[2 * j + 1]; } }
#pragma unroll
                for (int jj = 1; jj < win; ++jj) { const v4u pw = *(const LAS v4u*)(pb - jj * 528 + (g * 64 + ks * 32) * 2); const unsigned ww[4] = {pw.x, pw.y, pw.z, pw.w};
#pragma unroll
                  for (int j = 0; j < 4; ++j) { sum[2 * j] += bflo(ww[j]); sum[2 * j + 1] += bfhi(ww[j]); } }
                float mv[8];
#pragma unroll
                for (int j = 0; j < 8; ++j) mv[j] = sum[j] * rc - cur[j];
                const bf16x8 bfrag = pk8(mv);
#pragma unroll
                for (int db = 0; db < 4; ++db) acc[g][db] = mfma16(wa[ks][db], bfrag, acc[g][db]);
            }
#pragma unroll
            for (int ks = 0; ks < 2; ++ks)
#pragma unroll
                for (int db = 0; db < 4; ++db) wa[ks][db] = wn[ks][db];
            __builtin_amdgcn_sched_barrier(0);
        }
        float ss = 0.f;
#pragma unroll
        for (int g = 0; g < 4; ++g)
#pragma unroll
            for (int db = 0; db < 4; ++db) { const f32x4 y = acc[g][db];
                ss += (y[0] * y[0] + y[1] * y[1]) + (y[2] * y[2] + y[3] * y[3]); }
        const float rC = __builtin_amdgcn_rsqf(quad_sum(ss) * (1.0f / POOL_W) + EPS);
#pragma unroll
        for (int g = 0; g < 4; ++g) {
#pragma unroll
            for (int db = 0; db < 4; ++db) *(LAS u32x2*)(stg + tl * 144 + db * 32 + kq * 8) = pk4(acc[g][db] * rC);
#pragma unroll
            for (int i = 0; i < 2; ++i) *(GAS v4u*)(mixw + (size_t)(8 * i + (lane >> 3)) * (DM * 2) + (768 + g * 64) * 2 + (lane & 7) * 16) = *(const LAS v4u*)(stg + (8 * i + (lane >> 3)) * 144 + (lane & 7) * 16);
        }
    }
    __syncthreads();
}

#ifndef ATT_SPLIT
#define ATT_SPLIT 1
#endif
constexpr int ATT_MAXI = 2;
__device__ const unsigned char att_nsp_tab[32] = {1,1,1,1,1,1,1,1,1,1,1,1,2,2,1,1,1,2,2,3,2,2,3,3,3,3,3,3,2,3,2,4};
__device__ const unsigned char att_tab[32 * ATT_MAXI * 4] = {
    16,0,0,68, 255,0,0,0,
    15,0,0,64, 255,0,0,0,
    30,1,62,124, 255,0,0,0,
    30,0,0,62, 255,0,0,0,
    14,0,0,60, 255,0,0,0,
    28,1,58,116, 1,0,0,8,
    28,0,0,58, 0,0,0,4,
    11,0,0,48, 2,0,0,12,
    21,1,44,88, 5,0,0,24,
    21,0,0,44, 4,0,0,20,
    10,0,0,44, 3,0,0,16,
    20,1,42,84, 12,1,26,52,
    20,0,0,42, 12,0,0,26,
    29,2,80,120, 6,0,0,28,
    29,1,40,80, 19,2,53,80,
    29,0,0,40, 19,1,26,53,
    9,0,0,40, 19,0,0,26,
    27,2,74,112, 22,0,0,30,
    18,1,38,76, 13,1,28,56,
    18,0,0,38, 13,0,0,28,
    27,1,37,74, 22,2,61,92,
    27,0,0,37, 22,1,30,61,
    26,2,72,108, 31,1,32,64,
    26,1,36,72, 31,0,0,32,
    26,0,0,36, 23,2,64,96,
    17,1,36,72, 23,1,32,64,
    17,0,0,36, 23,0,0,32,
    8,0,0,36, 7,0,0,32,
    25,2,69,104, 31,3,96,128,
    25,1,34,69, 31,2,64,96,
    25,0,0,34, 24,1,33,66,
    24,2,66,100, 24,0,0,33,
};
__constant__ const unsigned att_tab32[32 * ATT_MAXI] = {0x44000010u, 0x000000ffu, 0x4000000fu, 0x000000ffu, 0x7c3e011eu, 0x000000ffu, 0x3e00001eu, 0x000000ffu, 0x3c00000eu, 0x000000ffu, 0x743a011cu, 0x08000001u, 0x3a00001cu, 0x04000000u, 0x3000000bu, 0x0c000002u, 0x582c0115u, 0x18000005u, 0x2c000015u, 0x14000004u, 0x2c00000au, 0x10000003u, 0x542a0114u, 0x341a010cu, 0x2a000014u, 0x1a00000cu, 0x7850021du, 0x1c000006u, 0x5028011du, 0x50350213u, 0x2800001du, 0x351a0113u, 0x28000009u, 0x1a000013u, 0x704a021bu, 0x1e000016u, 0x4c260112u, 0x381c010du, 0x26000012u, 0x1c00000du, 0x4a25011bu, 0x5c3d0216u, 0x2500001bu, 0x3d1e0116u, 0x6c48021au, 0x4020011fu, 0x4824011au, 0x2000001fu, 0x2400001au, 0x60400217u, 0x48240111u, 0x40200117u, 0x24000011u, 0x20000017u, 0x24000008u, 0x20000007u, 0x68450219u, 0x8060031fu, 0x45220119u, 0x6040021fu, 0x22000019u, 0x42210118u, 0x64420218u, 0x21000018u};
__constant__ const unsigned att_nsp32[32] = {1,1,1,1,1,1,1,1,1,1,1,1,2,2,1,1,1,2,2,3,2,2,3,3,3,3,3,3,2,3,2,4};
__device__ __forceinline__ int att_nsplit(int qb) { return ATT_SPLIT ? (int)att_nsp32[__builtin_amdgcn_readfirstlane(qb)] : 1; }
__device__ __forceinline__ void p4_combine(Frame& F) {
    const int gw = F.vcu * NWAVES + F.wave, NGW = F.G * NWAVES, lane = F.lane, h = lane >> 4, d0 = (lane & 15) * 8;
    const float2* ML = (const float2*)(F.a->ws + WS_ML);
    for (int m0 = gw * 4; m0 < M; m0 += NGW * 4) {
        const int b = m0 >> 13, s0 = m0 & (SEQ - 1), bh = b * NHEAD + h, nsp = att_nsplit(s0 >> 8);
        const size_t row0 = (size_t)bh * SEQ + s0;
        float li[4][4]; v4u ow[4][4];
#pragma unroll
        for (int r = 0; r < 4; ++r)
#pragma unroll
            for (int i = 0; i < 4; ++i) if (i < nsp) { li[r][i] = ML[(size_t)i * 8 * SEQ + row0 + r].y; ow[r][i] = *(const v4u*)(F.a->ws + opart_off(i) + ((row0 + r) * 128 + d0) * 2); }
#pragma unroll
        for (int r = 0; r < 4; ++r) {
            float a[8] = {0.f, 0.f, 0.f, 0.f, 0.f, 0.f, 0.f, 0.f}, wsum = 0.f;
#pragma unroll
            for (int i = 0; i < 4; ++i) if (i < nsp) { const float wgt = li[r][i]; wsum += wgt; const unsigned ww[4] = {ow[r][i].x, ow[r][i].y, ow[r][i].z, ow[r][i].w};
#pragma unroll
                for (int j = 0; j < 4; ++j) { a[2 * j] += wgt * bflo(ww[j]); a[2 * j + 1] += wgt * bfhi(ww[j]); } }
            const float rw = 1.0f / wsum; float ss = 0.f;
#pragma unroll
            for (int j = 0; j < 8; ++j) { a[j] *= rw; ss += a[j] * a[j]; }
            const float rA = __builtin_amdgcn_rsqf(wave_sum_dpp(ss) * (1.0f / 512.0f) + EPS);
#pragma unroll
            for (int j = 0; j < 8; ++j) a[j] *= rA;
            *(bf16x8*)(wsp(F, WS_MIX) + (size_t)(m0 + r) * DM + h * 128 + d0) = pk8(a);
        }
    }
}

struct AttnSchedPaired {
    int bh, idx;
    __device__ __forceinline__ bool get(int i, attn::Item& it) const {
        if (idx >= 16 || i >= 2) return false;
        it.bh = bh; it.qb = (i == 0) ? idx : 31 - idx; it.jlo = 0; it.jhi = 4 * (it.qb + 1); it.chunk = 0; return true;
    }
};
struct AttnSchedSplit {
    int bid, G;
    __device__ __forceinline__ bool get(int i, attn::Item& it) const {
        int cnt = 0;
        for (int slot = bid; slot < 256; slot += G)
#pragma unroll
            for (int j = 0; j < ATT_MAXI; ++j) {
#ifdef PROBE_SPREAD
                const unsigned e = att_tab32[(slot & 31) * ATT_MAXI + j]; const int bh = slot >> 5;
#else
                const unsigned e = att_tab32[(slot >> 3) * ATT_MAXI + j]; const int bh = slot & 7;
#endif
                if ((e & 255u) != 255u) { if (cnt == i) { it.bh = bh; it.qb = (int)(e & 255u); it.chunk = (int)((e >> 8) & 255u); it.jlo = (int)((e >> 16) & 255u); it.jhi = (int)(e >> 24); return true; } ++cnt; } }
        return false;
    }
};

__device__ __forceinline__ XcdBarrier mk_bar(const Frame& F) {
    XcdBarrier b; b.bar = (unsigned*)(F.a->ws + WS_CTL) + CW_BAR; b.x = xb_xcc_id(); b.st = (volatile LAS unsigned*)(F.lds + MISC_OFF) + 8; return b;
}
__device__ __forceinline__ void grid_bar(const Frame& F) { xcd_barrier(mk_bar(F)); }
__device__ __forceinline__ void group_bar(const Frame& F) {
    asm volatile("s_waitcnt vmcnt(0)" ::: "memory");
    __syncthreads();
    if (threadIdx.x == 0) {
        __builtin_amdgcn_s_waitcnt(0);
        unsigned* w = (unsigned*)(F.a->ws + WS_CTL) + CW_GB + 64 * ((int)blockIdx.x & 63);
        volatile LAS unsigned* st = (volatile LAS unsigned*)(F.lds + MISC_OFF) + 8;
        const unsigned same = st[3];
        if (same == 0u) { const unsigned o = __hip_atomic_fetch_or(w + 1, 1u << xb_xcc_id(), __ATOMIC_RELAXED, __HIP_MEMORY_SCOPE_AGENT); asm volatile("" :: "v"(o)); }
        if (same != 1u) { __builtin_amdgcn_fence(__ATOMIC_RELEASE, "agent"); asm volatile("s_waitcnt vmcnt(0)" ::: "memory"); }
        const unsigned old = xb_add(w, 1u), tgt = (old / 4u + 1u) * 4u;
        __builtin_amdgcn_fence(__ATOMIC_ACQUIRE, "agent");
        asm volatile("s_waitcnt vmcnt(0)" ::: "memory");
        XB_SPIN(xb_ld(w) < tgt, (unsigned*)(F.a->ws + WS_CTL) + CW_BAR);
        if (same == 0u) { const unsigned m = xb_ld(w + 1); st[3] = (m & (m - 1u)) == 0u ? 1u : 2u; }
    }
    __syncthreads();
}
__global__ void __launch_bounds__(NWAVES * 64, 2) hybrid_fwd(Args args_) {
    extern __shared__ __attribute__((aligned(16))) unsigned char lds[];
    (void)args_;
    const CAS Args* ap0 = (const CAS Args*)__builtin_amdgcn_kernarg_segment_ptr();
    { const int tid = threadIdx.x;
      for (int u = tid; u < (LDS_BYTES - LDSCTL_OFF) / 4; u += NWAVES * 64) ((LAS unsigned*)((LAS unsigned char*)lds + LDSCTL_OFF))[u] = 0u;
      __syncthreads();
      if (N_LAUNCHES == 1) (void)xcd_barrier_post((unsigned*)(ap0->ws + WS_CTL) + CW_BAR, (volatile LAS unsigned*)((LAS unsigned char*)lds + MISC_OFF) + 8); }
    const int p_lo = ap0->ph_lo;
#ifdef PROBE_TWICE
    int twice_ = 0;
#endif
#ifdef PROBE_Q
    int rep_ = 0;
#endif
#pragma unroll 1
    for (int p = p_lo;; ++p) {
        const CAS Args* ap = ap0; asm volatile("" : "+s"(ap));
        if (p >= ap->ph_hi) break;
        Frame F; F.lds = (LAS unsigned char*)lds; F.a = ap;
        { int tid = threadIdx.x; asm volatile("" : "+v"(tid)); F.lane = tid & 63; F.wave = __builtin_amdgcn_readfirstlane(tid >> 6); }
        F.G = gridDim.x; { const int bx = blockIdx.x; F.vcu = (F.G % 8 == 0) ? (bx % 8) * (F.G / 8) + bx / 8 : bx; }
        const int l = (p - 1) / PH_PER_LAYER, q = (p == 0) ? -1 : (p - 1) % PH_PER_LAYER;
        bool split_done = false;
        unsigned char* wl = F.a->ws + WS_W + (size_t)l * LW;
        if (q == -1) p0_prologue(F);
        else if (q == 0) {
            pg8::Gemm g{wsp(F, WS_XB), (const bf16*)(wl + OW_IN), M, ZLD, DM}; pg8::StaticOrder S; S.init(M, ZLD, F.G, (int)blockIdx.x);
            pg8::EpiScaleBf16 E{wsp(F, WS_Z), ZLD, ssq_mix(F, l), 1.0f / DM, EPS};
            pg8::gemm_phase<pg8::EpiScaleBf16, pg8::StaticOrder, GEMM_ALIGN, GEMM_SP2>(F.lds + RING_OFF, g, S, E);
            if (SPLIT_BAR && N_LAUNCHES == 1 && p + 1 < F.a->ph_hi) { xcd_barrier_arrive(mk_bar(F)); split_done = true; }
            if (CONV_DEFER) {
                const int nwg = (M / 256) * (ZLD / 256), rem = nwg % F.G, c = (int)blockIdx.x;
                const int first = (l > 0 && CONV_TAIL) ? CI_SPLIT : 0, last = CONV_DOWN_LATE ? CI_OUT + 2 * CI_G : CI_SET1;
                if (rem == 0) conv_set(F, l, 1, c * NWAVES + F.wave, F.G * NWAVES, first, last); else if (c >= rem) conv_set(F, l, 1, (c - rem) * NWAVES + F.wave, (F.G - rem) * NWAVES, first, last);
            }
        } else if (q == 1) {
#if defined(PROBE_SUB) && PROBE_SUB == 2
            if (rep_ == 0)
#endif
#ifdef PROBE_Q
            for (int u = F.vcu; u < M / CHUNK; u += F.G) p2_upproj_unit(F, l, u, rep_ == 1);
#elif defined(P2_INTERLEAVE)
            for (int v = F.vcu; v < 2 * (M / CHUNK); v += F.G) if (!(v & 1)) p2_upproj_unit(F, l, v >> 1);
#else
            for (int u = F.vcu; u < M / CHUNK; u += F.G) p2_upproj_unit(F, l, u);
#endif
#if defined(PROBE_SUB) && PROBE_SUB == 1
            if (rep_ == 0)
#endif
#ifdef P2_INTERLEAVE
            for (int v = F.vcu; v < 2 * (M / CHUNK); v += F.G) if (v & 1) p2_sgu_pool_unit(F, l, v >> 1);
#else
            for (int u = F.vcu + ((M / CHUNK - F.vcu + F.G - 1) / F.G) * F.G; u < 2 * (M / CHUNK); u += F.G)
#ifdef PROBE_CUT
                p2_sgu_pool_unit(F, l, u - M / CHUNK, rep_ == 1 ? PROBE_CUT : 0);
#else
                p2_sgu_pool_unit(F, l, u - M / CHUNK);
#endif
#endif
        } else if (q == 2) {
            const float cshift = *(const float*)(wl + OW_END);
            const attn::Tensors AT{(const attn::bf16*)wsp(F, WS_Q), (const attn::bf16*)wsp(F, WS_K), (const attn::bf16*)wsp(F, WS_V), (attn::bf16*)(F.a->ws + opart_off(0)), (attn::bf16*)(F.a->ws + opart_off(2)), (float2*)(F.a->ws + WS_ML), cshift
#if defined(PROBE_RACY) || defined(PROBE_HALF)
                , rep_ == 0 ? 1 : 0
#endif
            };
#if ATT_SPLIT
            const AttnSchedSplit S{(int)blockIdx.x, F.G};
            attn::attn_phase<AttnSchedSplit>((char*)lds + RING_OFF, AT, S);
#else
            const AttnSchedPaired S{(int)(blockIdx.x & 7), (int)(blockIdx.x >> 3)};
            attn::attn_phase<AttnSchedPaired>((char*)lds + RING_OFF, AT, S);
#endif
        } else if (q == 3) p4_combine(F);
        else if (q == 5) {
            pg8::Gemm g{wsp(F, WS_XB), (const bf16*)(wl + OW_GU), M, FF2, DM}; pg8::StaticOrder S; S.init(M, FF2, F.G, (int)blockIdx.x);
            pg8::EpiSwiglu E{wsp(F, WS_H), FF, ssq_ffn(F, l), 1.0f / DM, EPS};
#ifdef PROBE_DRYEPI
            if (rep_ == 1) E.H = nullptr;
#endif
#ifdef PROBE_NOMMA
            if (rep_ == 1) { E.H = nullptr; g.M = 0; }
#endif
            pg8::gemm_phase<pg8::EpiSwiglu, pg8::StaticOrder, GEMM_ALIGN, GEMM_SP2>(F.lds + RING_OFF, g, S, E);
            if (CONV_DEFER && CONV_DOWN_LATE) {
                const int nwg = (M / 256) * (FF2 / 256), rem = nwg % F.G, c = (int)blockIdx.x;
                if (rem != 0 && c >= rem) conv_set(F, l, 1, (c - rem) * NWAVES + F.wave, (F.G - rem) * NWAVES, CI_OUT + 2 * CI_G, CI_SET1);
                else if (rem == 0) conv_set(F, l, 1, c * NWAVES + F.wave, F.G * NWAVES, CI_OUT + 2 * CI_G, CI_SET1);
            }
            if (CONV_DEFER && CONV_TAIL && l + 1 < DEPTH) {
                const int nwg = (M / 256) * (FF2 / 256), rem = nwg % F.G, c = (int)blockIdx.x;
                if (rem != 0 && c >= rem) conv_set(F, l + 1, 1, (c - rem) * NWAVES + F.wave, (F.G - rem) * NWAVES, 0, CI_SPLIT);
                else if (rem == 0) conv_set(F, l + 1, 1, c * NWAVES + F.wave, F.G * NWAVES, 0, CI_SPLIT);
            }
        } else {
            const bool dn = q == 6, nx = l + 1 < DEPTH;
            pg8::Gemm g{dn ? wsp(F, WS_H) : wsp(F, WS_MIX), (const bf16*)(wl + (dn ? OW_DN : OW_OUT)), M, DM, dn ? FF : DM}; pg8::StaticOrder S; S.init(M, DM, F.G, (int)blockIdx.x);
            pg8::EpiResid E{wsp(F, WS_XB), (dn && !nx) ? F.a->out : nullptr, (dn && !nx) ? nullptr : wsp(F, WS_XB), dn ? (nx ? ssq_mix(F, l + 1) : nullptr) : ssq_ffn(F, l), DM};
#ifdef PROBE_Q
            if (q == PROBE_Q && rep_ == 0) { E.out = nullptr; E.xb = nullptr; if (E.ssq) E.ssq = (float*)(F.a->ws + 204 * MiB); }
#endif
            pg8::gemm_phase<pg8::EpiResid, pg8::StaticOrder, GEMM_ALIGN, GEMM_SP2>(F.lds + RING_OFF, g, S, E);
        }
        if (split_done) xcd_barrier_wait(mk_bar(F));
        else if (N_LAUNCHES == 1 && p + 1 < F.a->ph_hi) {
            if (GROUP_BAR && F.G == 256 && q >= 4) group_bar(F); else grid_bar(F);
        }
#ifdef PROBE_GBAR
        if (N_LAUNCHES == 1 && p + 1 < F.a->ph_hi && GROUP_BAR && F.G == 256 && q >= 4) { for (int xb_ = 0; xb_ < PROBE_GBAR; ++xb_) group_bar(F); }
#endif
#ifdef PROBE_XBAR
        if (N_LAUNCHES == 1 && p + 1 < F.a->ph_hi) { for (int xb_ = 0; xb_ < PROBE_XBAR; ++xb_) grid_bar(F); }
#endif
#ifdef PROBE_TWICE
        if (p + 1 == F.a->ph_hi && twice_ < PROBE_TWICE) { ++twice_; grid_bar(F); p = -1; }
#endif
#ifdef PROBE_Q
        if (q == PROBE_Q && rep_ == 0) { rep_ = 1; --p; } else rep_ = 0;
#endif
    }
}

extern "C" void kernel_launch(void* const* d_in, const int* in_sizes, int n_in, void* d_out, int out_size, void* d_ws, size_t ws_size, hipStream_t stream) {
    static int grid = 0;
    if (grid == 0) {
        if (n_in != 23 || in_sizes[0] != M * DM || out_size != M * DM || ws_size < WS_END) { fprintf(stderr, "kernel_launch: shape mismatch (n_in %d, in0 %d, out %d, ws %zu)\n", n_in, n_in > 0 ? in_sizes[0] : -1, out_size, ws_size); grid = -1; return; }
        int dev = 0, cus = 0, per_cu = 0;
        if (hipGetDevice(&dev) != hipSuccess || hipDeviceGetAttribute(&cus, hipDeviceAttributeMultiprocessorCount, dev) != hipSuccess) { fprintf(stderr, "kernel_launch: device query failed\n"); grid = -1; return; }
        if (hipFuncSetAttribute((const void*)hybrid_fwd, hipFuncAttributeMaxDynamicSharedMemorySize, LDS_BYTES) != hipSuccess) { fprintf(stderr, "kernel_launch: hipFuncSetAttribute failed\n"); grid = -1; return; }
        if (hipOccupancyMaxActiveBlocksPerMultiprocessor(&per_cu, (const void*)hybrid_fwd, NWAVES * 64, LDS_BYTES) != hipSuccess || per_cu < 1)
            fprintf(stderr, "kernel_launch: note: occupancy query reports %d workgroups per CU\n", per_cu);
        (void)hipGetLastError();
        grid = cus;
        if (grid != 256) fprintf(stderr, "kernel_launch: note: %d CUs (tuned for 256)\n", grid);
    }
    if (grid < 0) return;
    if (hipMemsetAsync((char*)d_ws + WS_CTL, 0, CTL_ZERO_BYTES, stream) != hipSuccess) { fprintf(stderr, "kernel_launch: hipMemsetAsync failed\n"); return; }
#ifdef PROBE_MEMSET2
    for (int i = 0; i < PROBE_MEMSET2; ++i) (void)hipMemsetAsync((char*)d_ws + WS_CTL, 0, CTL_ZERO_BYTES, stream);
#endif
    Args a{};
    for (int i = 0; i < 23; ++i) a.in[i] = (const float*)d_in[i];
    a.out = (float*)d_out; a.ws = (unsigned char*)d_ws;
#ifdef PROBE_PRO
    a.ph_lo = 0; a.ph_hi = 1; a.li = 0;
    hipLaunchKernelGGL(hybrid_fwd, dim3(grid), dim3(NWAVES * 64), LDS_BYTES, stream, a);
    (void)hipMemsetAsync((char*)d_ws + WS_CTL, 0, CTL_ZERO_BYTES, stream);
#endif
    for (int li = 0; li < N_LAUNCHES; ++li) {
        a.ph_lo = (N_LAUNCHES == 1) ? 0 : li; a.ph_hi = (N_LAUNCHES == 1) ? NPH : li + 1; a.li = li;
        hipLaunchKernelGGL(hybrid_fwd, dim3(grid), dim3(NWAVES * 64), LDS_BYTES, stream, a);
        const hipError_t le = hipPeekAtLastError();
        if (le != hipSuccess) { fprintf(stderr, "kernel_launch: launch %d failed: %s\n", li, hipGetErrorName(le)); break; }
    }
}
```

```cpp
#include <hip/hip_runtime.h>
#include <hip/hip_bf16.h>
#include <cstdio>
#include <cstdint>
#ifndef PG8_WGM
#define PG8_WGM 8
#endif

namespace pg8 {
#define PG8_LAS __attribute__((address_space(3)))
typedef unsigned short bf16_t;
typedef short bf16x8 __attribute__((ext_vector_type(8)));
typedef float f32x4 __attribute__((ext_vector_type(4)));
typedef unsigned u32x4 __attribute__((ext_vector_type(4)));
constexpr int BM = 256, BK = 64, HALF = 128, HTB = HALF * BK * 2  , STAGE_BYTES = 8 * HTB, NXCD = 8, WGM = PG8_WGM;

__host__ __device__ __forceinline__ int lds_byte(int r, int c) { const int st = (r >> 4) * 2 + (c >> 5), rr = r & 15, cc = c & 31, ob = rr * 64 + cc * 2; return st * 1024 + (ob ^ (((ob >> 9) & 1) << 5)); }
__host__ __device__ __forceinline__ void stage_rc(int b, int& R, int& C) { const int st = b / 1024, sb = b % 1024, swz = sb ^ (((sb >> 9) & 1) << 5); R = (st >> 1) * 16 + swz / 64; C = (st & 1) * 32 + (swz % 64) / 2; }
__host__ __device__ __forceinline__ int perm32(int rho) { const int n = rho >> 4, i = rho & 15; return 8 * (i >> 2) + 4 * n + (i & 3); }

struct Unit { int pm, pn; };
struct Gemm { const bf16_t* A; const bf16_t* Bt; int M, N, K; };

struct StaticOrder {
    int nM, nN, nwg, G, c;
    __host__ __device__ void init(int M, int N, int G_, int c_) { nM = M / BM; nN = N / BM; nwg = nM * nN; G = G_; c = c_; }
    __host__ __device__ bool next(int i, Unit& u) const {
        const long L = (long)i * G + c; if (L >= nwg) return false;
        int wgid = (int)L; { const int q = nwg / NXCD, r = nwg % NXCD, xcd = wgid % NXCD, off = wgid / NXCD; wgid = (xcd < r ? xcd * (q + 1) : r * (q + 1) + (xcd - r) * q) + off; }
        const int nig = WGM * nN, gid = wgid / nig, fm = gid * WGM, gsz = (nM - fm) < WGM ? (nM - fm) : WGM;
        u.pm = fm + ((wgid % nig) % gsz); u.pn = (wgid % nig) / gsz; return true;
    }
    __device__ __forceinline__ void a_ready(const Unit&) const {}
    __device__ __forceinline__ void done(const Unit&) const {}
};


__device__ __forceinline__ unsigned cvt_pk_bf16(float lo, float hi) { unsigned r; asm volatile("v_cvt_pk_bf16_f32 %0, %1, %2" : "=v"(r) : "v"(lo), "v"(hi)); return r; }
typedef float f32x2 __attribute__((ext_vector_type(2)));

typedef unsigned u32x2 __attribute__((ext_vector_type(2)));
#ifndef EPI_WT
#define EPI_WT 0
#endif
#ifndef RESID_FENCE
#define RESID_FENCE(m) ((m) & 1)
#endif
#ifndef EPI_PRE
#define EPI_PRE true
#endif
__device__ __forceinline__ void st16(void* p, u32x4 v) {
#if EPI_WT
    asm volatile("global_store_dwordx4 %0, %1, off sc1\n\ts_nop 1" :: "v"(p), "v"(v) : "memory");
#else
    *(u32x4*)p = v;
#endif
}
__device__ __forceinline__ void st16f(void* p, f32x4 v) { st16(p, __builtin_bit_cast(u32x4, v)); }
__device__ __forceinline__ void st8(void* p, u32x2 v) {
#if EPI_WT
    asm volatile("global_store_dwordx2 %0, %1, off sc1\n\ts_nop 1" :: "v"(p), "v"(v) : "memory");
#else
    *(u32x2*)p = v;
#endif
}
struct EpiScaleBf16 {
    static constexpr bool PERM = true, AFTER_DRAIN = false, PRE = EPI_PRE;
    bf16_t* O; int ldc; const float* ssq; float inv_n, eps;
    __device__ __forceinline__ void operator()(const f32x4 (&acc)[2][2][4][2], const Unit& u, int wr, int wc, int fr, int fq, const PG8_LAS float* ssl = nullptr) const {
        const int row0 = u.pm * BM + wr * 64 + fr, col0 = u.pn * BM + wc * 32 + 8 * fq;
        float rr[2][4];
#pragma unroll
        for (int ai = 0; ai < 2; ++ai)
#pragma unroll
            for (int m = 0; m < 4; ++m) rr[ai][m] = PRE ? ssl[wr * 64 + fr + ai * HALF + m * 16] : ssq[row0 + ai * HALF + m * 16];
#pragma unroll
        for (int ai = 0; ai < 2; ++ai)
#pragma unroll
            for (int m = 0; m < 4; ++m) { const int row = row0 + ai * HALF + m * 16; const float r = __builtin_amdgcn_rsqf(rr[ai][m] * inv_n + eps); bf16_t* rowp = O + (size_t)row * ldc + col0;
#pragma unroll
                for (int bj = 0; bj < 2; ++bj) { const f32x4 v0 = acc[ai][bj][m][0] * r, v1 = acc[ai][bj][m][1] * r;
                    u32x4 w; w.x = cvt_pk_bf16(v0[0], v0[1]); w.y = cvt_pk_bf16(v0[2], v0[3]); w.z = cvt_pk_bf16(v1[0], v1[1]); w.w = cvt_pk_bf16(v1[2], v1[3]);
                    st16(rowp + bj * HALF, w); } }
    }
};
struct EpiSwiglu {
    static constexpr bool PERM = true, AFTER_DRAIN = false, PRE = EPI_PRE;
    bf16_t* H; int ldh; const float* ssq; float inv_n, eps;
    __device__ __forceinline__ static float swi(float g, float u) { return g * __builtin_amdgcn_rcpf(1.0f + __builtin_amdgcn_exp2f(g * -1.4426950408889634f)) * u; }
    __device__ __forceinline__ void operator()(const f32x4 (&acc)[2][2][4][2], const Unit& u, int wr, int wc, int fr, int fq, const PG8_LAS float* ssl = nullptr) const {
        const int row0 = u.pm * BM + wr * 64 + fr, col0 = u.pn * HALF + wc * 32 + 8 * fq;
#ifdef PROBE_DRYEPI
        if (!H) { asm volatile("" :: "v"(acc[0][0][0][0]), "v"(acc[1][1][3][1])); return; }
#endif
        float rr[2][4];
#pragma unroll
        for (int ai = 0; ai < 2; ++ai)
#pragma unroll
            for (int m = 0; m < 4; ++m) rr[ai][m] = PRE ? ssl[wr * 64 + fr + ai * HALF + m * 16] : ssq[row0 + ai * HALF + m * 16];
#pragma unroll
        for (int ai = 0; ai < 2; ++ai)
#pragma unroll
            for (int m = 0; m < 4; ++m) { const int row = row0 + ai * HALF + m * 16; const float r = __builtin_amdgcn_rsqf(rr[ai][m] * inv_n + eps);
                const f32x4 g0 = acc[ai][0][m][0] * r, g1 = acc[ai][0][m][1] * r, u0 = acc[ai][1][m][0] * r, u1 = acc[ai][1][m][1] * r;
                u32x4 w; w.x = cvt_pk_bf16(swi(g0[0], u0[0]), swi(g0[1], u0[1])); w.y = cvt_pk_bf16(swi(g0[2], u0[2]), swi(g0[3], u0[3]));
                w.z = cvt_pk_bf16(swi(g1[0], u1[0]), swi(g1[1], u1[1])); w.w = cvt_pk_bf16(swi(g1[2], u1[2]), swi(g1[3], u1[3]));
                st16(H + (size_t)row * ldh + col0, w); }
    }
};
struct EpiResid {
    static constexpr bool PERM = true, AFTER_DRAIN = false, PRE = false;
    const bf16_t* base16; float* out; bf16_t* xb; float* ssq; int ldc;
    __device__ __forceinline__ void operator()(const f32x4 (&acc)[2][2][4][2], const Unit& u, int wr, int wc, int fr, int fq) const {
        const int row0 = u.pm * BM + wr * 64 + fr, col0 = u.pn * BM + wc * 32 + 8 * fq;
#pragma unroll
        for (int ai = 0; ai < 2; ++ai) {
            u32x4 bw[4][2];
#pragma unroll
            for (int m = 0; m < 4; ++m)
#pragma unroll
                for (int bj = 0; bj < 2; ++bj) bw[m][bj] = *(const u32x4*)(base16 + (size_t)(row0 + ai * HALF + m * 16) * ldc + col0 + bj * HALF);
            asm volatile("" ::: "memory");
#pragma unroll
            for (int m = 0; m < 4; ++m) { const int row = row0 + ai * HALF + m * 16; const size_t off = (size_t)row * ldc + col0; float s = 0.f;
#pragma unroll
                for (int bj = 0; bj < 2; ++bj) { const u32x4 w4 = bw[m][bj];
                    f32x4 o0 = (f32x4){__builtin_bit_cast(float, w4.x << 16), __builtin_bit_cast(float, w4.x & 0xffff0000u), __builtin_bit_cast(float, w4.y << 16), __builtin_bit_cast(float, w4.y & 0xffff0000u)};
                    f32x4 o1 = (f32x4){__builtin_bit_cast(float, w4.z << 16), __builtin_bit_cast(float, w4.z & 0xffff0000u), __builtin_bit_cast(float, w4.w << 16), __builtin_bit_cast(float, w4.w & 0xffff0000u)};
                    o0 = o0 + acc[ai][bj][m][0]; o1 = o1 + acc[ai][bj][m][1];
                    if (out) { *(f32x4*)(out + off + bj * HALF) = o0; *(f32x4*)(out + off + bj * HALF + 4) = o1; }
                    s += ((o0[0] * o0[0] + o0[1] * o0[1]) + (o0[2] * o0[2] + o0[3] * o0[3])) + ((o1[0] * o1[0] + o1[1] * o1[1]) + (o1[2] * o1[2] + o1[3] * o1[3]));
                    if (xb) { u32x4 w; w.x = cvt_pk_bf16(o0[0], o0[1]); w.y = cvt_pk_bf16(o0[2], o0[3]); w.z = cvt_pk_bf16(o1[0], o1[1]); w.w = cvt_pk_bf16(o1[2], o1[3]); *(u32x4*)(xb + off + bj * HALF) = w; } }
                if (ssq) { s += __shfl_xor(s, 16); s += __shfl_xor(s, 32); if (fq == 0) atomicAdd(ssq + row, s); } }
            asm volatile("" ::: "memory");
        }
    }
};


template <class Epi, class Sched, bool ALIGN_EPI = false, bool SP2 = false>
__device__ __forceinline__ void gemm_phase(PG8_LAS unsigned char* lds, const Gemm g, const Sched& S, const Epi& E) {
    int tid_ = threadIdx.x; asm volatile("" : "+v"(tid_));
    const int tid = tid_, wid = __builtin_amdgcn_readfirstlane(tid >> 6), lane = tid & 63, wr = wid >> 2, wc = wid & 3, fr = lane & 15, fq = lane >> 4;
    const int K = g.K, nt = K / BK;
    unsigned voffA[2], voffB[2];
#pragma unroll
    for (int i = 0; i < 2; ++i) { int R, C; stage_rc(tid * 16 + i * 8192, R, C); const int Rb = Epi::PERM ? ((R & ~31) + perm32(R & 31)) : R;
        voffA[i] = (unsigned)(R * K + C) * 2u; voffB[i] = (unsigned)(Rb * K + C) * 2u; }
    const size_t kstep = (size_t)(BK * 2);
    const size_t hstep = (size_t)HALF * K * 2;
    const size_t tstep = 2 * hstep;
    const unsigned ldsw = (unsigned)wid * 1024u;
    const int aoff = lds_byte(wr * 64 + fr, fq * 8), boff = lds_byte(wc * 32 + fr, fq * 8);
#define PG8_SA(b, h) (((b) * 2 + (h)) * HTB)
#define PG8_SB(b, h) ((4 + (b) * 2 + (h)) * HTB)
#define PG8_STAGE(bufoff, gbase, voff) do { _Pragma("unroll") for (int _i = 0; _i < 2; ++_i) \
        __builtin_amdgcn_global_load_lds((const unsigned*)((const char*)(gbase) + (voff)[_i]), (PG8_LAS unsigned*)(lds + (bufoff) + ldsw + _i * 8192), 16, 0, 0); } while (0)
#define PG8_LDA(dst, b, h) do { _Pragma("unroll") for (int m = 0; m < 4; ++m) _Pragma("unroll") for (int k = 0; k < 2; ++k) dst[m][k] = *(const PG8_LAS bf16x8*)(lds + PG8_SA(b, h) + aoff + m * 2048 + k * 1024); } while (0)
#define PG8_LDB(dst, b, h) do { _Pragma("unroll") for (int n = 0; n < 2; ++n) _Pragma("unroll") for (int k = 0; k < 2; ++k) dst[n][k] = *(const PG8_LAS bf16x8*)(lds + PG8_SB(b, h) + boff + n * 2048 + k * 1024); } while (0)
#ifdef PROBE_NOMMA
#define PG8_MMA_ON (g.M != 0)
#else
#define PG8_MMA_ON true
#endif
#define PG8_MMA(ai, bj, At, Bt) do { if (!PG8_MMA_ON) break; __builtin_amdgcn_s_setprio(1); _Pragma("unroll") for (int m = 0; m < 4; ++m) _Pragma("unroll") for (int n = 0; n < 2; ++n) _Pragma("unroll") for (int k = 0; k < 2; ++k) \
        acc[ai][bj][m][n] = __builtin_amdgcn_mfma_f32_16x16x32_bf16(Bt[n][k], At[m][k], acc[ai][bj][m][n], 0, 0, 0); __builtin_amdgcn_s_setprio(0); } while (0)
#define PG8_WAIT_V(n) asm volatile("s_waitcnt vmcnt(" #n ")" ::: "memory")
#define PG8_WAIT_L(n) asm volatile("s_waitcnt lgkmcnt(" #n ")" ::: "memory")
#define PG8_BAR __builtin_amdgcn_s_barrier()
#define PG8_SCHED __builtin_amdgcn_sched_barrier(0)
    PG8_LAS unsigned char* const ssl_base = lds + STAGE_BYTES;
#define PG8_PRE(u, i) do { if constexpr (Epi::PRE) __builtin_amdgcn_global_load_lds((const unsigned*)(E.ssq + (size_t)(u).pm * BM + (wid & 3) * 64 + lane), \
        (PG8_LAS unsigned*)(ssl_base + ((i) & 1) * 2048 + wid * 256), 4, 0, 0); } while (0)
    Unit cur, nxt; int ui = 0;
    if (!S.next(0, cur)) return;
    f32x4 acc[2][2][4][2];
#pragma unroll
    for (int a = 0; a < 2; ++a)
#pragma unroll
        for (int b = 0; b < 2; ++b)
#pragma unroll
            for (int m = 0; m < 4; ++m)
#pragma unroll
                for (int n = 0; n < 2; ++n) acc[a][b][m][n] = (f32x4){0.f, 0.f, 0.f, 0.f};
    bf16x8 At[4][2], B0[2][2], B1[2][2];
#ifdef PROBE_SAMETILE
    const size_t tsA = (g.N == 0) ? 0 : tstep, tsB = (g.N == 0) ? (PROBE_SAMETILE == 2 ? tstep : 0) : tstep;
#else
    const size_t tsA = tstep, tsB = tstep;
#endif
    const char* cA = (const char*)g.A + (size_t)cur.pm * tsA; const char* cB = (const char*)g.Bt + (size_t)cur.pn * tsB;
    S.a_ready(cur);
    PG8_PRE(cur, 0);
    if constexpr (SP2) {
        PG8_STAGE(PG8_SB(0, 0), cB, voffB); PG8_STAGE(PG8_SB(0, 1), cB + hstep, voffB); PG8_STAGE(PG8_SA(0, 0), cA, voffA); PG8_STAGE(PG8_SA(0, 1), cA + hstep, voffA);
        if (wr == 1) PG8_BAR;
        PG8_WAIT_V(2); PG8_BAR;
        PG8_STAGE(PG8_SB(1, 0), cB + kstep, voffB); PG8_STAGE(PG8_SA(1, 0), cA + kstep, voffA); PG8_STAGE(PG8_SB(1, 1), cB + hstep + kstep, voffB);
        PG8_WAIT_V(6); PG8_BAR;
    } else {
        PG8_STAGE(PG8_SB(0, 0), cB, voffB); PG8_STAGE(PG8_SA(0, 0), cA, voffA); PG8_STAGE(PG8_SB(0, 1), cB + hstep, voffB); PG8_STAGE(PG8_SA(0, 1), cA + hstep, voffA);
        if (wr == 1) PG8_BAR;
        PG8_WAIT_V(4); PG8_BAR;
        PG8_STAGE(PG8_SB(1, 0), cB + kstep, voffB); PG8_STAGE(PG8_SA(1, 0), cA + kstep, voffA); PG8_STAGE(PG8_SB(1, 1), cB + hstep + kstep, voffB);
        PG8_WAIT_V(6); PG8_BAR;
    }
    for (;;) {
        const bool has_next = S.next(ui + 1, nxt);
        const char* nA = has_next ? (const char*)g.A + (size_t)nxt.pm * tsA : cA; const char* nB = has_next ? (const char*)g.Bt + (size_t)nxt.pn * tsB : cB;
        for (int t = 0; t < nt; t += 2) {
            const bool last = (t == nt - 2);
            const char* a1 = cA + (size_t)(t + 1) * kstep;
            const char* a2 = last ? nA : cA + (size_t)(t + 2) * kstep; const char* b2 = last ? nB : cB + (size_t)(t + 2) * kstep;
            const char* a3 = a2 + kstep; const char* b3 = b2 + kstep;
            if (last && has_next) S.a_ready(nxt);
            if constexpr (SP2) {
            PG8_LDB(B0, 0, 0); PG8_LDB(B1, 0, 1); PG8_SCHED; PG8_LDA(At, 0, 0); PG8_STAGE(PG8_SA(1, 1), a1 + hstep, voffA);
            PG8_WAIT_V(8); PG8_WAIT_L(0); PG8_BAR; PG8_MMA(0, 0, At, B0); PG8_MMA(0, 1, At, B1); PG8_BAR; PG8_SCHED;
            PG8_LDA(At, 0, 1); PG8_STAGE(PG8_SB(0, 0), b2, voffB); PG8_STAGE(PG8_SB(0, 1), b2 + hstep, voffB); PG8_STAGE(PG8_SA(0, 0), a2, voffA);
            PG8_WAIT_V(8); PG8_WAIT_L(0); PG8_BAR; PG8_MMA(1, 0, At, B0); PG8_MMA(1, 1, At, B1); PG8_BAR; PG8_SCHED;
            PG8_LDB(B0, 1, 0); PG8_LDB(B1, 1, 1); PG8_SCHED; PG8_LDA(At, 1, 0); PG8_STAGE(PG8_SA(0, 1), a2 + hstep, voffA);
            PG8_WAIT_V(8); PG8_WAIT_L(0); PG8_BAR; PG8_MMA(0, 0, At, B0); PG8_MMA(0, 1, At, B1); PG8_BAR; PG8_SCHED;
            PG8_LDA(At, 1, 1); PG8_STAGE(PG8_SB(1, 0), b3, voffB); PG8_STAGE(PG8_SB(1, 1), b3 + hstep, voffB); PG8_STAGE(PG8_SA(1, 0), a3, voffA);
            PG8_WAIT_V(8); PG8_WAIT_L(0); PG8_BAR; PG8_MMA(1, 0, At, B0); PG8_MMA(1, 1, At, B1); PG8_BAR; PG8_SCHED;
            } else {
            PG8_LDB(B0, 0, 0); PG8_SCHED; PG8_LDA(At, 0, 0); PG8_STAGE(PG8_SA(1, 1), a1 + hstep, voffA);
            PG8_WAIT_L(8); PG8_BAR; PG8_WAIT_L(0); PG8_MMA(0, 0, At, B0); PG8_BAR; PG8_SCHED;
            PG8_LDB(B1, 0, 1); PG8_STAGE(PG8_SB(0, 0), b2, voffB);
            PG8_BAR; PG8_WAIT_L(0); PG8_MMA(0, 1, At, B1); PG8_BAR;
            PG8_LDA(At, 0, 1); PG8_STAGE(PG8_SA(0, 0), a2, voffA);
            PG8_BAR; PG8_WAIT_L(0); PG8_MMA(1, 0, At, B0); PG8_BAR; PG8_SCHED;
            PG8_STAGE(PG8_SB(0, 1), b2 + hstep, voffB);
            PG8_WAIT_V(6); PG8_BAR; PG8_MMA(1, 1, At, B1); PG8_BAR;
            PG8_LDB(B0, 1, 0); PG8_SCHED; PG8_LDA(At, 1, 0); PG8_STAGE(PG8_SA(0, 1), a2 + hstep, voffA);
            PG8_WAIT_L(8); PG8_BAR; PG8_WAIT_L(0); PG8_MMA(0, 0, At, B0); PG8_BAR; PG8_SCHED;
            PG8_LDB(B1, 1, 1); PG8_STAGE(PG8_SB(1, 0), b3, voffB);
            PG8_BAR; PG8_WAIT_L(0); PG8_MMA(0, 1, At, B1); PG8_BAR;
            PG8_LDA(At, 1, 1); PG8_STAGE(PG8_SA(1, 0), a3, voffA);
            PG8_BAR; PG8_WAIT_L(0); PG8_MMA(1, 0, At, B0); PG8_BAR; PG8_SCHED;
            PG8_STAGE(PG8_SB(1, 1), b3 + hstep, voffB);
            PG8_WAIT_V(6); PG8_BAR; PG8_MMA(1, 1, At, B1); PG8_BAR;
            }
        }
        if constexpr (ALIGN_EPI) { if (wr == 0) PG8_BAR; }
        if constexpr (Epi::PRE) { E(acc, cur, wr, wc, fr, fq, (const PG8_LAS float*)(ssl_base + (ui & 1) * 2048)); S.done(cur); }
        else if constexpr (!Epi::AFTER_DRAIN) { E(acc, cur, wr, wc, fr, fq); S.done(cur); }
        if (!has_next) break;
#pragma unroll
        for (int a = 0; a < 2; ++a)
#pragma unroll
            for (int b = 0; b < 2; ++b)
#pragma unroll
                for (int m = 0; m < 4; ++m)
#pragma unroll
                    for (int n = 0; n < 2; ++n) acc[a][b][m][n] = (f32x4){0.f, 0.f, 0.f, 0.f};
        cur = nxt; cA = nA; cB = nB; ++ui;
        PG8_PRE(cur, ui);
        if constexpr (ALIGN_EPI) { if (wr == 1) PG8_BAR; }
    }
    PG8_WAIT_V(0);
    if constexpr (!ALIGN_EPI) { if (wr == 0) PG8_BAR; }
    PG8_BAR;
    if constexpr (Epi::AFTER_DRAIN) { E.fused(acc, cur, wr, wc, fr, fq, lds, wid, lane); S.done(cur); }
#undef PG8_SA
#undef PG8_SB
#undef PG8_STAGE
#undef PG8_LDA
#undef PG8_LDB
#undef PG8_MMA
#undef PG8_WAIT_V
#undef PG8_WAIT_L
#undef PG8_BAR
#undef PG8_SCHED
#undef PG8_PRE
}
}

namespace attn {
constexpr int D = 128, NQD = 6;
constexpr float THR = 8.f;
#ifndef ATT_WSKIP
#define ATT_WSKIP false
#endif
constexpr bool WSKIP = ATT_WSKIP;
constexpr float SCALE = 0.10206207261596575f;
constexpr int NW = 8, QBLK = 32, KVBLK = 64, QB = NW * QBLK;
constexpr int SHM_V = KVBLK * D * 2, SHM_K = KVBLK * D * 2;
constexpr int LDS_BYTES = 2 * SHM_V + 2 * SHM_K + NW * 64 * 4;

using bf16 = __hip_bfloat16;
typedef short bf16x8 __attribute__((ext_vector_type(8)));
typedef short s16x4 __attribute__((ext_vector_type(4)));
typedef float f32x16 __attribute__((ext_vector_type(16)));
typedef float f32x4 __attribute__((ext_vector_type(4)));
typedef unsigned u32x4 __attribute__((ext_vector_type(4)));
template <class A, class Bt> struct same_t { static constexpr bool v = false; };
template <class A> struct same_t<A, A> { static constexpr bool v = true; };

#define KSWZ(row, colB) ((row) * 256 + ((colB) ^ (((row) & 7) << 4)))
#define SBAR() __builtin_amdgcn_sched_barrier(0)
__device__ __forceinline__ int v_st(int k, int c) { const int kk = (k & ~0xC) | ((k & 4) << 1) | ((k & 8) >> 1); return ((kk >> 3) * 4 + (c >> 5)) * 512 + ((kk & 7) * 32 + (c & 31)) * 2; }
__device__ __forceinline__ int v_rd_base(int lane) { return ((lane & 3) << 3) | (((lane >> 2) & 3) << 6) | (((lane >> 4) & 1) << 5) | (((lane >> 5) & 1) << 8); }
constexpr int v_rd_off(int d0, int ks, int half) { return d0 * 512 + ks * 4096 + half * 2048; }
__device__ __forceinline__ int crow(int r, int hi) { return (r & 3) + 8 * (r >> 2) + 4 * hi; }
__device__ __forceinline__ unsigned cvtpk(float lo, float hi) {
    unsigned r; asm volatile("v_cvt_pk_bf16_f32 %0, %1, %2" : "=v"(r) : "v"(lo), "v"(hi)); return r;
}
__device__ __forceinline__ bf16x8 pack8(f32x4 a, f32x4 b) {
    u32x4 w = {cvtpk(a[0], a[1]), cvtpk(a[2], a[3]), cvtpk(b[0], b[1]), cvtpk(b[2], b[3])};
    return *reinterpret_cast<bf16x8*>(&w);
}
template <class T> __device__ __forceinline__ bf16x8 load8(const T* p) {
    if constexpr (same_t<T, float>::v) { return pack8(*(const f32x4*)p, *(const f32x4*)(p + 4)); }
    else { return *reinterpret_cast<const bf16x8*>(p); }
}
__device__ __forceinline__ void mask_tile(f32x16& p0, f32x16& p1, int dq, unsigned W) {
    const float NEG = -__builtin_inff();
#pragma unroll
    for (int r = 0; r < 16; ++r) {
        const int c = (r & 3) + 8 * (r >> 2);
        if ((unsigned)(dq - c) >= W) p0[r] = NEG;
        if ((unsigned)(dq - c - 32) >= W) p1[r] = NEG;
    }
}
__device__ __forceinline__ void partialSM(f32x16& p0, f32x16& p1, float& m_reg, float& mn, float& alpha, float cshift) {
    (void)m_reg; mn = 0.f; alpha = 1.f;
    if (__builtin_expect(cshift != 0.f, 0)) { for (int r = 0; r < 16; ++r) { p0[r] -= cshift; p1[r] -= cshift; } }
    for (int r = 0; r < 16; ++r) p0[r] = __builtin_amdgcn_exp2f(p0[r]);
}
__device__ __forceinline__ void finishSM(f32x16& p0, f32x16& p1, float alpha, float& l_reg, bf16x8& pa0, bf16x8& pa1, bf16x8& pa2, bf16x8& pa3) {
    for (int r = 0; r < 16; ++r) p1[r] = __builtin_amdgcn_exp2f(p1[r]);
    float ps = 0; for (int r = 0; r < 16; ++r) ps += p0[r]; for (int r = 0; r < 16; ++r) ps += p1[r];
    { auto rr = __builtin_amdgcn_permlane32_swap(__float_as_uint(ps), __float_as_uint(ps), false, false);
      ps = __uint_as_float(rr[0]) + __uint_as_float(rr[1]); }
    l_reg += ps; (void)alpha;
#define PK4(P, B_, OUT) do { unsigned a0 = cvtpk(P[B_+0], P[B_+1]), a1 = cvtpk(P[B_+2], P[B_+3]);                          \
        unsigned b0 = cvtpk(P[B_+4], P[B_+5]), b1 = cvtpk(P[B_+6], P[B_+7]);                                             \
        auto r0 = __builtin_amdgcn_permlane32_swap(a0, b0, false, false); auto r1 = __builtin_amdgcn_permlane32_swap(a1, b1, false, false); \
        u32x4 w = {r0[0], r1[0], r0[1], r1[1]}; OUT = *reinterpret_cast<bf16x8*>(&w); } while (0)
    PK4(p0, 0, pa0); PK4(p0, 8, pa1); PK4(p1, 0, pa2); PK4(p1, 8, pa3);
#undef PK4
}
template <int KB, bool SK>
__device__ __forceinline__ void qkt(f32x16& p0, f32x16& p1, const char* K_lds, int r32, int hi, const bf16x8* qr, bool act) {
    if (SK && !act) { const float NEG = -__builtin_inff();
#pragma unroll
        for (int r = 0; r < 16; ++r) { p0[r] = NEG; p1[r] = NEG; } return; }
    p0 = f32x16{}; p1 = f32x16{};
    const char* kb[4];
#pragma unroll
    for (int dd = 0; dd < 4; ++dd) kb[dd] = K_lds + KB * SHM_K + KSWZ(r32, (dd * 16 + hi * 8) * 2);
#pragma unroll
    for (int d0 = 0; d0 < NQD; ++d0) { const char* a = kb[d0 & 3] + (d0 >> 2) * 128;
        bf16x8 b0 = *reinterpret_cast<const bf16x8*>(a);
        bf16x8 b1 = *reinterpret_cast<const bf16x8*>(a + 32 * 256);
        p0 = __builtin_amdgcn_mfma_f32_32x32x16_bf16(b0, qr[d0], p0, 0, 0, 0);
        p1 = __builtin_amdgcn_mfma_f32_32x32x16_bf16(b1, qr[d0], p1, 0, 0, 0); }
}
template <int VB, bool SK>
__device__ __forceinline__ void pv_tile(f32x16* o, int vb0, bf16x8 pa0, bf16x8 pa1, bf16x8 pa2, bf16x8 pa3, bool act) {
    if (SK && !act) return;
#define TRRD(dst, off) asm volatile("ds_read_b64_tr_b16 %0, %1 offset:%2" : "=&v"(dst) : "v"(vb0), "i"(off) : "memory")
#define PV_D0(d0) do { s16x4 l0, l1, l2, l3, h0, h1, h2, h3; constexpr int b_ = VB * SHM_V + v_rd_off(d0, 0, 0);     \
        TRRD(l0, b_); TRRD(h0, b_ + 2048); TRRD(l1, b_ + 4096); TRRD(h1, b_ + 6144); TRRD(l2, b_ + 8192); TRRD(h2, b_ + 10240); TRRD(l3, b_ + 12288); TRRD(h3, b_ + 14336); \
        asm volatile("s_waitcnt lgkmcnt(0)" ::: "memory"); SBAR();                 \
        o[d0] = __builtin_amdgcn_mfma_f32_32x32x16_bf16(pa0, (bf16x8){l0[0], l0[1], l0[2], l0[3], h0[0], h0[1], h0[2], h0[3]}, o[d0], 0, 0, 0);   \
        o[d0] = __builtin_amdgcn_mfma_f32_32x32x16_bf16(pa1, (bf16x8){l1[0], l1[1], l1[2], l1[3], h1[0], h1[1], h1[2], h1[3]}, o[d0], 0, 0, 0);   \
        o[d0] = __builtin_amdgcn_mfma_f32_32x32x16_bf16(pa2, (bf16x8){l2[0], l2[1], l2[2], l2[3], h2[0], h2[1], h2[2], h2[3]}, o[d0], 0, 0, 0);   \
        o[d0] = __builtin_amdgcn_mfma_f32_32x32x16_bf16(pa3, (bf16x8){l3[0], l3[1], l3[2], l3[3], h3[0], h3[1], h3[2], h3[3]}, o[d0], 0, 0, 0); } while (0)
    PV_D0(0); PV_D0(1); PV_D0(2); PV_D0(3);
#undef PV_D0
#undef TRRD
}

template <class TIn, class TOut> struct BlockRef { const TIn* Q; const TIn* K; const TIn* V; TOut* O; float2* ML; int P0; int jlo; int jhi; float cshift; };
template <class TIn> struct Seam {
    bf16x8 qr[NQD];
    bf16x8 st_v0, st_v1, st_k0, st_k1; f32x4 sf0, sf1, sf2, sf3;
    f32x4 tq[1];
};
__device__ __forceinline__ int swa_jlo(int P0, int W) { const int lowk = P0 - W + 1; return lowk > 0 ? lowk / KVBLK : 0; }
#define ROW(p, k0, rr) ((p) + (size_t)((k0) + (rr)) * D + sc)
#define VMW() asm volatile("s_waitcnt vmcnt(0)" ::: "memory")
#define VMWN(n) asm volatile("s_waitcnt vmcnt(%0)" :: "i"(n) : "memory")
#define SLOAD_H(Kp, Vp, k0) do { S.st_v0 = load8<TIn>(ROW(Vp, k0, sr)); S.st_v1 = load8<TIn>(ROW(Vp, k0, 32 + sr));              \
                         S.st_k0 = load8<TIn>(ROW(Kp, k0, sr)); S.st_k1 = load8<TIn>(ROW(Kp, k0, 32 + sr)); } while (0)
#define SWRITE_HK(bf) do { *(bf16x8*)(K_lds + (bf) * SHM_K + kws) = S.st_k0; *(bf16x8*)(K_lds + (bf) * SHM_K + kws + 32 * 256) = S.st_k1; } while (0)
#define SWRITE_HV(bf) do { *(bf16x8*)(V_lds + (bf) * SHM_V + vst0) = S.st_v0; *(bf16x8*)(V_lds + (bf) * SHM_V + vst1) = S.st_v1; } while (0)
#define SWRITE_H(bf) do { SWRITE_HV(bf); SWRITE_HK(bf); } while (0)
#define SLOAD_F(p, k0) do { S.sf0 = *(const f32x4*)ROW(p, k0, sr); S.sf1 = *(const f32x4*)(ROW(p, k0, sr) + 4);                \
                            S.sf2 = *(const f32x4*)ROW(p, k0, 32 + sr); S.sf3 = *(const f32x4*)(ROW(p, k0, 32 + sr) + 4); } while (0)
#define SWRITE_KF(bf) do { *(bf16x8*)(K_lds + (bf) * SHM_K + kws) = pack8(S.sf0, S.sf1); *(bf16x8*)(K_lds + (bf) * SHM_K + kws + 32 * 256) = pack8(S.sf2, S.sf3); } while (0)
#define SWRITE_VF(bf) do { *(bf16x8*)(V_lds + (bf) * SHM_V + vst0) = pack8(S.sf0, S.sf1); *(bf16x8*)(V_lds + (bf) * SHM_V + vst1) = pack8(S.sf2, S.sf3); } while (0)
template <class TIn, class TOut>
__device__ __forceinline__ void causal_swa_prime(const BlockRef<TIn, TOut>& cur, int W, char* lds, Seam<TIn>& S) {
    constexpr bool F32 = same_t<TIn, float>::v;
    int tid_ = threadIdx.x; asm volatile("" : "+v"(tid_));
    const int tid = tid_, wid = __builtin_amdgcn_readfirstlane(tid >> 6), lane = tid & 63, r32 = lane & 31, hi = lane >> 5;
    const int sr = tid >> 4, sc = (tid & 15) * 8, kws = KSWZ(sr, sc * 2); char* K_lds = lds + 2 * SHM_V;
    const int kb0 = cur.jlo * KVBLK;
    for (int d0 = 0; d0 < NQD; ++d0) S.qr[d0] = load8<TIn>(cur.Q + (size_t)(wid * QBLK + r32) * D + d0 * 16 + hi * 8);
    if constexpr (F32) { SLOAD_F((const float*)cur.K, kb0); VMW(); SWRITE_KF(0); SBAR(); SLOAD_F((const float*)cur.V, kb0); }
    else { SLOAD_H(cur.K, cur.V, kb0); VMW(); SWRITE_HK(0); }
    __syncthreads();
}
template <class TIn, class TOut>
__device__ __forceinline__ void causal_swa_block(const BlockRef<TIn, TOut>& cur, const BlockRef<TIn, TOut>& nxt, int skv, int W, char* lds, Seam<TIn>& S) {
    constexpr bool F32 = same_t<TIn, float>::v;
    int tid_ = threadIdx.x; asm volatile("" : "+v"(tid_));
    const int tid = tid_, wid = __builtin_amdgcn_readfirstlane(tid >> 6), lane = tid & 63, r32 = lane & 31, hi = lane >> 5;
    const int j_lo = cur.jlo; const int j_hi = cur.jhi; (void)skv;
    const int NT = j_hi - j_lo;
    const int kbn = nxt.jlo * KVBLK;
    const int qlo = cur.P0 + wid * QBLK, qm = qlo + r32 - 4 * hi;
    char* V_lds = lds; char* K_lds = lds + 2 * SHM_V;
    float* ws = (float*)(lds + 2 * SHM_V + 2 * SHM_K) + wid * 64; float* li_l = ws, * al_l = ws + 32;
    float m_reg = -1e30f, l_reg = 0; f32x16 o[4] = {};
    const int sr = tid >> 4, sc = (tid & 15) * 8, vst0 = v_st(sr, sc), vst1 = v_st(32 + sr, sc), kws = KSWZ(sr, sc * 2);
    const int vb0 = (int)(uintptr_t)V_lds + v_rd_base(lane);
    const TIn* Kh = cur.K; const TIn* Vh = cur.V;
#define RESC(a) do { (void)(a); (void)al_l; } while (0)
#define KBASE(t) ((j_lo + (t)) * KVBLK)
#define ACT(t) (KBASE(t) <= qlo + QBLK - 1 && KBASE(t) + KVBLK - 1 >= qlo - W + 1)
#define MASKT(P0_, P1_, t) do { const int kb_ = KBASE(t); if ((!SK || ACT(t)) && (kb_ + KVBLK - 1 > qlo || kb_ <= qlo + QBLK - 1 - W)) mask_tile(P0_, P1_, qm - kb_, (unsigned)W); } while (0)
    constexpr int NQL = F32 ? 16 : NQD;
    constexpr bool SK = WSKIP && !F32;
#define SEAM_K0() do { VMWN(NQL); if constexpr (F32) { SWRITE_KF(0); SBAR(); SLOAD_F((const float*)nxt.V, kbn); } else { SWRITE_HK(0); } SBAR(); } while (0)
    f32x16 pA0, pA1, pB0, pB1; float mnA, mnB, alA, alB; bf16x8 pa0, pa1, pa2, pa3;
    if constexpr (F32) { VMW(); SWRITE_VF(0); SBAR(); } else { SWRITE_HV(0); SBAR(); }
    if (NT > 1) { if constexpr (F32) SLOAD_F((const float*)Kh, KBASE(1)); else SLOAD_H(Kh, Vh, KBASE(1)); }
    SBAR(); qkt<0, SK>(pA0, pA1, K_lds, r32, hi, S.qr, ACT(0));
    if constexpr (F32) { if (NT > 1) { VMW(); SWRITE_KF(1); SBAR(); SLOAD_F((const float*)Vh, KBASE(1)); } }
    MASKT(pA0, pA1, 0); partialSM(pA0, pA1, m_reg, mnA, alA, cur.cshift);
    if (NT > 1) { VMW(); if constexpr (F32) { SWRITE_VF(1); SBAR(); if (NT > 2) SLOAD_F((const float*)Kh, KBASE(2)); } else SWRITE_H(1); }
    __syncthreads();
#define HALF_STEP(PX0, PX1, mnX, alX, PY0, PY1, alY, t, KB, VB, SB) do {                                                      \
        SBAR(); qkt<KB, SK>(PX0, PX1, K_lds, r32, hi, S.qr, ACT(t));                                             \
        finishSM(PY0, PY1, alY, l_reg, pa0, pa1, pa2, pa3); SBAR();                                                           \
        if ((t) + 1 < NT) { if constexpr (F32) { VMW(); SWRITE_KF(SB); SBAR(); SLOAD_F((const float*)Vh, KBASE((t) + 1)); }  \
                            else { SLOAD_H(Kh, Vh, KBASE((t) + 1)); } SBAR(); }                                               \
        pv_tile<VB, SK>(o, vb0, pa0, pa1, pa2, pa3, ACT((t) - 1)); MASKT(PX0, PX1, (t)); partialSM(PX0, PX1, m_reg, mnX, alX, cur.cshift);                                        \
        __syncthreads();                                                                                                      \
        if ((t) + 1 < NT) { VMW(); if constexpr (F32) { SWRITE_VF(SB); SBAR(); if ((t) + 2 < NT) SLOAD_F((const float*)Kh, KBASE((t) + 2)); } \
                            else { SWRITE_H(SB); } }                                                                          \
        RESC(alX); __syncthreads(); } while (0)
    for (int t = 1; t + 1 < NT; t += 2) {
        HALF_STEP(pB0, pB1, mnB, alB, pA0, pA1, alA, t, 1, 0, 0);
        HALF_STEP(pA0, pA1, mnA, alA, pB0, pB1, alB, t + 1, 0, 1, 1);
    }
    const bool even = (NT & 1) == 0;
    if (even) { SBAR(); qkt<1, SK>(pB0, pB1, K_lds, r32, hi, S.qr, ACT(NT - 1)); SBAR(); }
#define QROW(e) (nxt.Q + (size_t)(wid * QBLK + r32) * D + ((e) >> 1) * 16 + hi * 8 + ((e) & 1) * 4)
    if constexpr (F32) { SLOAD_F((const float*)nxt.K, kbn); SBAR();
#pragma unroll
        for (int e = 0; e < 8; ++e) S.tq[e] = *(const f32x4*)QROW(e); }
    else { SLOAD_H(nxt.K, nxt.V, kbn); SBAR();
#pragma unroll
        for (int d0 = 0; d0 < NQD; ++d0) S.qr[d0] = load8<TIn>(nxt.Q + (size_t)(wid * QBLK + r32) * D + d0 * 16 + hi * 8); }
    SBAR();
    finishSM(pA0, pA1, alA, l_reg, pa0, pa1, pa2, pa3); SBAR();
    if constexpr (F32) {
#pragma unroll
        for (int e = 8; e < 16; ++e) S.tq[e] = *(const f32x4*)QROW(e); SBAR(); }
#undef QROW
    pv_tile<0, SK>(o, vb0, pa0, pa1, pa2, pa3, ACT(even ? NT - 2 : NT - 1));
    if (even) { MASKT(pB0, pB1, NT - 1); partialSM(pB0, pB1, m_reg, mnB, alB, cur.cshift); __syncthreads(); RESC(alB);
        finishSM(pB0, pB1, alB, l_reg, pa0, pa1, pa2, pa3); SBAR(); pv_tile<1, SK>(o, vb0, pa0, pa1, pa2, pa3, ACT(NT - 1)); }
    SBAR(); SEAM_K0();
    if (hi == 0) { li_l[r32] = l_reg; cur.ML[wid * QBLK + r32] = make_float2(0.f, l_reg); } asm volatile("s_waitcnt lgkmcnt(0)" ::: "memory");
    float rli[16];
#pragma unroll
    for (int r = 0; r < 16; ++r) rli[r] = __builtin_amdgcn_rcpf(li_l[crow(r, hi)]);
    TOut* Ow = cur.O + (size_t)(wid * QBLK) * D;
#pragma unroll
    for (int r = 0; r < 16; ++r) { const int orow = crow(r, hi);
#pragma unroll
        for (int d0 = 0; d0 < 4; ++d0) { const float v = o[d0][r] * rli[r];
            if constexpr (same_t<TOut, float>::v) { Ow[(size_t)orow * D + d0 * 32 + r32] = v; }
            else { *(unsigned short*)(lds + LDS_BYTES + wid * 8704 + orow * 272 + (d0 * 32 + r32) * 2) = (unsigned short)(cvtpk(v, v) & 0xffffu); } } }
    if constexpr (!same_t<TOut, float>::v) {
#pragma unroll
        for (int i = 0; i < 8; ++i) { const int row = 4 * i + (lane >> 4), c16 = lane & 15;
            *(u32x4*)((char*)Ow + (size_t)row * (D * 2) + c16 * 16) = *(const u32x4*)(lds + LDS_BYTES + wid * 8704 + row * 272 + c16 * 16); } }
    if constexpr (F32) {
#pragma unroll
        for (int d0 = 0; d0 < NQD; ++d0) S.qr[d0] = pack8(S.tq[2 * d0], S.tq[2 * d0 + 1]); }
    if constexpr (!F32) {
#pragma unroll
        for (int d0 = 0; d0 < NQD; ++d0) asm volatile("" : "+v"(S.qr[d0]));
        asm volatile("" : "+v"(S.st_v0), "+v"(S.st_v1)); }
    __syncthreads();
#undef RESC
#undef KBASE
#undef ACT
#undef MASKT
#undef SEAM_K0
#undef HALF_STEP
}
#undef ROW
#undef VMW
#undef VMWN
#undef SLOAD_H
#undef SWRITE_HK
#undef SWRITE_HV
#undef SWRITE_H
#undef SLOAD_F
#undef SWRITE_KF
#undef SWRITE_VF

struct Item { int bh, qb, jlo, jhi, chunk; };
#ifdef PROBE_RACY
#endif
struct Tensors { const bf16* Q; const bf16* K; const bf16* V; bf16* O01; bf16* O23; float2* ML; float cshift;
#if defined(PROBE_RACY) || defined(PROBE_HALF)
    int racy;
#endif
};
constexpr int SEQ = 8192, NBH = 8;
__device__ __forceinline__ BlockRef<bf16, bf16> mkref(const Tensors& T, const Item& it) {
    BlockRef<bf16, bf16> r; const size_t row0 = (size_t)it.bh * SEQ + (size_t)it.qb * QB;
    r.Q = T.Q + row0 * D; r.K = T.K + (size_t)it.bh * SEQ * D; r.V = T.V + (size_t)it.bh * SEQ * D;
    r.O = (it.chunk < 2 ? T.O01 + (size_t)it.chunk * NBH * SEQ * D : T.O23 + (size_t)(it.chunk - 2) * NBH * SEQ * D) + row0 * D; r.ML = T.ML + (size_t)it.chunk * NBH * SEQ + row0; r.P0 = it.qb * QB; r.jlo = it.jlo; r.jhi = it.jhi; r.cshift = T.cshift;
#ifdef PROBE_RACY
    r.racy = T.racy;
#endif
#ifdef PROBE_HALF
#ifdef PROBE_ONE
    if (T.racy) r.jhi = r.jlo + PROBE_ONE;
#else
    if (T.racy) r.jhi = r.jlo + (r.jhi - r.jlo + 1) / 2;
#endif
#endif
    return r;
}
template <class Sched> __device__ __forceinline__ void attn_phase(char* lds, const Tensors& T, const Sched& S) {
    Item it, itn; if (!S.get(0, it)) return;
    BlockRef<bf16, bf16> cur = mkref(T, it);
    Seam<bf16> Sm;
    causal_swa_prime<bf16, bf16>(cur, 1 << 30, lds, Sm);
    for (int i = 0;; ++i) {
        const bool more = S.get(i + 1, itn);
        const BlockRef<bf16, bf16> nxt = more ? mkref(T, itn) : cur;
        causal_swa_block<bf16, bf16>(cur, nxt, SEQ, 1 << 30, lds, Sm);
        if (!more) break;
        cur = nxt;
    }
}
#undef KSWZ
#undef SBAR
}

constexpr int NWAVES = 8;
#ifndef MK_N_LAUNCHES
#define MK_N_LAUNCHES 1
#endif
#ifndef SPLIT_BAR
#define SPLIT_BAR 0
#endif
#ifndef GROUP_BAR
#define GROUP_BAR 1
#endif
#ifndef CONV_DOWN_LATE
#define CONV_DOWN_LATE (!GROUP_BAR)
#endif
#ifndef CONV_TAIL
#define CONV_TAIL 0
#endif
#ifndef GEMM_ALIGN
#define GEMM_ALIGN true
#endif
#ifndef GEMM_SP2
#define GEMM_SP2 true
#endif
constexpr int BATCH = 2, SEQ = 8192, DM = 1024, DEPTH = 2;
constexpr int M = BATCH * SEQ;
constexpr int Q_LORA = 256, KV_LORA = 128, QK_ROPE = 32, QK_NOPE = 64, QK_HEAD = 96, V_HEAD = 128, NHEAD = 4;
constexpr int SGU_W = 256, POOL_W = 256, CHUNK = 128;
constexpr int IN_W = 1184, ZLD = 1280;
constexpr int ZO_KV = 256, ZO_ROPE = 384, ZO_U = 416, ZO_V = 672, ZO_P = 928;
constexpr int FF = 2816, FF2 = 2 * FF;
constexpr float EPS = 1e-6f;
constexpr float QPRESCALE = 1.4426950408889634f * 0.10206207261596575f;
constexpr int PH_PER_LAYER = 7, NPH = 1 + DEPTH * PH_PER_LAYER;
constexpr int N_LAUNCHES = (MK_N_LAUNCHES == 1) ? 1 : NPH;

constexpr size_t MiB = 1u << 20;
constexpr size_t WS_CTL = 0, CTL_ZERO_BYTES = 64 * 1024 + (size_t)4 * 16384 * 4;
constexpr size_t WS_SSQ = 64 * 1024;
constexpr size_t WS_W = 2 * MiB, LW = 22 * MiB;
constexpr size_t OW_IN = 0, OW_Q = OW_IN + (size_t)ZLD * DM * 2, OW_KV = OW_Q + (size_t)384 * Q_LORA * 2, OW_OUT = OW_KV + (size_t)768 * KV_LORA * 2,
                 OW_GU = OW_OUT + (size_t)DM * DM * 2, OW_DN = OW_GU + (size_t)FF2 * DM * 2, OW_POOL = OW_DN + (size_t)DM * FF * 2, OW_SP = OW_POOL + (size_t)4 * 64 * 64 * 2, OW_END = OW_SP + (size_t)4 * CHUNK * CHUNK * 2;
static_assert(OW_END + 64 <= LW, "weight map");
constexpr size_t WS_CS = 46 * MiB;
constexpr size_t WS_XB = 48 * MiB;
constexpr size_t WS_Z = 80 * MiB;
constexpr size_t WS_MIX = 120 * MiB;
constexpr size_t WS_Q = 152 * MiB, WS_K = 168 * MiB, WS_V = 184 * MiB;
constexpr size_t WS_ML = 200 * MiB;
constexpr size_t WS_H = 152 * MiB;
constexpr size_t WS_END = 240 * MiB;
constexpr size_t OPART_BYTES = (size_t)8 * SEQ * 128 * 2;
constexpr size_t WS_OP01 = 202 * MiB;
static_assert(WS_W + DEPTH * LW <= WS_CS && WS_H + (size_t)M * FF * 2 <= WS_END && WS_END <= 256 * MiB && WS_Z + (size_t)M * ZLD * 2 <= WS_MIX && WS_Z + 2 * OPART_BYTES <= WS_MIX && WS_OP01 + 2 * OPART_BYTES <= 256 * MiB, "d_ws map");
__host__ __device__ constexpr size_t opart_off(int chunk) { return chunk < 2 ? WS_OP01 + (size_t)chunk * OPART_BYTES : WS_Z + (size_t)(chunk - 2) * OPART_BYTES; }
constexpr int CW_TMO = 0, CW_CODE = 1;
constexpr int CW_BAR = 4096;
constexpr int CW_GB = 8192;

constexpr int RING_OFF = 0, RING_BYTES = 163584;
constexpr int LDSCTL_OFF = RING_BYTES, MISC_OFF = LDSCTL_OFF;
constexpr int LDS_BYTES = 163840;
static_assert(MISC_OFF + 64 <= LDS_BYTES, "LDS map");

#define GAS __attribute__((address_space(1)))
#define LAS __attribute__((address_space(3)))
typedef unsigned short bf16;
typedef unsigned v4u __attribute__((ext_vector_type(4)));
typedef float f32x4 __attribute__((ext_vector_type(4)));
typedef short bf16x8 __attribute__((ext_vector_type(8)));
typedef GAS unsigned gu32;
typedef GAS unsigned long long gu64;
#define RLX_AGENT __ATOMIC_RELAXED, __HIP_MEMORY_SCOPE_AGENT
#define LDS_WAIT() asm volatile("s_waitcnt lgkmcnt(0)" ::: "memory")
#define VM_WAIT() asm volatile("s_waitcnt vmcnt(0)" ::: "memory")
__device__ __forceinline__ unsigned long long rt() { return __builtin_amdgcn_s_memrealtime(); }
__device__ __forceinline__ unsigned f2bf(float f) { unsigned u = __builtin_bit_cast(unsigned, f); return (u + 0x7fffu + ((u >> 16) & 1u)) >> 16; }
typedef float f32x2_t __attribute__((ext_vector_type(2))); typedef __bf16 bf16x2_t __attribute__((ext_vector_type(2)));
__device__ __forceinline__ unsigned pk2(float lo, float hi) { f32x2_t v = {lo, hi}; bf16x2_t b = __builtin_convertvector(v, bf16x2_t); return __builtin_bit_cast(unsigned, b); }

#ifndef XB_EARLY_INV
#define XB_EARLY_INV 1
#endif
#ifndef XB_EARLY_WB
#define XB_EARLY_WB 0
#endif
#ifndef XB_FLAT_RELEASE
#define XB_FLAT_RELEASE 1
#endif
#define XB_TMO      128
#define XB_XCNT(j)  (256  + 64 * (j))
#define XB_XSUB(j)  (1280 + 64 * (j))
#define XB_XGEN(j)  (2304 + 64 * (j))
#define XB_TOP      3328
#define XB_TOPGEN   3392
#define XCD_BAR_WORDS 3456
#define XB_SPIN_CAP (1u << 18)

__device__ __forceinline__ unsigned xb_ld(unsigned* p)              { return __hip_atomic_load(p, __ATOMIC_RELAXED, __HIP_MEMORY_SCOPE_AGENT); }
__device__ __forceinline__ unsigned xb_add(unsigned* p, unsigned v) { return __hip_atomic_fetch_add(p, v, __ATOMIC_RELAXED, __HIP_MEMORY_SCOPE_AGENT); }
__device__ __forceinline__ unsigned xb_xcc_id() { return (unsigned)__builtin_amdgcn_s_getreg((3 << 11) | 20) & 0xFu; }
#define XB_SPIN(cond, bar) do { unsigned _sp = 0; while (cond) { __builtin_amdgcn_s_sleep(1); \
    if ((++_sp & 255u) == 0u) { if (xb_ld(&(bar)[XB_TMO])) break; if (_sp > XB_SPIN_CAP) { atomicAdd(&(bar)[XB_TMO], 1u); break; } } } } while (0)

struct XcdBarrier {
    unsigned* bar; unsigned x;
    volatile LAS unsigned* st;
};

__device__ __forceinline__ XcdBarrier xcd_barrier_post(unsigned* bar, volatile LAS unsigned* st) {
    XcdBarrier b; b.bar = bar; b.x = xb_xcc_id(); b.st = st;
    if (threadIdx.x == 0) (void)xb_add(&bar[XB_XCNT(b.x)], 1u);
    return b;
}
__device__ __forceinline__ void xcd_barrier_complete(unsigned* bar, unsigned x, unsigned& nloc, unsigned& nx) {
    const unsigned G = gridDim.x * gridDim.y * gridDim.z;
    unsigned sum, cnt, mine, sp = 0u;
    for (;;) {
        sum = 0u; cnt = 0u; mine = 0u;
#pragma unroll
        for (unsigned j = 0; j < 16; ++j) { const unsigned c = xb_ld(&bar[XB_XCNT(j)]); sum += c; cnt += (c > 0u) ? 1u : 0u; mine = (j == x) ? c : mine; }
        if (sum == G) break;
        __builtin_amdgcn_s_sleep(1);
        if ((++sp & 255u) == 0u) { if (xb_ld(&bar[XB_TMO])) break; if (sp > XB_SPIN_CAP) { atomicAdd(&bar[XB_TMO], 1u); break; } }
    }
    nloc = mine > 0u ? mine : 1u; nx = cnt > 0u ? cnt : 1u;
}

__device__ __forceinline__ void xcd_barrier(const XcdBarrier& b) {
    asm volatile("s_waitcnt vmcnt(0)" ::: "memory");
    __syncthreads();
    if (threadIdx.x == 0) {
        unsigned* bar = b.bar;
        __builtin_amdgcn_s_waitcnt(0);
        unsigned nloc = b.st[0], nx = b.st[1];
        if (nloc == 0u) { xcd_barrier_complete(bar, b.x, nloc, nx); b.st[0] = nloc; b.st[1] = nx; }
        const unsigned old = xb_add(&bar[XB_XSUB(b.x)], 1u);
        const unsigned gen = old / nloc;
        if (old + 1u == (gen + 1u) * nloc) {
            __builtin_amdgcn_fence(__ATOMIC_RELEASE, "agent");
            asm volatile("s_waitcnt vmcnt(0)" ::: "memory");
            const unsigned og = xb_add(&bar[XB_TOP], 1u);
            const unsigned tg = og / nx;
#if XB_EARLY_INV
            if (og + 1u == (tg + 1u) * nx) { xb_add(&bar[XB_TOPGEN], 1u);
                __builtin_amdgcn_fence(__ATOMIC_ACQUIRE, "agent"); }
            else { __builtin_amdgcn_fence(__ATOMIC_ACQUIRE, "agent");
                   XB_SPIN(xb_ld(&bar[XB_TOPGEN]) == tg, bar); }
#else
            if (og + 1u == (tg + 1u) * nx) xb_add(&bar[XB_TOPGEN], 1u);
            else XB_SPIN(xb_ld(&bar[XB_TOPGEN]) == tg, bar);
            __builtin_amdgcn_fence(__ATOMIC_ACQUIRE, "agent");
#endif
#if !(XB_EARLY_INV && XB_FLAT_RELEASE)
            xb_add(&bar[XB_XGEN(b.x)], 1u);
#endif
            asm volatile("s_waitcnt vmcnt(0)" ::: "memory");
        } else {
#if XB_EARLY_WB
            if (old == gen * nloc) { __builtin_amdgcn_fence(__ATOMIC_RELEASE, "agent"); asm volatile("s_waitcnt vmcnt(0)" ::: "memory"); }
#endif
#if XB_EARLY_INV
            __builtin_amdgcn_fence(__ATOMIC_ACQUIRE, "agent");
            asm volatile("s_waitcnt vmcnt(0)" ::: "memory");
#if XB_FLAT_RELEASE
            XB_SPIN(xb_ld(&bar[XB_TOPGEN]) == gen, bar);
#else
            XB_SPIN(xb_ld(&bar[XB_XGEN(b.x)]) == gen, bar);
#endif
#else
            XB_SPIN(xb_ld(&bar[XB_XGEN(b.x)]) == gen, bar);
            __builtin_amdgcn_fence(__ATOMIC_ACQUIRE, "agent");
            asm volatile("s_waitcnt vmcnt(0)" ::: "memory");
#endif
        }
    }
    __syncthreads();
}

__device__ __forceinline__ void xcd_barrier_arrive(const XcdBarrier& b) {
    asm volatile("s_waitcnt vmcnt(0)" ::: "memory");
    __syncthreads();
    if (threadIdx.x == 0) {
        unsigned* bar = b.bar;
        __builtin_amdgcn_s_waitcnt(0);
        const unsigned nloc = b.st[0], nx = b.st[1];
        const unsigned old = xb_add(&bar[XB_XSUB(b.x)], 1u);
        const unsigned gen = old / nloc;
        b.st[2] = gen;
        if (old + 1u == (gen + 1u) * nloc) {
            __builtin_amdgcn_fence(__ATOMIC_RELEASE, "agent");
            asm volatile("s_waitcnt vmcnt(0)" ::: "memory");
            const unsigned og = xb_add(&bar[XB_TOP], 1u);
            const unsigned tg = og / nx;
            if (og + 1u == (tg + 1u) * nx) xb_add(&bar[XB_TOPGEN], 1u);
        }
    }
    __syncthreads();
}
__device__ __forceinline__ void xcd_barrier_wait(const XcdBarrier& b) {
    asm volatile("s_waitcnt vmcnt(0)" ::: "memory");
    __syncthreads();
    if (threadIdx.x == 0) {
        const unsigned gen = b.st[2];
        __builtin_amdgcn_fence(__ATOMIC_ACQUIRE, "agent");
        asm volatile("s_waitcnt vmcnt(0)" ::: "memory");
        XB_SPIN(xb_ld(&b.bar[XB_TOPGEN]) == gen, b.bar);
    }
    __syncthreads();
}

typedef unsigned u32x2 __attribute__((ext_vector_type(2)));
#define CAS __attribute__((address_space(4)))
struct Args { const float* in[23]; float* out; unsigned char* ws; int ph_lo, ph_hi, li, pad; };
struct Frame {
    LAS unsigned char* lds;
    const CAS Args* a;
    int lane, wave;
    int vcu, G;
};
__device__ __forceinline__ float wave_sum(float v) {
#pragma unroll
    for (int o = 1; o < 64; o <<= 1) v += __shfl_xor(v, o);
    return v;
}
__device__ __forceinline__ float wave_sum_dpp(float v) {
#define WS_DPP(ctrl, rmask) v += __builtin_bit_cast(float, __builtin_amdgcn_update_dpp(0, __builtin_bit_cast(int, v), ctrl, rmask, 0xf, false))
    WS_DPP(0x111, 0xf); WS_DPP(0x112, 0xf); WS_DPP(0x114, 0xf); WS_DPP(0x118, 0xf); WS_DPP(0x142, 0xa); WS_DPP(0x143, 0xc);
#undef WS_DPP
    return __builtin_bit_cast(float, __builtin_amdgcn_readlane(__builtin_bit_cast(int, v), 63));
}
__device__ __forceinline__ float quad_sum(float v) { v += __shfl_xor(v, 16); v += __shfl_xor(v, 32); return v; }
__device__ __forceinline__ float bf2f(unsigned short h) { return __builtin_bit_cast(float, (unsigned)h << 16); }
__device__ __forceinline__ float bflo(unsigned w) { return __builtin_bit_cast(float, w << 16); }
__device__ __forceinline__ float bfhi(unsigned w) { return __builtin_bit_cast(float, w & 0xffff0000u); }
__device__ __forceinline__ f32x4 mfma16(bf16x8 a, bf16x8 b, f32x4 c) { return __builtin_amdgcn_mfma_f32_16x16x32_bf16(a, b, c, 0, 0, 0); }
__device__ __forceinline__ u32x2 pk4(f32x4 v) { u32x2 w; w.x = pk2(v[0], v[1]); w.y = pk2(v[2], v[3]); return w; }
__device__ __forceinline__ bf16x8 pk8(const float* v) { v4u w; w.x = pk2(v[0], v[1]); w.y = pk2(v[2], v[3]); w.z = pk2(v[4], v[5]); w.w = pk2(v[6], v[7]); return __builtin_bit_cast(bf16x8, w); }

#define IN_F(i) ((const float*)F.a->in[i])
__device__ __forceinline__ bf16* wsp(const Frame& F, size_t off) { return (bf16*)(F.a->ws + off); }
__device__ __forceinline__ float* ssq_mix(const Frame& F, int l) { return (float*)(F.a->ws + WS_SSQ) + (size_t)(2 * l) * M; }
__device__ __forceinline__ float* ssq_ffn(const Frame& F, int l) { return (float*)(F.a->ws + WS_SSQ) + (size_t)(2 * l + 1) * M; }

__device__ __forceinline__ void p0_tr_item64(const float* W, int ldw, int k0, int n0, int nv, const float* gain, bf16* WT, int ldt, int drow0, LAS float* scr, int lane) {
    const int c4 = 4 * (lane & 15), rr = lane >> 4;
    f32x4 v[16]; float gg[16];
#pragma unroll
    for (int i = 0; i < 16; ++i) gg[i] = gain ? gain[k0 + rr + 4 * i] : 1.0f;
#pragma unroll
    for (int i = 0; i < 16; ++i) { v[i] = (f32x4){0.f, 0.f, 0.f, 0.f}; if (c4 < nv) v[i] = *(const GAS f32x4*)(W + (size_t)(k0 + rr + 4 * i) * ldw + n0 + c4); }
#pragma unroll
    for (int i = 0; i < 16; ++i) { const int kk = rr + 4 * i; const float g = gg[i];
#pragma unroll
        for (int e = 0; e < 4; ++e) scr[kk * 65 + c4 + e] = v[i][e] * g; }
    LDS_WAIT(); asm volatile("" ::: "memory");
    const int c = lane & 7;
#pragma unroll
    for (int j = 0; j < 8; ++j) { const int n = (lane >> 3) + 8 * j; const LAS float* sp = scr + (8 * c) * 65 + n;
        if (n < nv) { v4u o; o.x = pk2(sp[0 * 65], sp[1 * 65]); o.y = pk2(sp[2 * 65], sp[3 * 65]); o.z = pk2(sp[4 * 65], sp[5 * 65]); o.w = pk2(sp[6 * 65], sp[7 * 65]);
            *(GAS v4u*)(WT + (size_t)(drow0 + n) * ldt + k0 + 8 * c) = o; } }
    LDS_WAIT(); asm volatile("" ::: "memory");
}
constexpr int CI_IN = (DM / 64) * ((IN_W + 63) / 64), CI_Q = (Q_LORA / 64) * (384 / 64), CI_KV = (KV_LORA / 64) * (768 / 64), CI_SET0 = CI_IN + CI_Q + CI_KV;
constexpr int CI_OUT = (DM / 64) * (DM / 64), CI_G = (DM / 64) * (FF / 64), CI_DN = (FF / 64) * (DM / 64), CI_SET1 = CI_OUT + 2 * CI_G + CI_DN;
__device__ __forceinline__ void conv_item(Frame& F, int l, int set, int r, LAS float* scr, int lane) {
    unsigned char* wl = F.a->ws + WS_W + (size_t)l * LW;
    if (set == 0) {
        if (r < CI_IN) { const int nb = (IN_W + 63) / 64, kb = r / nb, n0 = 64 * (r % nb);
            p0_tr_item64(IN_F(3) + (size_t)l * DM * IN_W, IN_W, 64 * kb, n0, IN_W - n0 < 64 ? IN_W - n0 : 64, IN_F(2) + l * DM, (bf16*)(wl + OW_IN), DM, n0, scr, lane); return; } r -= CI_IN;
        if (r < CI_Q) { const int nb = 384 / 64, kb = r / nb, n0 = 64 * (r % nb);
            p0_tr_item64(IN_F(5) + (size_t)l * Q_LORA * 384, 384, 64 * kb, n0, 64, IN_F(4) + l * Q_LORA, (bf16*)(wl + OW_Q), Q_LORA, n0, scr, lane); return; } r -= CI_Q;
        { const int nb = 768 / 64, kb = r / nb, n0 = 64 * (r % nb);
            p0_tr_item64(IN_F(7) + (size_t)l * KV_LORA * 768, 768, 64 * kb, n0, 64, IN_F(6) + l * KV_LORA, (bf16*)(wl + OW_KV), KV_LORA, n0, scr, lane); return; }
    }
    if (r < CI_OUT) { const int nb = DM / 64, kb = r / nb, n0 = 64 * (r % nb), k0 = 64 * kb;
        const float* g = k0 < 512 ? IN_F(15) + l * 512 : k0 < 768 ? IN_F(16) + l * 256 - 512 : IN_F(17) + l * 256 - 768;
        p0_tr_item64(IN_F(18) + (size_t)l * DM * DM, DM, k0, n0, 64, g, (bf16*)(wl + OW_OUT), DM, n0, scr, lane); return; } r -= CI_OUT;
    if (r < 2 * CI_G) { const int up = r >= CI_G; if (up) r -= CI_G; const int nb = FF / 64, kb = r / nb, n0 = 64 * (r % nb);
        p0_tr_item64(IN_F(up ? 21 : 20) + (size_t)l * DM * FF, FF, 64 * kb, n0, 64, IN_F(19) + l * DM, (bf16*)(wl + OW_GU), DM, (n0 >> 7) * 256 + (n0 & 127) + (up ? 128 : 0), scr, lane); return; } r -= 2 * CI_G;
    { const int nb = DM / 64, kb = r / nb, n0 = 64 * (r % nb);
        p0_tr_item64(IN_F(22) + (size_t)l * FF * DM, DM, 64 * kb, n0, 64, nullptr, (bf16*)(wl + OW_DN), FF, n0, scr, lane); }
}
__device__ __forceinline__ void conv_set(Frame& F, int l, int set, int wk, int nwk, int first = 0, int last = 1 << 30) {
    LAS float* scr = (LAS float*)(F.lds + RING_OFF + F.wave * 16640);
    const int n = set == 0 ? CI_SET0 : CI_SET1, hi = last < n ? last : n;
    for (int it = first + wk; it < hi; it += nwk) conv_item(F, l, set, it, scr, F.lane);
}
constexpr int CI_SPLIT = 1184;
#ifndef CONV_DEFER
#define CONV_DEFER 1
#endif
__device__ __forceinline__ void p0_prologue(Frame& F) {
    const int gw = F.vcu * NWAVES + F.wave, NGW = F.G * NWAVES, lane = F.lane;
    { const int wk0 = F.wave * F.G + F.vcu;
      for (int l = 0; l < DEPTH; ++l) { conv_set(F, l, 0, (wk0 + NGW - (l * CI_SET0) % NGW) % NGW, NGW); if (!CONV_DEFER) conv_set(F, l, 1, gw, NGW); } }
    { const int gt = gw * 64 + lane, NGT = NGW * 64;
        constexpr int NPAD = DEPTH * (ZLD - IN_W) * DM / 8, NPOOL = DEPTH * 4 * 64 * 64, NTRIL = DEPTH * 4 * CHUNK * CHUNK / 8, NROPE = M * 16;
        const int* pos = (const int*)IN_F(1);
        auto pad_body = [&](int i) { const int l = i / ((ZLD - IN_W) * DM / 8), e = i % ((ZLD - IN_W) * DM / 8);
            *(GAS v4u*)(F.a->ws + WS_W + (size_t)l * LW + OW_IN + (size_t)IN_W * DM * 2 + (size_t)e * 16) = (v4u){0u, 0u, 0u, 0u}; };
        auto pool_ld = [&](int i, float& w, float& sc) { const int l = i >> 14, g = (i >> 12) & 3, d = (i >> 6) & 63, c = i & 63; w = IN_F(13)[(size_t)l * 16384 + (g * 64 + c) * 64 + d]; sc = IN_F(14)[l * POOL_W + g * 64 + d]; };
        auto pool_body = [&](int i, float w, float sc) { const int l = i >> 14, g = (i >> 12) & 3, d = (i >> 6) & 63, c = i & 63;
            ((bf16*)(F.a->ws + WS_W + (size_t)l * LW + OW_POOL))[(g * 64 + d) * 64 + c] = (bf16)f2bf(w * sc); };
        auto tril_ld = [&](int i, f32x4& a, f32x4& b) { const int l = i >> 13, e = (i & 8191) * 8; const float* src = IN_F(11) + (size_t)l * 4 * CHUNK * CHUNK + e; a = *(const f32x4*)src; b = *(const f32x4*)(src + 4); };
        auto tril_body = [&](int i, f32x4 a, f32x4 b) { const int l = i >> 13, e = (i & 8191) * 8, t = (e >> 7) & 127, s0 = e & 127;
            float v[8] = {a[0], a[1], a[2], a[3], b[0], b[1], b[2], b[3]};
#pragma unroll
            for (int j = 0; j < 8; ++j) if (s0 + j > t) v[j] = 0.f;
            *(bf16x8*)(F.a->ws + WS_W + (size_t)l * LW + OW_SP + (size_t)e * 2) = pk8(v); };
        auto rope_body = [&](int i, int pv) { const int m = i >> 4, f = i & 15;
            const float inv = 1.0f / powf(10000.0f, (float)f * (1.0f / 16.0f));
            const float ang = (float)pv * inv;
            const double a = (double)ang, n = rint(a * 0.15915494309189535), y = a - n * 6.283185307179586;
            const float yf = (float)y; ((float*)(F.a->ws + WS_CS))[(size_t)m * 32 + f] = cosf(yf); ((float*)(F.a->ws + WS_CS))[(size_t)m * 32 + 16 + f] = sinf(yf); };
        { float pw = 0.f, psc = 0.f; f32x4 ta = {0.f, 0.f, 0.f, 0.f}, tb = ta; int pv0 = 0, pv1 = 0;
          if (gt < NPOOL) pool_ld(gt, pw, psc);
          if (gt < NTRIL) tril_ld(gt, ta, tb);
          if (gt < NROPE) pv0 = pos[gt >> 4];
          if (gt + NGT < NROPE) pv1 = pos[(gt + NGT) >> 4];
          if (gt < NPAD) pad_body(gt);
          if (gt < NPOOL) pool_body(gt, pw, psc);
          if (gt < NTRIL) tril_body(gt, ta, tb);
          if (gt < NROPE) rope_body(gt, pv0);
          if (gt + NGT < NROPE) rope_body(gt + NGT, pv1); }
        for (int i = gt + NGT; i < NPAD; i += NGT) pad_body(i);
        for (int i = gt + NGT; i < NPOOL; i += NGT) { float w, sc; pool_ld(i, w, sc); pool_body(i, w, sc); }
        for (int i = gt + NGT; i < NTRIL; i += NGT) { f32x4 a, b; tril_ld(i, a, b); tril_body(i, a, b); }
        for (int i = gt + 2 * NGT; i < NROPE; i += NGT) rope_body(i, pos[i >> 4]);
    }
    if (gw < DEPTH) { const int l = gw; float gqm = 0.f, gkm = 0.f; const float* gq = IN_F(8) + l * QK_HEAD; const float* gk = IN_F(9) + l * QK_HEAD;
        for (int i = lane; i < QK_HEAD; i += 64) { gqm = fmaxf(gqm, fabsf(gq[i])); gkm = fmaxf(gkm, fabsf(gk[i])); }
#pragma unroll
        for (int o = 1; o < 64; o <<= 1) { gqm = fmaxf(gqm, __shfl_xor(gqm, o)); gkm = fmaxf(gkm, __shfl_xor(gkm, o)); }
        if (lane == 0) *(float*)(F.a->ws + WS_W + (size_t)l * LW + OW_END) = fmaxf(0.f, 1.4426950408889634f * 9.797958971132712f * gqm * gkm - 64.0f); }
    float* ssq0 = ssq_mix(F, 0);
#ifdef PROBE_TWICE
    for (int i = gw * 64 + lane; i < 3 * M; i += NGW * 64) ssq0[M + i] = 0.f;
#endif
    static_assert(M % (64 * 256) == 0, "x pass: 64 rows per workgroup and round");
    for (int mb = F.vcu * 64; mb < M; mb += F.G * 64)
    for (int j = F.wave >= 3 ? F.wave - 3 : 13 + F.wave; j < (F.wave >= 3 ? 13 : 16); j += (F.wave >= 3 ? 5 : 16)) {
        const int m0 = mb + 4 * j;
        f32x4 v[4][4];
#pragma unroll
        for (int r = 0; r < 4; ++r) { const GAS f32x4* xr = (const GAS f32x4*)(IN_F(0) + (size_t)(m0 + r) * DM) + 2 * lane;
#pragma unroll
            for (int j = 0; j < 2; ++j) { v[r][2 * j] = xr[128 * j]; v[r][2 * j + 1] = xr[128 * j + 1]; } }
#pragma unroll
        for (int r = 0; r < 4; ++r) { float s = 0.f; GAS v4u* o16 = (GAS v4u*)(wsp(F, WS_XB) + (size_t)(m0 + r) * DM) + lane;
#pragma unroll
            for (int j = 0; j < 2; ++j) { const f32x4 x = v[r][2 * j], y = v[r][2 * j + 1];
                s += ((x.x * x.x + x.y * x.y) + (x.z * x.z + x.w * x.w)) + ((y.x * y.x + y.y * y.y) + (y.z * y.z + y.w * y.w));
                o16[64 * j] = (v4u){pk2(x.x, x.y), pk2(x.z, x.w), pk2(y.x, y.y), pk2(y.z, y.w)}; }
            s = wave_sum_dpp(s); if (lane == 0) ssq0[m0 + r] = s; }
    }
}

__device__ __forceinline__ void p2_upproj_unit(Frame& F, int l, int chunk, bool dry = false) {
    int lane_ = F.lane; asm volatile("" : "+v"(lane_));
    const int lane = lane_, tl = lane & 15, kq = lane >> 4;
    const int m0w = chunk * CHUNK + F.wave * 16, m = m0w + tl, b = m >> 13, s0w = m0w & (SEQ - 1);
    const bf16* zrow = wsp(F, WS_Z) + (size_t)m * ZLD;
    const unsigned char* wl = F.a->ws + WS_W + (size_t)l * LW;
    const bf16* Wq = (const bf16*)(wl + OW_Q); const bf16* Wkv = (const bf16*)(wl + OW_KV);
    LAS unsigned char* buf0 = F.lds + RING_OFF; LAS unsigned char* buf1 = F.lds + RING_OFF + 49152;
    LAS unsigned char* stg = F.lds + RING_OFF + 98304 + F.wave * 4352;
#define UP_DMAQ(h_) do { _Pragma("unroll") for (int i = 0; i < 6; ++i) { const int j = F.wave * 6 + i, row = 2 * j + (lane >> 5), slot = lane & 31; \
        __builtin_amdgcn_global_load_lds((const unsigned*)((const unsigned char*)Wq + (size_t)((h_) * QK_HEAD + row) * (Q_LORA * 2) + ((slot ^ (row & 15)) * 16)), (LAS unsigned*)(buf0 + j * 1024), 16, 0, 0); } } while (0)
#define UP_DMAKV(h_) do { _Pragma("unroll") for (int i = 0; i < 6; ++i) { const int j = F.wave * 6 + i, row = 4 * j + (lane >> 4), slot = lane & 15; \
        __builtin_amdgcn_global_load_lds((const unsigned*)((const unsigned char*)Wkv + (size_t)((h_) * 192 + row) * (KV_LORA * 2) + ((slot ^ (row & 15)) * 16)), (LAS unsigned*)(buf1 + j * 1024), 16, 0, 0); } } while (0)
    UP_DMAQ(0);
    bf16x8 zq[8], zkv[4];
#pragma unroll
    for (int ks = 0; ks < 8; ++ks) zq[ks] = *(const bf16x8*)(zrow + ks * 32 + kq * 8);
#pragma unroll
    for (int ks = 0; ks < 4; ++ks) zkv[ks] = *(const bf16x8*)(zrow + ZO_KV + ks * 32 + kq * 8);
    const u32x2 kw0 = *(const u32x2*)(zrow + ZO_ROPE + 4 * kq), kw1 = *(const u32x2*)(zrow + ZO_ROPE + 16 + 4 * kq);
    const float* csr = (const float*)(F.a->ws + WS_CS) + (size_t)m * 32;
    const f32x4 cs = *(const f32x4*)(csr + 4 * kq), sn = *(const f32x4*)(csr + 16 + 4 * kq);
    const float* gq = IN_F(8) + l * QK_HEAD; const float* gk = IN_F(9) + l * QK_HEAD;
    LAS float* gtab = (LAS float*)(F.lds + RING_OFF + 98304 + 8 * 4352);
    if (F.wave == 0) { for (int i = lane; i < 2 * QK_HEAD; i += 64) gtab[i] = i < QK_HEAD ? gq[i] : gk[i - QK_HEAD]; }
#define gqv(nb_) (*(const LAS f32x4*)(gtab + (nb_) * 16 + 4 * kq))
#define gkv(nb_) (*(const LAS f32x4*)(gtab + QK_HEAD + (nb_) * 16 + 4 * kq))
    float sq = 0.f, skv = 0.f;
#pragma unroll
    for (int ks = 0; ks < 8; ++ks)
#pragma unroll
        for (int j = 0; j < 8; ++j) { const float v = bf2f((unsigned short)zq[ks][j]); sq += v * v; }
#pragma unroll
    for (int ks = 0; ks < 4; ++ks)
#pragma unroll
        for (int j = 0; j < 8; ++j) { const float v = bf2f((unsigned short)zkv[ks][j]); skv += v * v; }
    const float r_q = __builtin_amdgcn_rsqf(quad_sum(sq) * (1.0f / Q_LORA) + EPS), r_kv = __builtin_amdgcn_rsqf(quad_sum(skv) * (1.0f / KV_LORA) + EPS);
    const f32x4 kr0 = {bflo(kw0.x), bfhi(kw0.x), bflo(kw0.y), bfhi(kw0.y)}, kr1 = {bflo(kw1.x), bfhi(kw1.x), bflo(kw1.y), bfhi(kw1.y)};
    float skr = (kr0[0] * kr0[0] + kr0[1] * kr0[1]) + (kr0[2] * kr0[2] + kr0[3] * kr0[3]) + (kr1[0] * kr1[0] + kr1[1] * kr1[1]) + (kr1[2] * kr1[2] + kr1[3] * kr1[3]);
    skr = quad_sum(skr);
#define UP_RD(dst_, ad_, OFF_) asm volatile("ds_read_b128 %0, %1 offset:%2" : "=v"(dst_) : "v"(ad_), "i"(OFF_) : "memory")
    const unsigned qbase = (unsigned)(uintptr_t)buf0 + tl * 512, kbase = (unsigned)(uintptr_t)buf1 + tl * 256;
#define UP_RDQ(d_, ks_) do { const unsigned ad_ = qbase + ((((ks_) * 4 + kq) ^ tl) << 4); UP_RD(d_[0], ad_, 0); UP_RD(d_[1], ad_, 8192); UP_RD(d_[2], ad_, 16384); UP_RD(d_[3], ad_, 24576); UP_RD(d_[4], ad_, 32768); UP_RD(d_[5], ad_, 40960); } while (0)
#define UP_RDKV(d_, ks_) do { const unsigned ad_ = kbase + ((((ks_) * 4 + kq) ^ tl) << 4); UP_RD(d_[0], ad_, 0); UP_RD(d_[1], ad_, 4096); UP_RD(d_[2], ad_, 8192); UP_RD(d_[3], ad_, 12288); UP_RD(d_[4], ad_, 16384); UP_RD(d_[5], ad_, 20480); \
        UP_RD(d_[6], ad_, 24576); UP_RD(d_[7], ad_, 28672); UP_RD(d_[8], ad_, 32768); UP_RD(d_[9], ad_, 36864); UP_RD(d_[10], ad_, 40960); UP_RD(d_[11], ad_, 45056); } while (0)
#define UP_PUT(nb_, v_) (*(LAS u32x2*)(stg + tl * 272 + (nb_) * 32 + kq * 8) = pk4(v_))
#ifdef PROBE_DRYSTORE
#define UP_DRY dry
#else
#define UP_DRY false
#endif
#define UP_FLUSH(dst_) do { if (!UP_DRY) { unsigned char* d_ = (unsigned char*)(dst_) + (size_t)(lane >> 4) * 256 + (lane & 15) * 16; _Pragma("unroll") for (int i = 0; i < 4; ++i) \
        *(GAS v4u*)(d_ + i * 1024) = *(const LAS v4u*)(stg + (4 * i + (lane >> 4)) * 272 + (lane & 15) * 16); } } while (0)
    __syncthreads();
#pragma unroll 1
    for (int h = 0; h < NHEAD; ++h) {
        const size_t orow0 = ((size_t)(b * NHEAD + h) * SEQ + s0w) * 128;
#ifdef PROBE_NODMA
        if (!dry)
#endif
        UP_DMAKV(h); asm volatile("" ::: "memory");
        {
            f32x4 acc[6];
#pragma unroll
            for (int nb = 0; nb < 6; ++nb) acc[nb] = (f32x4){0.f, 0.f, 0.f, 0.f};
            {
                bf16x8 fa[6], fb[6];
                UP_RDQ(fa, 0);
#define UP_QSTEP(cur_, nxt_, ks_) do { asm volatile("s_waitcnt lgkmcnt(0)" ::: "memory"); __builtin_amdgcn_sched_barrier(0); if ((ks_) + 1 < 8) UP_RDQ(nxt_, (ks_) + 1); \
                    _Pragma("unroll") for (int nb = 0; nb < 6; ++nb) acc[nb] = mfma16(cur_[nb], zq[ks_], acc[nb]); __builtin_amdgcn_sched_barrier(0); } while (0)
                UP_QSTEP(fa, fb, 0); UP_QSTEP(fb, fa, 1); UP_QSTEP(fa, fb, 2); UP_QSTEP(fb, fa, 3); UP_QSTEP(fa, fb, 4); UP_QSTEP(fb, fa, 5); UP_QSTEP(fa, fb, 6); UP_QSTEP(fb, fa, 7);
#undef UP_QSTEP
            }
            float ss = 0.f;
#pragma unroll
            for (int nb = 0; nb < 6; ++nb) { acc[nb] = acc[nb] * r_q; ss += (acc[nb][0] * acc[nb][0] + acc[nb][1] * acc[nb][1]) + (acc[nb][2] * acc[nb][2] + acc[nb][3] * acc[nb][3]); }
            const float rh = __builtin_amdgcn_rsqf(quad_sum(ss) * (1.0f / QK_HEAD) + EPS);
#pragma unroll
            for (int nb = 0; nb < 6; ++nb) acc[nb] = acc[nb] * (rh * QPRESCALE) * gqv(nb);
            const f32x4 x1 = acc[4], x2 = acc[5]; acc[4] = x1 * cs - x2 * sn; acc[5] = x2 * cs + x1 * sn;
#pragma unroll
            for (int nb = 0; nb < 6; ++nb) UP_PUT(nb, acc[nb]);
            UP_PUT(6, ((f32x4){0.f, 0.f, 0.f, 0.f})); UP_PUT(7, ((f32x4){0.f, 0.f, 0.f, 0.f}));
            UP_FLUSH(wsp(F, WS_Q) + orow0);
        }
        asm volatile("s_waitcnt vmcnt(4) lgkmcnt(0)" ::: "memory"); __builtin_amdgcn_s_barrier(); asm volatile("" ::: "memory");
#ifdef PROBE_NODMA
        if (!dry)
#endif
        if (h + 1 < NHEAD) UP_DMAQ(h + 1);
        asm volatile("" ::: "memory");
        {
            f32x4 acc[12];
#pragma unroll
            for (int nb = 0; nb < 12; ++nb) acc[nb] = (f32x4){0.f, 0.f, 0.f, 0.f};
            {
                bf16x8 fa[12], fb[12];
                UP_RDKV(fa, 0);
#define UP_KSTEP(cur_, nxt_, ks_) do { asm volatile("s_waitcnt lgkmcnt(0)" ::: "memory"); __builtin_amdgcn_sched_barrier(0); if ((ks_) + 1 < 4) UP_RDKV(nxt_, (ks_) + 1); \
                    _Pragma("unroll") for (int nb = 0; nb < 12; ++nb) acc[nb] = mfma16(cur_[nb], zkv[ks_], acc[nb]); __builtin_amdgcn_sched_barrier(0); } while (0)
                UP_KSTEP(fa, fb, 0); UP_KSTEP(fb, fa, 1); UP_KSTEP(fa, fb, 2); UP_KSTEP(fb, fa, 3);
#undef UP_KSTEP
            }
            float ss = 0.f;
#pragma unroll
            for (int nb = 0; nb < 4; ++nb) { acc[nb] = acc[nb] * r_kv; ss += (acc[nb][0] * acc[nb][0] + acc[nb][1] * acc[nb][1]) + (acc[nb][2] * acc[nb][2] + acc[nb][3] * acc[nb][3]); }
            const float rh = __builtin_amdgcn_rsqf((quad_sum(ss) + skr) * (1.0f / QK_HEAD) + EPS);
#pragma unroll
            for (int nb = 0; nb < 4; ++nb) UP_PUT(nb, acc[nb] * rh * gkv(nb));
            const f32x4 x1 = kr0 * rh * gkv(4), x2 = kr1 * rh * gkv(5);
            UP_PUT(4, x1 * cs - x2 * sn); UP_PUT(5, x2 * cs + x1 * sn);
            UP_PUT(6, ((f32x4){0.f, 0.f, 0.f, 0.f})); UP_PUT(7, ((f32x4){0.f, 0.f, 0.f, 0.f}));
            UP_FLUSH(wsp(F, WS_K) + orow0);
#pragma unroll
            for (int nb = 0; nb < 8; ++nb) UP_PUT(nb, acc[4 + nb] * r_kv);
            UP_FLUSH(wsp(F, WS_V) + orow0);
        }
        asm volatile("s_waitcnt vmcnt(8) lgkmcnt(0)" ::: "memory"); __builtin_amdgcn_s_barrier(); asm volatile("" ::: "memory");
    }
#undef gqv
#undef gkv
#undef UP_DMAQ
#undef UP_DMAKV
#undef UP_PUT
#undef UP_RD
#undef UP_RDQ
#undef UP_RDKV
#undef UP_FLUSH
}

constexpr int VS = 136;
__device__ __forceinline__ void p2_sgu_pool_unit(Frame& F, int l, int chunk, int cut = 0) {
    int lane_ = F.lane; asm volatile("" : "+v"(lane_));
    const int lane = lane_, tl = lane & 15, kq = lane >> 4, w = F.wave;
    LAS bf16* vnT = (LAS bf16*)(F.lds + RING_OFF);
    LAS unsigned char* pt = F.lds + RING_OFF + 69632;
    LAS unsigned char* stg = F.lds + RING_OFF + 145152 + w * 2304;
    const bf16* Z = wsp(F, WS_Z);
    const unsigned char* wl = F.a->ws + WS_W + (size_t)l * LW;
    const int t = w * 16 + tl, m = chunk * CHUNK + t, s = m & (SEQ - 1);
    const bf16* zrow = Z + (size_t)m * ZLD;
    v4u pv[9];
    { const int tid = w * 64 + lane, m0 = chunk * CHUNK, s0 = m0 & (SEQ - 1);
#pragma unroll
      for (int i = 0; i < 9; ++i) { const int c = tid + 512 * i, r = c >> 5, k = c & 31; pv[i] = (v4u){0u, 0u, 0u, 0u};
          if (c < 143 * 32 && s0 + r >= 15) pv[i] = *(const GAS v4u*)(Z + (size_t)(m0 - 15 + r) * ZLD + ZO_P + k * 8); } }
    u32x2 vws[16];
#pragma unroll
    for (int i = 0; i < 16; ++i) vws[i] = *(const u32x2*)(Z + (size_t)(chunk * CHUNK + w * 16 + i) * ZLD + ZO_V + 4 * lane);
    const f32x4 gv = *(const f32x4*)(IN_F(10) + l * SGU_W + 4 * lane);
    bf16x8 bfr[4][4];
#pragma unroll
    for (int ks = 0; ks < 4; ++ks)
#pragma unroll
        for (int h = 0; h < 4; ++h) bfr[ks][h] = *(const bf16x8*)(wl + OW_SP + ((size_t)(h * CHUNK + t) * CHUNK + ks * 32 + kq * 8) * 2);
    { float vv[4][16];
#pragma unroll
      for (int i = 0; i < 16; ++i) { const f32x4 v = {bflo(vws[i].x), bfhi(vws[i].x), bflo(vws[i].y), bfhi(vws[i].y)};
          const float r = __builtin_amdgcn_rsqf(wave_sum_dpp((v[0] * v[0] + v[1] * v[1]) + (v[2] * v[2] + v[3] * v[3])) * (1.0f / SGU_W) + EPS);
#pragma unroll
          for (int j = 0; j < 4; ++j) vv[j][i] = v[j] * r * gv[j]; }
#pragma unroll
      for (int j = 0; j < 4; ++j) { *(LAS bf16x8*)(vnT + (j * 64 + lane) * VS + w * 16) = pk8(&vv[j][0]); *(LAS bf16x8*)(vnT + (j * 64 + lane) * VS + w * 16 + 8) = pk8(&vv[j][8]); } }
    { const int tid = w * 64 + lane;
#pragma unroll
      for (int i = 0; i < 9; ++i) { const int c = tid + 512 * i, r = c >> 5, k = c & 31; if (c < 143 * 32) *(LAS v4u*)(pt + r * 528 + k * 16) = pv[i]; } }
    __syncthreads();
#ifdef PROBE_CUT
    if (cut == 1) { __syncthreads(); return; }
#endif
    unsigned char* mixw = (unsigned char*)(wsp(F, WS_MIX) + (size_t)(chunk * CHUNK + w * 16) * DM);
    {
        v4u uw[4][2]; float bsp[4];
#pragma unroll
        for (int h = 0; h < 4; ++h) { bsp[h] = IN_F(12)[(size_t)(l * 4 + h) * CHUNK + t];
#pragma unroll
            for (int e = 0; e < 2; ++e) uw[h][e] = *(const v4u*)(zrow + ZO_U + h * 64 + 16 * kq + 8 * e); }
        f32x4 acc[4][4];
#pragma unroll
        for (int h = 0; h < 4; ++h)
#pragma unroll
            for (int db = 0; db < 4; ++db) acc[h][db] = (f32x4){0.f, 0.f, 0.f, 0.f};
#pragma unroll
        for (int ks = 0; ks < 4; ++ks) {
#pragma unroll
            for (int h = 0; h < 4; ++h)
#pragma unroll
                for (int db = 0; db < 4; ++db) { const bf16x8 a = *(const LAS bf16x8*)(vnT + (db * 64 + h * 16 + tl) * VS + ks * 32 + kq * 8); acc[h][db] = mfma16(a, bfr[ks][h], acc[h][db]); }
            __builtin_amdgcn_sched_barrier(0);
        }
        float ss = 0.f;
#pragma unroll
        for (int h = 0; h < 4; ++h) { const unsigned uu[8] = {uw[h][0].x, uw[h][0].y, uw[h][0].z, uw[h][0].w, uw[h][1].x, uw[h][1].y, uw[h][1].z, uw[h][1].w};
#pragma unroll
            for (int r = 0; r < 4; ++r)
#pragma unroll
                for (int db = 0; db < 4; ++db) { const int c = 4 * r + db; const float u = (c & 1) ? bfhi(uu[c >> 1]) : bflo(uu[c >> 1]); const float g = u * (acc[h][db][r] + bsp[h]); acc[h][db][r] = g; ss += g * g; } }
        const float rB = __builtin_amdgcn_rsqf(quad_sum(ss) * (1.0f / SGU_W) + EPS);
#pragma unroll
        for (int h = 0; h < 4; ++h) { float o[16];
#pragma unroll
            for (int r = 0; r < 4; ++r)
#pragma unroll
                for (int db = 0; db < 4; ++db) o[4 * r + db] = acc[h][db][r] * rB;
            unsigned char* dst = mixw + (size_t)tl * (DM * 2) + (512 + h * 64 + 16 * kq) * 2;
            *(GAS bf16x8*)dst = pk8(&o[0]); *(GAS bf16x8*)(dst + 16) = pk8(&o[8]); }
    }
#ifdef PROBE_CUT
    if (cut == 2) { __syncthreads(); return; }
#endif
    {
        f32x4 acc[4][4];
#pragma unroll
        for (int g = 0; g < 4; ++g)
#pragma unroll
            for (int db = 0; db < 4; ++db) acc[g][db] = (f32x4){0.f, 0.f, 0.f, 0.f};
        const bf16* wp = (const bf16*)(wl + OW_POOL);
        const LAS unsigned char* pb = pt + (15 + t) * 528 + kq * 16;
        bf16x8 wa[2][4], wn[2][4];
#pragma unroll
        for (int ks = 0; ks < 2; ++ks)
#pragma unroll
            for (int db = 0; db < 4; ++db) wa[ks][db] = *(const bf16x8*)(wp + (size_t)(db * 16 + tl) * 64 + ks * 32 + kq * 8);
#pragma unroll
        for (int g = 0; g < 4; ++g) { const int win = 2 << g; const int cnt = (s + 1 < win) ? s + 1 : win; const float rc = 1.0f / (float)cnt;
            if (g < 3) {
#pragma unroll
                for (int ks = 0; ks < 2; ++ks)
#pragma unroll
                    for (int db = 0; db < 4; ++db) wn[ks][db] = *(const bf16x8*)(wp + (size_t)((g + 1) * 64 + db * 16 + tl) * 64 + ks * 32 + kq * 8); }
#pragma unroll
            for (int ks = 0; ks < 2; ++ks) {
                float sum[8], cur[8];
                { const v4u pw = *(const LAS v4u*)(pb + (g * 64 + ks * 32) * 2); const unsigned ww[4] = {pw.x, pw.y, pw.z, pw.w};
#pragma unroll
                  for (int j = 0; j < 4; ++j) { cur[2 * j] = bflo(ww[j]); cur[2 * j + 1] = bfhi(ww[j]); sum[2 * j] = cur[2 * j]; sum[2 * j + 1] = cur[2 * j + 1]; } }
#pragma unroll
                for (int jj = 1; jj < win; ++jj) { const v4u pw = *(const LAS v4u*)(pb - jj * 528 + (g * 64 + ks * 32) * 2); const unsigned ww[4] = {pw.x, pw.y, pw.z, pw.w};
#pragma unroll
                  for (int j = 0; j < 4; ++j) { sum[2 * j] += bflo(ww[j]); sum[2 * j + 1] += bfhi(ww[j]); } }
                float mv[8];
#pragma unroll
                for (int j = 0; j < 8; ++j) mv[j] = sum[j] * rc - cur[j];
                const bf16x8 bfrag = pk8(mv);
#pragma unroll
                for (int db = 0; db < 4; ++db) acc[g][db] = mfma16(wa[ks][db], bfrag, acc[g][db]);
            }
#pragma unroll
            for (int ks = 0; ks < 2; ++ks)
#pragma unroll
                for (int db = 0; db < 4; ++db) wa[ks][db] = wn[ks][db];
            __builtin_amdgcn_sched_barrier(0);
        }
        float ss = 0.f;
#pragma unroll
        for (int g = 0; g < 4; ++g)
#pragma unroll
            for (int db = 0; db < 4; ++db) { const f32x4 y = acc[g][db];
                ss += (y[0] * y[0] + y[1] * y[1]) + (y[2] * y[2] + y[3] * y[3]); }
        const float rC = __builtin_amdgcn_rsqf(quad_sum(ss) * (1.0f / POOL_W) + EPS);
#pragma unroll
        for (int g = 0; g < 4; ++g) {
#pragma unroll
            for (int db = 0; db < 4; ++db) *(LAS u32x2*)(stg + tl * 144 + db * 32 + kq * 8) = pk4(acc[g][db] * rC);
#pragma unroll
            for (int i = 0; i < 2; ++i) *(GAS v4u*)(mixw + (size_t)(8 * i + (lane >> 3)) * (DM * 2) + (768 + g * 64) * 2 + (lane & 7) * 16) = *(const LAS v4u*)(stg + (8 * i + (lane >> 3)) * 144 + (lane & 7) * 16);
        }
    }
    __syncthreads();
}

#ifndef ATT_SPLIT
#define ATT_SPLIT 1
#endif
constexpr int ATT_MAXI = 2;
__device__ const unsigned char att_nsp_tab[32] = {1,1,1,1,1,1,1,1,1,1,1,1,1,1,1,1,1,2,2,2,2,2,2,2,2,2,2,2,2,2,2,2};
__device__ const unsigned char att_tab[32 * ATT_MAXI * 4] = {
    31,0,0,60, 17,0,0,4,
    30,0,0,56, 18,0,0,8,
    29,0,0,52, 19,0,0,12,
    28,0,0,48, 20,0,0,16,
    27,0,0,44, 21,0,0,20,
    26,0,0,40, 22,0,0,24,
    25,0,0,36, 23,0,0,28,
    24,0,0,32, 7,0,0,32,
    16,0,0,68, 255,0,0,0,
    14,0,0,60, 0,0,0,4,
    13,0,0,56, 1,0,0,8,
    12,0,0,52, 2,0,0,12,
    11,0,0,48, 3,0,0,16,
    10,0,0,44, 4,0,0,20,
    9,0,0,40, 5,0,0,24,
    8,0,0,36, 6,0,0,28,
    17,1,4,72, 255,0,0,0,
    18,1,8,76, 255,0,0,0,
    19,1,12,80, 255,0,0,0,
    20,1,16,84, 255,0,0,0,
    21,1,20,88, 255,0,0,0,
    22,1,24,92, 255,0,0,0,
    23,1,28,96, 255,0,0,0,
    24,1,32,100, 255,0,0,0,
    25,1,36,104, 255,0,0,0,
    26,1,40,108, 255,0,0,0,
    27,1,44,112, 255,0,0,0,
    28,1,48,116, 255,0,0,0,
    29,1,52,120, 255,0,0,0,
    30,1,56,124, 255,0,0,0,
    31,1,60,128, 255,0,0,0,
    15,0,0,64, 255,0,0,0,
};
__constant__ const unsigned att_tab32[32 * ATT_MAXI] = {0x3c00001fu, 0x04000011u, 0x3800001eu, 0x08000012u, 0x3400001du, 0x0c000013u, 0x3000001cu, 0x10000014u, 0x2c00001bu, 0x14000015u, 0x2800001au, 0x18000016u, 0x24000019u, 0x1c000017u, 0x20000018u, 0x20000007u, 0x44000010u, 0x000000ffu, 0x3c00000eu, 0x04000000u, 0x3800000du, 0x08000001u, 0x3400000cu, 0x0c000002u, 0x3000000bu, 0x10000003u, 0x2c00000au, 0x14000004u, 0x28000009u, 0x18000005u, 0x24000008u, 0x1c000006u, 0x48040111u, 0x000000ffu, 0x4c080112u, 0x000000ffu, 0x500c0113u, 0x000000ffu, 0x54100114u, 0x000000ffu, 0x58140115u, 0x000000ffu, 0x5c180116u, 0x000000ffu, 0x601c0117u, 0x000000ffu, 0x64200118u, 0x000000ffu, 0x68240119u, 0x000000ffu, 0x6c28011au, 0x000000ffu, 0x702c011bu, 0x000000ffu, 0x7430011cu, 0x000000ffu, 0x7834011du, 0x000000ffu, 0x7c38011eu, 0x000000ffu, 0x803c011fu, 0x000000ffu, 0x4000000fu, 0x000000ffu};
__constant__ const unsigned att_nsp32[32] = {1,1,1,1,1,1,1,1,1,1,1,1,1,1,1,1,1,2,2,2,2,2,2,2,2,2,2,2,2,2,2,2};
__device__ __forceinline__ int att_nsplit(int qb) { return ATT_SPLIT ? (int)att_nsp32[__builtin_amdgcn_readfirstlane(qb)] : 1; }
__device__ __forceinline__ void p4_combine(Frame& F) {
    const int gw = F.vcu * NWAVES + F.wave, NGW = F.G * NWAVES, lane = F.lane, h = lane >> 4, d0 = (lane & 15) * 8;
    const float2* ML = (const float2*)(F.a->ws + WS_ML);
    for (int m0 = gw * 4; m0 < M; m0 += NGW * 4) {
        const int b = m0 >> 13, s0 = m0 & (SEQ - 1), bh = b * NHEAD + h, nsp = att_nsplit(s0 >> 8);
        const size_t row0 = (size_t)bh * SEQ + s0;
        float li[4][4]; v4u ow[4][4];
#pragma unroll
        for (int r = 0; r < 4; ++r)
#pragma unroll
            for (int i = 0; i < 4; ++i) if (i < nsp) { li[r][i] = ML[(size_t)i * 8 * SEQ + row0 + r].y; ow[r][i] = *(const v4u*)(F.a->ws + opart_off(i) + ((row0 + r) * 128 + d0) * 2); }
#pragma unroll
        for (int r = 0; r < 4; ++r) {
            float a[8] = {0.f, 0.f, 0.f, 0.f, 0.f, 0.f, 0.f, 0.f}, wsum = 0.f;
#pragma unroll
            for (int i = 0; i < 4; ++i) if (i < nsp) { const float wgt = li[r][i]; wsum += wgt; const unsigned ww[4] = {ow[r][i].x, ow[r][i].y, ow[r][i].z, ow[r][i].w};
#pragma unroll
                for (int j = 0; j < 4; ++j) { a[2 * j] += wgt * bflo(ww[j]); a[2 * j + 1] += wgt * bfhi(ww[j]); } }
            const float rw = 1.0f / wsum; float ss = 0.f;
#pragma unroll
            for (int j = 0; j < 8; ++j) { a[j] *= rw; ss += a[j] * a[j]; }
            const float rA = __builtin_amdgcn_rsqf(wave_sum_dpp(ss) * (1.0f / 512.0f) + EPS);
#pragma unroll
            for (int j = 0; j < 8; ++j) a[j] *= rA;
            *(bf16x8*)(wsp(F, WS_MIX) + (size_t)(m0 + r) * DM + h * 128 + d0) = pk8(a);
        }
    }
}

struct AttnSchedPaired {
    int bh, idx;
    __device__ __forceinline__ bool get(int i, attn::Item& it) const {
        if (idx >= 16 || i >= 2) return false;
        it.bh = bh; it.qb = (i == 0) ? idx : 31 - idx; it.jlo = 0; it.jhi = 4 * (it.qb + 1); it.chunk = 0; return true;
    }
};
struct AttnSchedSplit {
    int bid, G;
    __device__ __forceinline__ bool get(int i, attn::Item& it) const {
        int cnt = 0;
        for (int slot = bid; slot < 256; slot += G)
#pragma unroll
            for (int j = 0; j < ATT_MAXI; ++j) {
#ifdef PROBE_SPREAD
                const unsigned e = att_tab32[(slot & 31) * ATT_MAXI + j]; const int bh = slot >> 5;
#else
                const unsigned e = att_tab32[(slot >> 3) * ATT_MAXI + j]; const int bh = slot & 7;
#endif
                if ((e & 255u) != 255u) { if (cnt == i) { it.bh = bh; it.qb = (int)(e & 255u); it.chunk = (int)((e >> 8) & 255u); it.jlo = (int)((e >> 16) & 255u); it.jhi = (int)(e >> 24); return true; } ++cnt; } }
        return false;
    }
};

__device__ __forceinline__ XcdBarrier mk_bar(const Frame& F) {
    XcdBarrier b; b.bar = (unsigned*)(F.a->ws + WS_CTL) + CW_BAR; b.x = xb_xcc_id(); b.st = (volatile LAS unsigned*)(F.lds + MISC_OFF) + 8; return b;
}
__device__ __forceinline__ void grid_bar(const Frame& F) { xcd_barrier(mk_bar(F)); }
__device__ __forceinline__ void group_bar(const Frame& F) {
    asm volatile("s_waitcnt vmcnt(0)" ::: "memory");
    __syncthreads();
    if (threadIdx.x == 0) {
        __builtin_amdgcn_s_waitcnt(0);
        unsigned* w = (unsigned*)(F.a->ws + WS_CTL) + CW_GB + 64 * ((int)blockIdx.x & 63);
        volatile LAS unsigned* st = (volatile LAS unsigned*)(F.lds + MISC_OFF) + 8;
        const unsigned same = st[3];
        if (same == 0u) { const unsigned o = __hip_atomic_fetch_or(w + 1, 1u << xb_xcc_id(), __ATOMIC_RELAXED, __HIP_MEMORY_SCOPE_AGENT); asm volatile("" :: "v"(o)); }
        if (same != 1u) { __builtin_amdgcn_fence(__ATOMIC_RELEASE, "agent"); asm volatile("s_waitcnt vmcnt(0)" ::: "memory"); }
        const unsigned old = xb_add(w, 1u), tgt = (old / 4u + 1u) * 4u;
        __builtin_amdgcn_fence(__ATOMIC_ACQUIRE, "agent");
        asm volatile("s_waitcnt vmcnt(0)" ::: "memory");
        XB_SPIN(xb_ld(w) < tgt, (unsigned*)(F.a->ws + WS_CTL) + CW_BAR);
        if (same == 0u) { const unsigned m = xb_ld(w + 1); st[3] = (m & (m - 1u)) == 0u ? 1u : 2u; }
    }
    __syncthreads();
}
__global__ void __launch_bounds__(NWAVES * 64, 2) hybrid_fwd(Args args_) {
    extern __shared__ __attribute__((aligned(16))) unsigned char lds[];
    (void)args_;
    const CAS Args* ap0 = (const CAS Args*)__builtin_amdgcn_kernarg_segment_ptr();
    { const int tid = threadIdx.x;
      for (int u = tid; u < (LDS_BYTES - LDSCTL_OFF) / 4; u += NWAVES * 64) ((LAS unsigned*)((LAS unsigned char*)lds + LDSCTL_OFF))[u] = 0u;
      __syncthreads();
      if (N_LAUNCHES == 1) (void)xcd_barrier_post((unsigned*)(ap0->ws + WS_CTL) + CW_BAR, (volatile LAS unsigned*)((LAS unsigned char*)lds + MISC_OFF) + 8); }
    const int p_lo = ap0->ph_lo;
#ifdef PROBE_TWICE
    int twice_ = 0;
#endif
#ifdef PROBE_Q
    int rep_ = 0;
#endif
#pragma unroll 1
    for (int p = p_lo;; ++p) {
        const CAS Args* ap = ap0; asm volatile("" : "+s"(ap));
        if (p >= ap->ph_hi) break;
        Frame F; F.lds = (LAS unsigned char*)lds; F.a = ap;
        { int tid = threadIdx.x; asm volatile("" : "+v"(tid)); F.lane = tid & 63; F.wave = __builtin_amdgcn_readfirstlane(tid >> 6); }
        F.G = gridDim.x; { const int bx = blockIdx.x; F.vcu = (F.G % 8 == 0) ? (bx % 8) * (F.G / 8) + bx / 8 : bx; }
        const int l = (p - 1) / PH_PER_LAYER, q = (p == 0) ? -1 : (p - 1) % PH_PER_LAYER;
        bool split_done = false;
        unsigned char* wl = F.a->ws + WS_W + (size_t)l * LW;
        if (q == -1) p0_prologue(F);
        else if (q == 0) {
            pg8::Gemm g{wsp(F, WS_XB), (const bf16*)(wl + OW_IN), M, ZLD, DM}; pg8::StaticOrder S; S.init(M, ZLD, F.G, (int)blockIdx.x);
            pg8::EpiScaleBf16 E{wsp(F, WS_Z), ZLD, ssq_mix(F, l), 1.0f / DM, EPS};
            pg8::gemm_phase<pg8::EpiScaleBf16, pg8::StaticOrder, GEMM_ALIGN, GEMM_SP2>(F.lds + RING_OFF, g, S, E);
            if (SPLIT_BAR && N_LAUNCHES == 1 && p + 1 < F.a->ph_hi) { xcd_barrier_arrive(mk_bar(F)); split_done = true; }
            if (CONV_DEFER) {
                const int nwg = (M / 256) * (ZLD / 256), rem = nwg % F.G, c = (int)blockIdx.x;
                const int first = (l > 0 && CONV_TAIL) ? CI_SPLIT : 0, last = CONV_DOWN_LATE ? CI_OUT + 2 * CI_G : CI_SET1;
                if (rem == 0) conv_set(F, l, 1, c * NWAVES + F.wave, F.G * NWAVES, first, last); else if (c >= rem) conv_set(F, l, 1, (c - rem) * NWAVES + F.wave, (F.G - rem) * NWAVES, first, last);
            }
        } else if (q == 1) {
#if defined(PROBE_SUB) && PROBE_SUB == 2
            if (rep_ == 0)
#endif
#ifdef PROBE_Q
            for (int u = F.vcu; u < M / CHUNK; u += F.G) p2_upproj_unit(F, l, u, rep_ == 1);
#elif defined(P2_INTERLEAVE)
            for (int v = F.vcu; v < 2 * (M / CHUNK); v += F.G) if (!(v & 1)) p2_upproj_unit(F, l, v >> 1);
#else
            for (int u = F.vcu; u < M / CHUNK; u += F.G) p2_upproj_unit(F, l, u);
#endif
#if defined(PROBE_SUB) && PROBE_SUB == 1
            if (rep_ == 0)
#endif
#ifdef P2_INTERLEAVE
            for (int v = F.vcu; v < 2 * (M / CHUNK); v += F.G) if (v & 1) p2_sgu_pool_unit(F, l, v >> 1);
#else
            for (int u = F.vcu + ((M / CHUNK - F.vcu + F.G - 1) / F.G) * F.G; u < 2 * (M / CHUNK); u += F.G)
#ifdef PROBE_CUT
                p2_sgu_pool_unit(F, l, u - M / CHUNK, rep_ == 1 ? PROBE_CUT : 0);
#else
                p2_sgu_pool_unit(F, l, u - M / CHUNK);
#endif
#endif
        } else if (q == 2) {
            const float cshift = *(const float*)(wl + OW_END);
            const attn::Tensors AT{(const attn::bf16*)wsp(F, WS_Q), (const attn::bf16*)wsp(F, WS_K), (const attn::bf16*)wsp(F, WS_V), (attn::bf16*)(F.a->ws + opart_off(0)), (attn::bf16*)(F.a->ws + opart_off(2)), (float2*)(F.a->ws + WS_ML), cshift
#if defined(PROBE_RACY) || defined(PROBE_HALF)
                , rep_ == 0 ? 1 : 0
#endif
            };
#if ATT_SPLIT
            const AttnSchedSplit S{(int)blockIdx.x, F.G};
            attn::attn_phase<AttnSchedSplit>((char*)lds + RING_OFF, AT, S);
#else
            const AttnSchedPaired S{(int)(blockIdx.x & 7), (int)(blockIdx.x >> 3)};
            attn::attn_phase<AttnSchedPaired>((char*)lds + RING_OFF, AT, S);
#endif
        } else if (q == 3) p4_combine(F);
        else if (q == 5) {
            pg8::Gemm g{wsp(F, WS_XB), (const bf16*)(wl + OW_GU), M, FF2, DM}; pg8::StaticOrder S; S.init(M, FF2, F.G, (int)blockIdx.x);
            pg8::EpiSwiglu E{wsp(F, WS_H), FF, ssq_ffn(F, l), 1.0f / DM, EPS};
#ifdef PROBE_DRYEPI
            if (rep_ == 1) E.H = nullptr;
#endif
#ifdef PROBE_SAMETILE
            if (rep_ == 1) { E.H = nullptr; g.N = 0; }
#endif
#ifdef PROBE_NOMMA
            if (rep_ == 1) { E.H = nullptr; g.M = 0; }
#endif
            pg8::gemm_phase<pg8::EpiSwiglu, pg8::StaticOrder, GEMM_ALIGN, GEMM_SP2>(F.lds + RING_OFF, g, S, E);
            if (CONV_DEFER && CONV_DOWN_LATE) {
                const int nwg = (M / 256) * (FF2 / 256), rem = nwg % F.G, c = (int)blockIdx.x;
                if (rem != 0 && c >= rem) conv_set(F, l, 1, (c - rem) * NWAVES + F.wave, (F.G - rem) * NWAVES, CI_OUT + 2 * CI_G, CI_SET1);
                else if (rem == 0) conv_set(F, l, 1, c * NWAVES + F.wave, F.G * NWAVES, CI_OUT + 2 * CI_G, CI_SET1);
            }
            if (CONV_DEFER && CONV_TAIL && l + 1 < DEPTH) {
                const int nwg = (M / 256) * (FF2 / 256), rem = nwg % F.G, c = (int)blockIdx.x;
                if (rem != 0 && c >= rem) conv_set(F, l + 1, 1, (c - rem) * NWAVES + F.wave, (F.G - rem) * NWAVES, 0, CI_SPLIT);
                else if (rem == 0) conv_set(F, l + 1, 1, c * NWAVES + F.wave, F.G * NWAVES, 0, CI_SPLIT);
            }
        } else {
            const bool dn = q == 6, nx = l + 1 < DEPTH;
            pg8::Gemm g{dn ? wsp(F, WS_H) : wsp(F, WS_MIX), (const bf16*)(wl + (dn ? OW_DN : OW_OUT)), M, DM, dn ? FF : DM}; pg8::StaticOrder S; S.init(M, DM, F.G, (int)blockIdx.x);
            pg8::EpiResid E{wsp(F, WS_XB), (dn && !nx) ? F.a->out : nullptr, (dn && !nx) ? nullptr : wsp(F, WS_XB), dn ? (nx ? ssq_mix(F, l + 1) : nullptr) : ssq_ffn(F, l), DM};
#ifdef PROBE_Q
            if (q == PROBE_Q && rep_ == 0) { E.out = nullptr; E.xb = nullptr; if (E.ssq) E.ssq = (float*)(F.a->ws + 204 * MiB); }
#endif
            pg8::gemm_phase<pg8::EpiResid, pg8::StaticOrder, GEMM_ALIGN, GEMM_SP2>(F.lds + RING_OFF, g, S, E);
        }
        if (split_done) xcd_barrier_wait(mk_bar(F));
        else if (N_LAUNCHES == 1 && p + 1 < F.a->ph_hi) {
            if (GROUP_BAR && F.G == 256 && q >= 4) group_bar(F); else grid_bar(F);
        }
#ifdef PROBE_GBAR
        if (N_LAUNCHES == 1 && p + 1 < F.a->ph_hi && GROUP_BAR && F.G == 256 && q >= 4) { for (int xb_ = 0; xb_ < PROBE_GBAR; ++xb_) group_bar(F); }
#endif
#ifdef PROBE_XBAR
        if (N_LAUNCHES == 1 && p + 1 < F.a->ph_hi) { for (int xb_ = 0; xb_ < PROBE_XBAR; ++xb_) grid_bar(F); }
#endif
#ifdef PROBE_TWICE
        if (p + 1 == F.a->ph_hi && twice_ < PROBE_TWICE) { ++twice_; grid_bar(F); p = -1; }
#endif
#ifdef PROBE_Q
        if (q == PROBE_Q && rep_ == 0) { rep_ = 1; --p; } else rep_ = 0;
#endif
    }
}

extern "C" void kernel_launch(void* const* d_in, const int* in_sizes, int n_in, void* d_out, int out_size, void* d_ws, size_t ws_size, hipStream_t stream) {
    static int grid = 0;
    if (grid == 0) {
        if (n_in != 23 || in_sizes[0] != M * DM || out_size != M * DM || ws_size < WS_END) { fprintf(stderr, "kernel_launch: shape mismatch (n_in %d, in0 %d, out %d, ws %zu)\n", n_in, n_in > 0 ? in_sizes[0] : -1, out_size, ws_size); grid = -1; return; }
        int dev = 0, cus = 0, per_cu = 0;
        if (hipGetDevice(&dev) != hipSuccess || hipDeviceGetAttribute(&cus, hipDeviceAttributeMultiprocessorCount, dev) != hipSuccess) { fprintf(stderr, "kernel_launch: device query failed\n"); grid = -1; return; }
        if (hipFuncSetAttribute((const void*)hybrid_fwd, hipFuncAttributeMaxDynamicSharedMemorySize, LDS_BYTES) != hipSuccess) { fprintf(stderr, "kernel_launch: hipFuncSetAttribute failed\n"); grid = -1; return; }
        if (hipOccupancyMaxActiveBlocksPerMultiprocessor(&per_cu, (const void*)hybrid_fwd, NWAVES * 64, LDS_BYTES) != hipSuccess || per_cu < 1)
            fprintf(stderr, "kernel_launch: note: occupancy query reports %d workgroups per CU\n", per_cu);
        (void)hipGetLastError();
        grid = cus;
        if (grid != 256) fprintf(stderr, "kernel_launch: note: %d CUs (tuned for 256)\n", grid);
    }
    if (grid < 0) return;
    if (hipMemsetAsync((char*)d_ws + WS_CTL, 0, CTL_ZERO_BYTES, stream) != hipSuccess) { fprintf(stderr, "kernel_launch: hipMemsetAsync failed\n"); return; }
#ifdef PROBE_MEMSET2
    for (int i = 0; i < PROBE_MEMSET2; ++i) (void)hipMemsetAsync((char*)d_ws + WS_CTL, 0, CTL_ZERO_BYTES, stream);
#endif
    Args a{};
    for (int i = 0; i < 23; ++i) a.in[i] = (const float*)d_in[i];
    a.out = (float*)d_out; a.ws = (unsigned char*)d_ws;
#ifdef PROBE_PRO
    a.ph_lo = 0; a.ph_hi = 1; a.li = 0;
    hipLaunchKernelGGL(hybrid_fwd, dim3(grid), dim3(NWAVES * 64), LDS_BYTES, stream, a);
    (void)hipMemsetAsync((char*)d_ws + WS_CTL, 0, CTL_ZERO_BYTES, stream);
#endif
    for (int li = 0; li < N_LAUNCHES; ++li) {
        a.ph_lo = (N_LAUNCHES == 1) ? 0 : li; a.ph_hi = (N_LAUNCHES == 1) ? NPH : li + 1; a.li = li;
        hipLaunchKernelGGL(hybrid_fwd, dim3(grid), dim3(NWAVES * 64), LDS_BYTES, stream, a);
        const hipError_t le = hipPeekAtLastError();
        if (le != hipSuccess) { fprintf(stderr, "kernel_launch: launch %d failed: %s\n", li, hipGetErrorName(le)); break; }
    }
}
```

```cpp
#include <hip/hip_runtime.h>
#include <hip/hip_bf16.h>
#include <cstdio>
#include <cstdint>
#ifndef PG8_WGM
#define PG8_WGM 8
#endif

namespace pg8 {
#define PG8_LAS __attribute__((address_space(3)))
typedef unsigned short bf16_t;
typedef short bf16x8 __attribute__((ext_vector_type(8)));
typedef float f32x4 __attribute__((ext_vector_type(4)));
typedef unsigned u32x4 __attribute__((ext_vector_type(4)));
constexpr int BM = 256, BK = 64, HALF = 128, HTB = HALF * BK * 2  , STAGE_BYTES = 8 * HTB, NXCD = 8, WGM = PG8_WGM;

__host__ __device__ __forceinline__ int lds_byte(int r, int c) { const int st = (r >> 4) * 2 + (c >> 5), rr = r & 15, cc = c & 31, ob = rr * 64 + cc * 2; return st * 1024 + (ob ^ (((ob >> 9) & 1) << 5)); }
__host__ __device__ __forceinline__ void stage_rc(int b, int& R, int& C) { const int st = b / 1024, sb = b % 1024, swz = sb ^ (((sb >> 9) & 1) << 5); R = (st >> 1) * 16 + swz / 64; C = (st & 1) * 32 + (swz % 64) / 2; }
__host__ __device__ __forceinline__ int perm32(int rho) { const int n = rho >> 4, i = rho & 15; return 8 * (i >> 2) + 4 * n + (i & 3); }

struct Unit { int pm, pn; };
struct Gemm { const bf16_t* A; const bf16_t* Bt; int M, N, K; };

struct StaticOrder {
    int nM, nN, nwg, G, c;
    __host__ __device__ void init(int M, int N, int G_, int c_) { nM = M / BM; nN = N / BM; nwg = nM * nN; G = G_; c = c_; }
    __host__ __device__ bool next(int i, Unit& u) const {
        const long L = (long)i * G + c; if (L >= nwg) return false;
        int wgid = (int)L; { const int q = nwg / NXCD, r = nwg % NXCD, xcd = wgid % NXCD, off = wgid / NXCD; wgid = (xcd < r ? xcd * (q + 1) : r * (q + 1) + (xcd - r) * q) + off; }
        const int nig = WGM * nN, gid = wgid / nig, fm = gid * WGM, gsz = (nM - fm) < WGM ? (nM - fm) : WGM;
        u.pm = fm + ((wgid % nig) % gsz); u.pn = (wgid % nig) / gsz; return true;
    }
    __device__ __forceinline__ void a_ready(const Unit&) const {}
    __device__ __forceinline__ void done(const Unit&) const {}
};


__device__ __forceinline__ unsigned cvt_pk_bf16(float lo, float hi) { unsigned r; asm volatile("v_cvt_pk_bf16_f32 %0, %1, %2" : "=v"(r) : "v"(lo), "v"(hi)); return r; }
typedef float f32x2 __attribute__((ext_vector_type(2)));

typedef unsigned u32x2 __attribute__((ext_vector_type(2)));
#ifndef EPI_WT
#define EPI_WT 0
#endif
#ifndef RESID_FENCE
#define RESID_FENCE(m) ((m) & 1)
#endif
#ifndef EPI_PRE
#define EPI_PRE true
#endif
__device__ __forceinline__ void st16(void* p, u32x4 v) {
#if EPI_WT
    asm volatile("global_store_dwordx4 %0, %1, off sc1\n\ts_nop 1" :: "v"(p), "v"(v) : "memory");
#else
    *(u32x4*)p = v;
#endif
}
__device__ __forceinline__ void st16f(void* p, f32x4 v) { st16(p, __builtin_bit_cast(u32x4, v)); }
__device__ __forceinline__ void st8(void* p, u32x2 v) {
#if EPI_WT
    asm volatile("global_store_dwordx2 %0, %1, off sc1\n\ts_nop 1" :: "v"(p), "v"(v) : "memory");
#else
    *(u32x2*)p = v;
#endif
}
struct EpiScaleBf16 {
    static constexpr bool PERM = true, AFTER_DRAIN = false, PRE = EPI_PRE;
    bf16_t* O; int ldc; const float* ssq; float inv_n, eps;
    __device__ __forceinline__ void operator()(const f32x4 (&acc)[2][2][4][2], const Unit& u, int wr, int wc, int fr, int fq, const PG8_LAS float* ssl = nullptr) const {
        const int row0 = u.pm * BM + wr * 64 + fr, col0 = u.pn * BM + wc * 32 + 8 * fq;
        float rr[2][4];
#pragma unroll
        for (int ai = 0; ai < 2; ++ai)
#pragma unroll
            for (int m = 0; m < 4; ++m) rr[ai][m] = PRE ? ssl[wr * 64 + fr + ai * HALF + m * 16] : ssq[row0 + ai * HALF + m * 16];
#pragma unroll
        for (int ai = 0; ai < 2; ++ai)
#pragma unroll
            for (int m = 0; m < 4; ++m) { const int row = row0 + ai * HALF + m * 16; const float r = __builtin_amdgcn_rsqf(rr[ai][m] * inv_n + eps); bf16_t* rowp = O + (size_t)row * ldc + col0;
#pragma unroll
                for (int bj = 0; bj < 2; ++bj) { const f32x4 v0 = acc[ai][bj][m][0] * r, v1 = acc[ai][bj][m][1] * r;
                    u32x4 w; w.x = cvt_pk_bf16(v0[0], v0[1]); w.y = cvt_pk_bf16(v0[2], v0[3]); w.z = cvt_pk_bf16(v1[0], v1[1]); w.w = cvt_pk_bf16(v1[2], v1[3]);
                    st16(rowp + bj * HALF, w); } }
    }
};
struct EpiSwiglu {
    static constexpr bool PERM = true, AFTER_DRAIN = false, PRE = EPI_PRE;
    bf16_t* H; int ldh; const float* ssq; float inv_n, eps;
    __device__ __forceinline__ static float swi(float g, float u) { return g * __builtin_amdgcn_rcpf(1.0f + __builtin_amdgcn_exp2f(g * -1.4426950408889634f)) * u; }
    __device__ __forceinline__ void operator()(const f32x4 (&acc)[2][2][4][2], const Unit& u, int wr, int wc, int fr, int fq, const PG8_LAS float* ssl = nullptr) const {
        const int row0 = u.pm * BM + wr * 64 + fr, col0 = u.pn * HALF + wc * 32 + 8 * fq;
#ifdef PROBE_DRYEPI
        if (!H) { asm volatile("" :: "v"(acc[0][0][0][0]), "v"(acc[1][1][3][1])); return; }
#endif
        float rr[2][4];
#pragma unroll
        for (int ai = 0; ai < 2; ++ai)
#pragma unroll
            for (int m = 0; m < 4; ++m) rr[ai][m] = PRE ? ssl[wr * 64 + fr + ai * HALF + m * 16] : ssq[row0 + ai * HALF + m * 16];
#pragma unroll
        for (int ai = 0; ai < 2; ++ai)
#pragma unroll
            for (int m = 0; m < 4; ++m) { const int row = row0 + ai * HALF + m * 16; const float r = __builtin_amdgcn_rsqf(rr[ai][m] * inv_n + eps);
                const f32x4 g0 = acc[ai][0][m][0] * r, g1 = acc[ai][0][m][1] * r, u0 = acc[ai][1][m][0] * r, u1 = acc[ai][1][m][1] * r;
                u32x4 w; w.x = cvt_pk_bf16(swi(g0[0], u0[0]), swi(g0[1], u0[1])); w.y = cvt_pk_bf16(swi(g0[2], u0[2]), swi(g0[3], u0[3]));
                w.z = cvt_pk_bf16(swi(g1[0], u1[0]), swi(g1[1], u1[1])); w.w = cvt_pk_bf16(swi(g1[2], u1[2]), swi(g1[3], u1[3]));
                st16(H + (size_t)row * ldh + col0, w); }
    }
};
struct EpiResid {
    static constexpr bool PERM = true, AFTER_DRAIN = false, PRE = false;
    const bf16_t* base16; float* out; bf16_t* xb; float* ssq; int ldc;
    __device__ __forceinline__ void operator()(const f32x4 (&acc)[2][2][4][2], const Unit& u, int wr, int wc, int fr, int fq) const {
        const int row0 = u.pm * BM + wr * 64 + fr, col0 = u.pn * BM + wc * 32 + 8 * fq;
#pragma unroll
        for (int ai = 0; ai < 2; ++ai) {
            u32x4 bw[4][2];
#pragma unroll
            for (int m = 0; m < 4; ++m)
#pragma unroll
                for (int bj = 0; bj < 2; ++bj) bw[m][bj] = *(const u32x4*)(base16 + (size_t)(row0 + ai * HALF + m * 16) * ldc + col0 + bj * HALF);
            asm volatile("" ::: "memory");
#pragma unroll
            for (int m = 0; m < 4; ++m) { const int row = row0 + ai * HALF + m * 16; const size_t off = (size_t)row * ldc + col0; float s = 0.f;
#pragma unroll
                for (int bj = 0; bj < 2; ++bj) { const u32x4 w4 = bw[m][bj];
                    f32x4 o0 = (f32x4){__builtin_bit_cast(float, w4.x << 16), __builtin_bit_cast(float, w4.x & 0xffff0000u), __builtin_bit_cast(float, w4.y << 16), __builtin_bit_cast(float, w4.y & 0xffff0000u)};
                    f32x4 o1 = (f32x4){__builtin_bit_cast(float, w4.z << 16), __builtin_bit_cast(float, w4.z & 0xffff0000u), __builtin_bit_cast(float, w4.w << 16), __builtin_bit_cast(float, w4.w & 0xffff0000u)};
                    o0 = o0 + acc[ai][bj][m][0]; o1 = o1 + acc[ai][bj][m][1];
                    if (out) { *(f32x4*)(out + off + bj * HALF) = o0; *(f32x4*)(out + off + bj * HALF + 4) = o1; }
                    s += ((o0[0] * o0[0] + o0[1] * o0[1]) + (o0[2] * o0[2] + o0[3] * o0[3])) + ((o1[0] * o1[0] + o1[1] * o1[1]) + (o1[2] * o1[2] + o1[3] * o1[3]));
                    if (xb) { u32x4 w; w.x = cvt_pk_bf16(o0[0], o0[1]); w.y = cvt_pk_bf16(o0[2], o0[3]); w.z = cvt_pk_bf16(o1[0], o1[1]); w.w = cvt_pk_bf16(o1[2], o1[3]); *(u32x4*)(xb + off + bj * HALF) = w; } }
                if (ssq) { s += __shfl_xor(s, 16); s += __shfl_xor(s, 32); if (fq == 0) atomicAdd(ssq + row, s); } }
            asm volatile("" ::: "memory");
        }
    }
};


template <class Epi, class Sched, bool ALIGN_EPI = false, bool SP2 = false>
__device__ __forceinline__ void gemm_phase(PG8_LAS unsigned char* lds, const Gemm g, const Sched& S, const Epi& E) {
    int tid_ = threadIdx.x; asm volatile("" : "+v"(tid_));
    const int tid = tid_, wid = __builtin_amdgcn_readfirstlane(tid >> 6), lane = tid & 63, wr = wid >> 2, wc = wid & 3, fr = lane & 15, fq = lane >> 4;
    const int K = g.K, nt = K / BK;
    unsigned voffA[2], voffB[2];
#pragma unroll
    for (int i = 0; i < 2; ++i) { int R, C; stage_rc(tid * 16 + i * 8192, R, C); const int Rb = Epi::PERM ? ((R & ~31) + perm32(R & 31)) : R;
        voffA[i] = (unsigned)(R * K + C) * 2u; voffB[i] = (unsigned)(Rb * K + C) * 2u; }
    const size_t kstep = (size_t)(BK * 2);
    const size_t hstep = (size_t)HALF * K * 2;
    const size_t tstep = 2 * hstep;
    const unsigned ldsw = (unsigned)wid * 1024u;
    const int aoff = lds_byte(wr * 64 + fr, fq * 8), boff = lds_byte(wc * 32 + fr, fq * 8);
#define PG8_SA(b, h) (((b) * 2 + (h)) * HTB)
#define PG8_SB(b, h) ((4 + (b) * 2 + (h)) * HTB)
#define PG8_STAGE(bufoff, gbase, voff) do { _Pragma("unroll") for (int _i = 0; _i < 2; ++_i) \
        __builtin_amdgcn_global_load_lds((const unsigned*)((const char*)(gbase) + (voff)[_i]), (PG8_LAS unsigned*)(lds + (bufoff) + ldsw + _i * 8192), 16, 0, 0); } while (0)
#define PG8_LDA(dst, b, h) do { _Pragma("unroll") for (int m = 0; m < 4; ++m) _Pragma("unroll") for (int k = 0; k < 2; ++k) dst[m][k] = *(const PG8_LAS bf16x8*)(lds + PG8_SA(b, h) + aoff + m * 2048 + k * 1024); } while (0)
#define PG8_LDB(dst, b, h) do { _Pragma("unroll") for (int n = 0; n < 2; ++n) _Pragma("unroll") for (int k = 0; k < 2; ++k) dst[n][k] = *(const PG8_LAS bf16x8*)(lds + PG8_SB(b, h) + boff + n * 2048 + k * 1024); } while (0)
#ifdef PROBE_NOMMA
#define PG8_MMA_ON (g.M != 0)
#else
#define PG8_MMA_ON true
#endif
#define PG8_MMA(ai, bj, At, Bt) do { if (!PG8_MMA_ON) break; __builtin_amdgcn_s_setprio(1); _Pragma("unroll") for (int m = 0; m < 4; ++m) _Pragma("unroll") for (int n = 0; n < 2; ++n) _Pragma("unroll") for (int k = 0; k < 2; ++k) \
        acc[ai][bj][m][n] = __builtin_amdgcn_mfma_f32_16x16x32_bf16(Bt[n][k], At[m][k], acc[ai][bj][m][n], 0, 0, 0); __builtin_amdgcn_s_setprio(0); } while (0)
#define PG8_WAIT_V(n) asm volatile("s_waitcnt vmcnt(" #n ")" ::: "memory")
#define PG8_WAIT_L(n) asm volatile("s_waitcnt lgkmcnt(" #n ")" ::: "memory")
#define PG8_BAR __builtin_amdgcn_s_barrier()
#define PG8_SCHED __builtin_amdgcn_sched_barrier(0)
    PG8_LAS unsigned char* const ssl_base = lds + STAGE_BYTES;
#define PG8_PRE(u, i) do { if constexpr (Epi::PRE) __builtin_amdgcn_global_load_lds((const unsigned*)(E.ssq + (size_t)(u).pm * BM + (wid & 3) * 64 + lane), \
        (PG8_LAS unsigned*)(ssl_base + ((i) & 1) * 2048 + wid * 256), 4, 0, 0); } while (0)
    Unit cur, nxt; int ui = 0;
    if (!S.next(0, cur)) return;
    f32x4 acc[2][2][4][2];
#pragma unroll
    for (int a = 0; a < 2; ++a)
#pragma unroll
        for (int b = 0; b < 2; ++b)
#pragma unroll
            for (int m = 0; m < 4; ++m)
#pragma unroll
                for (int n = 0; n < 2; ++n) acc[a][b][m][n] = (f32x4){0.f, 0.f, 0.f, 0.f};
    bf16x8 At[4][2], B0[2][2], B1[2][2];
#ifdef PROBE_SAMETILE
    const size_t tsA = (g.N == 0) ? 0 : tstep, tsB = (g.N == 0) ? (PROBE_SAMETILE == 2 ? tstep : 0) : tstep;
#else
    const size_t tsA = tstep, tsB = tstep;
#endif
    const char* cA = (const char*)g.A + (size_t)cur.pm * tsA; const char* cB = (const char*)g.Bt + (size_t)cur.pn * tsB;
    S.a_ready(cur);
    PG8_PRE(cur, 0);
    if constexpr (SP2) {
        PG8_STAGE(PG8_SB(0, 0), cB, voffB); PG8_STAGE(PG8_SB(0, 1), cB + hstep, voffB); PG8_STAGE(PG8_SA(0, 0), cA, voffA); PG8_STAGE(PG8_SA(0, 1), cA + hstep, voffA);
        if (wr == 1) PG8_BAR;
        PG8_WAIT_V(2); PG8_BAR;
        PG8_STAGE(PG8_SB(1, 0), cB + kstep, voffB); PG8_STAGE(PG8_SA(1, 0), cA + kstep, voffA); PG8_STAGE(PG8_SB(1, 1), cB + hstep + kstep, voffB);
        PG8_WAIT_V(6); PG8_BAR;
    } else {
        PG8_STAGE(PG8_SB(0, 0), cB, voffB); PG8_STAGE(PG8_SA(0, 0), cA, voffA); PG8_STAGE(PG8_SB(0, 1), cB + hstep, voffB); PG8_STAGE(PG8_SA(0, 1), cA + hstep, voffA);
        if (wr == 1) PG8_BAR;
        PG8_WAIT_V(4); PG8_BAR;
        PG8_STAGE(PG8_SB(1, 0), cB + kstep, voffB); PG8_STAGE(PG8_SA(1, 0), cA + kstep, voffA); PG8_STAGE(PG8_SB(1, 1), cB + hstep + kstep, voffB);
        PG8_WAIT_V(6); PG8_BAR;
    }
    for (;;) {
        const bool has_next = S.next(ui + 1, nxt);
        const char* nA = has_next ? (const char*)g.A + (size_t)nxt.pm * tsA : cA; const char* nB = has_next ? (const char*)g.Bt + (size_t)nxt.pn * tsB : cB;
        for (int t = 0; t < nt; t += 2) {
            const bool last = (t == nt - 2);
            const char* a1 = cA + (size_t)(t + 1) * kstep;
            const char* a2 = last ? nA : cA + (size_t)(t + 2) * kstep; const char* b2 = last ? nB : cB + (size_t)(t + 2) * kstep;
            const char* a3 = a2 + kstep; const char* b3 = b2 + kstep;
            if (last && has_next) S.a_ready(nxt);
            if constexpr (SP2) {
            PG8_LDB(B0, 0, 0); PG8_LDB(B1, 0, 1); PG8_SCHED; PG8_LDA(At, 0, 0); PG8_STAGE(PG8_SA(1, 1), a1 + hstep, voffA);
            PG8_WAIT_V(8); PG8_WAIT_L(0); PG8_BAR; PG8_MMA(0, 0, At, B0); PG8_MMA(0, 1, At, B1); PG8_BAR; PG8_SCHED;
            PG8_LDA(At, 0, 1); PG8_STAGE(PG8_SB(0, 0), b2, voffB); PG8_STAGE(PG8_SB(0, 1), b2 + hstep, voffB); PG8_STAGE(PG8_SA(0, 0), a2, voffA);
            PG8_WAIT_V(8); PG8_WAIT_L(0); PG8_BAR; PG8_MMA(1, 0, At, B0); PG8_MMA(1, 1, At, B1); PG8_BAR; PG8_SCHED;
            PG8_LDB(B0, 1, 0); PG8_LDB(B1, 1, 1); PG8_SCHED; PG8_LDA(At, 1, 0); PG8_STAGE(PG8_SA(0, 1), a2 + hstep, voffA);
            PG8_WAIT_V(8); PG8_WAIT_L(0); PG8_BAR; PG8_MMA(0, 0, At, B0); PG8_MMA(0, 1, At, B1); PG8_BAR; PG8_SCHED;
            PG8_LDA(At, 1, 1); PG8_STAGE(PG8_SB(1, 0), b3, voffB); PG8_STAGE(PG8_SB(1, 1), b3 + hstep, voffB); PG8_STAGE(PG8_SA(1, 0), a3, voffA);
            PG8_WAIT_V(8); PG8_WAIT_L(0); PG8_BAR; PG8_MMA(1, 0, At, B0); PG8_MMA(1, 1, At, B1); PG8_BAR; PG8_SCHED;
            } else {
            PG8_LDB(B0, 0, 0); PG8_SCHED; PG8_LDA(At, 0, 0); PG8_STAGE(PG8_SA(1, 1), a1 + hstep, voffA);
            PG8_WAIT_L(8); PG8_BAR; PG8_WAIT_L(0); PG8_MMA(0, 0, At, B0); PG8_BAR; PG8_SCHED;
            PG8_LDB(B1, 0, 1); PG8_STAGE(PG8_SB(0, 0), b2, voffB);
            PG8_BAR; PG8_WAIT_L(0); PG8_MMA(0, 1, At, B1); PG8_BAR;
            PG8_LDA(At, 0, 1); PG8_STAGE(PG8_SA(0, 0), a2, voffA);
            PG8_BAR; PG8_WAIT_L(0); PG8_MMA(1, 0, At, B0); PG8_BAR; PG8_SCHED;
            PG8_STAGE(PG8_SB(0, 1), b2 + hstep, voffB);
            PG8_WAIT_V(6); PG8_BAR; PG8_MMA(1, 1, At, B1); PG8_BAR;
            PG8_LDB(B0, 1, 0); PG8_SCHED; PG8_LDA(At, 1, 0); PG8_STAGE(PG8_SA(0, 1), a2 + hstep, voffA);
            PG8_WAIT_L(8); PG8_BAR; PG8_WAIT_L(0); PG8_MMA(0, 0, At, B0); PG8_BAR; PG8_SCHED;
            PG8_LDB(B1, 1, 1); PG8_STAGE(PG8_SB(1, 0), b3, voffB);
            PG8_BAR; PG8_WAIT_L(0); PG8_MMA(0, 1, At, B1); PG8_BAR;
            PG8_LDA(At, 1, 1); PG8_STAGE(PG8_SA(1, 0), a3, voffA);
            PG8_BAR; PG8_WAIT_L(0); PG8_MMA(1, 0, At, B0); PG8_BAR; PG8_SCHED;
            PG8_STAGE(PG8_SB(1, 1), b3 + hstep, voffB);
            PG8_WAIT_V(6); PG8_BAR; PG8_MMA(1, 1, At, B1); PG8_BAR;
            }
        }
        if constexpr (ALIGN_EPI) { if (wr == 0) PG8_BAR; }
        if constexpr (Epi::PRE) { E(acc, cur, wr, wc, fr, fq, (const PG8_LAS float*)(ssl_base + (ui & 1) * 2048)); S.done(cur); }
        else if constexpr (!Epi::AFTER_DRAIN) { E(acc, cur, wr, wc, fr, fq); S.done(cur); }
        if (!has_next) break;
#pragma unroll
        for (int a = 0; a < 2; ++a)
#pragma unroll
            for (int b = 0; b < 2; ++b)
#pragma unroll
                for (int m = 0; m < 4; ++m)
#pragma unroll
                    for (int n = 0; n < 2; ++n) acc[a][b][m][n] = (f32x4){0.f, 0.f, 0.f, 0.f};
        cur = nxt; cA = nA; cB = nB; ++ui;
        PG8_PRE(cur, ui);
        if constexpr (ALIGN_EPI) { if (wr == 1) PG8_BAR; }
    }
    PG8_WAIT_V(0);
    if constexpr (!ALIGN_EPI) { if (wr == 0) PG8_BAR; }
    PG8_BAR;
    if constexpr (Epi::AFTER_DRAIN) { E.fused(acc, cur, wr, wc, fr, fq, lds, wid, lane); S.done(cur); }
#undef PG8_SA
#undef PG8_SB
#undef PG8_STAGE
#undef PG8_LDA
#undef PG8_LDB
#undef PG8_MMA
#undef PG8_WAIT_V
#undef PG8_WAIT_L
#undef PG8_BAR
#undef PG8_SCHED
#undef PG8_PRE
}
}

namespace attn {
constexpr int D = 128, NQD = 6;
constexpr float THR = 8.f;
#ifndef ATT_WSKIP
#define ATT_WSKIP false
#endif
constexpr bool WSKIP = ATT_WSKIP;
constexpr float SCALE = 0.10206207261596575f;
constexpr int NW = 8, QBLK = 32, KVBLK = 64, QB = NW * QBLK;
constexpr int SHM_V = KVBLK * D * 2, SHM_K = KVBLK * D * 2;
constexpr int LDS_BYTES = 2 * SHM_V + 2 * SHM_K + NW * 64 * 4;

using bf16 = __hip_bfloat16;
typedef short bf16x8 __attribute__((ext_vector_type(8)));
typedef short s16x4 __attribute__((ext_vector_type(4)));
typedef float f32x16 __attribute__((ext_vector_type(16)));
typedef float f32x4 __attribute__((ext_vector_type(4)));
typedef unsigned u32x4 __attribute__((ext_vector_type(4)));
template <class A, class Bt> struct same_t { static constexpr bool v = false; };
template <class A> struct same_t<A, A> { static constexpr bool v = true; };

#define KSWZ(row, colB) ((row) * 256 + ((colB) ^ (((row) & 7) << 4)))
#define SBAR() __builtin_amdgcn_sched_barrier(0)
__device__ __forceinline__ int v_st(int k, int c) { const int kk = (k & ~0xC) | ((k & 4) << 1) | ((k & 8) >> 1); return ((kk >> 3) * 4 + (c >> 5)) * 512 + ((kk & 7) * 32 + (c & 31)) * 2; }
__device__ __forceinline__ int v_rd_base(int lane) { return ((lane & 3) << 3) | (((lane >> 2) & 3) << 6) | (((lane >> 4) & 1) << 5) | (((lane >> 5) & 1) << 8); }
constexpr int v_rd_off(int d0, int ks, int half) { return d0 * 512 + ks * 4096 + half * 2048; }
__device__ __forceinline__ int crow(int r, int hi) { return (r & 3) + 8 * (r >> 2) + 4 * hi; }
__device__ __forceinline__ unsigned cvtpk(float lo, float hi) {
    unsigned r; asm volatile("v_cvt_pk_bf16_f32 %0, %1, %2" : "=v"(r) : "v"(lo), "v"(hi)); return r;
}
__device__ __forceinline__ bf16x8 pack8(f32x4 a, f32x4 b) {
    u32x4 w = {cvtpk(a[0], a[1]), cvtpk(a[2], a[3]), cvtpk(b[0], b[1]), cvtpk(b[2], b[3])};
    return *reinterpret_cast<bf16x8*>(&w);
}
template <class T> __device__ __forceinline__ bf16x8 load8(const T* p) {
    if constexpr (same_t<T, float>::v) { return pack8(*(const f32x4*)p, *(const f32x4*)(p + 4)); }
    else { return *reinterpret_cast<const bf16x8*>(p); }
}
__device__ __forceinline__ void mask_tile(f32x16& p0, f32x16& p1, int dq, unsigned W) {
    const float NEG = -__builtin_inff();
#pragma unroll
    for (int r = 0; r < 16; ++r) {
        const int c = (r & 3) + 8 * (r >> 2);
        if ((unsigned)(dq - c) >= W) p0[r] = NEG;
        if ((unsigned)(dq - c - 32) >= W) p1[r] = NEG;
    }
}
__device__ __forceinline__ void partialSM(f32x16& p0, f32x16& p1, float& m_reg, float& mn, float& alpha, float cshift) {
    (void)m_reg; mn = 0.f; alpha = 1.f;
    if (__builtin_expect(cshift != 0.f, 0)) { for (int r = 0; r < 16; ++r) { p0[r] -= cshift; p1[r] -= cshift; } }
    for (int r = 0; r < 16; ++r) p0[r] = __builtin_amdgcn_exp2f(p0[r]);
}
__device__ __forceinline__ void finishSM(f32x16& p0, f32x16& p1, float alpha, float& l_reg, bf16x8& pa0, bf16x8& pa1, bf16x8& pa2, bf16x8& pa3) {
    for (int r = 0; r < 16; ++r) p1[r] = __builtin_amdgcn_exp2f(p1[r]);
    float ps = 0; for (int r = 0; r < 16; ++r) ps += p0[r]; for (int r = 0; r < 16; ++r) ps += p1[r];
    { auto rr = __builtin_amdgcn_permlane32_swap(__float_as_uint(ps), __float_as_uint(ps), false, false);
      ps = __uint_as_float(rr[0]) + __uint_as_float(rr[1]); }
    l_reg += ps; (void)alpha;
#define PK4(P, B_, OUT) do { unsigned a0 = cvtpk(P[B_+0], P[B_+1]), a1 = cvtpk(P[B_+2], P[B_+3]);                          \
        unsigned b0 = cvtpk(P[B_+4], P[B_+5]), b1 = cvtpk(P[B_+6], P[B_+7]);                                             \
        auto r0 = __builtin_amdgcn_permlane32_swap(a0, b0, false, false); auto r1 = __builtin_amdgcn_permlane32_swap(a1, b1, false, false); \
        u32x4 w = {r0[0], r1[0], r0[1], r1[1]}; OUT = *reinterpret_cast<bf16x8*>(&w); } while (0)
    PK4(p0, 0, pa0); PK4(p0, 8, pa1); PK4(p1, 0, pa2); PK4(p1, 8, pa3);
#undef PK4
}
template <int KB, bool SK>
__device__ __forceinline__ void qkt(f32x16& p0, f32x16& p1, const char* K_lds, int r32, int hi, const bf16x8* qr, bool act) {
    if (SK && !act) { const float NEG = -__builtin_inff();
#pragma unroll
        for (int r = 0; r < 16; ++r) { p0[r] = NEG; p1[r] = NEG; } return; }
    p0 = f32x16{}; p1 = f32x16{};
    const char* kb[4];
#pragma unroll
    for (int dd = 0; dd < 4; ++dd) kb[dd] = K_lds + KB * SHM_K + KSWZ(r32, (dd * 16 + hi * 8) * 2);
#pragma unroll
    for (int d0 = 0; d0 < NQD; ++d0) { const char* a = kb[d0 & 3] + (d0 >> 2) * 128;
        bf16x8 b0 = *reinterpret_cast<const bf16x8*>(a);
        bf16x8 b1 = *reinterpret_cast<const bf16x8*>(a + 32 * 256);
        p0 = __builtin_amdgcn_mfma_f32_32x32x16_bf16(b0, qr[d0], p0, 0, 0, 0);
        p1 = __builtin_amdgcn_mfma_f32_32x32x16_bf16(b1, qr[d0], p1, 0, 0, 0); }
}
template <int VB, bool SK>
__device__ __forceinline__ void pv_tile(f32x16* o, int vb0, bf16x8 pa0, bf16x8 pa1, bf16x8 pa2, bf16x8 pa3, bool act) {
    if (SK && !act) return;
#define TRRD(dst, off) asm volatile("ds_read_b64_tr_b16 %0, %1 offset:%2" : "=&v"(dst) : "v"(vb0), "i"(off) : "memory")
#define PV_D0(d0) do { s16x4 l0, l1, l2, l3, h0, h1, h2, h3; constexpr int b_ = VB * SHM_V + v_rd_off(d0, 0, 0);     \
        TRRD(l0, b_); TRRD(h0, b_ + 2048); TRRD(l1, b_ + 4096); TRRD(h1, b_ + 6144); TRRD(l2, b_ + 8192); TRRD(h2, b_ + 10240); TRRD(l3, b_ + 12288); TRRD(h3, b_ + 14336); \
        asm volatile("s_waitcnt lgkmcnt(0)" ::: "memory"); SBAR();                 \
        o[d0] = __builtin_amdgcn_mfma_f32_32x32x16_bf16(pa0, (bf16x8){l0[0], l0[1], l0[2], l0[3], h0[0], h0[1], h0[2], h0[3]}, o[d0], 0, 0, 0);   \
        o[d0] = __builtin_amdgcn_mfma_f32_32x32x16_bf16(pa1, (bf16x8){l1[0], l1[1], l1[2], l1[3], h1[0], h1[1], h1[2], h1[3]}, o[d0], 0, 0, 0);   \
        o[d0] = __builtin_amdgcn_mfma_f32_32x32x16_bf16(pa2, (bf16x8){l2[0], l2[1], l2[2], l2[3], h2[0], h2[1], h2[2], h2[3]}, o[d0], 0, 0, 0);   \
        o[d0] = __builtin_amdgcn_mfma_f32_32x32x16_bf16(pa3, (bf16x8){l3[0], l3[1], l3[2], l3[3], h3[0], h3[1], h3[2], h3[3]}, o[d0], 0, 0, 0); } while (0)
    PV_D0(0); PV_D0(1); PV_D0(2); PV_D0(3);
#undef PV_D0
#undef TRRD
}

template <class TIn, class TOut> struct BlockRef { const TIn* Q; const TIn* K; const TIn* V; TOut* O; float2* ML; int P0; int jlo; int jhi; float cshift; };
template <class TIn> struct Seam {
    bf16x8 qr[NQD];
    bf16x8 st_v0, st_v1, st_k0, st_k1; f32x4 sf0, sf1, sf2, sf3;
    f32x4 tq[1];
};
__device__ __forceinline__ int swa_jlo(int P0, int W) { const int lowk = P0 - W + 1; return lowk > 0 ? lowk / KVBLK : 0; }
#define ROW(p, k0, rr) ((p) + (size_t)((k0) + (rr)) * D + sc)
#define VMW() asm volatile("s_waitcnt vmcnt(0)" ::: "memory")
#define VMWN(n) asm volatile("s_waitcnt vmcnt(%0)" :: "i"(n) : "memory")
#define SLOAD_H(Kp, Vp, k0) do { S.st_v0 = load8<TIn>(ROW(Vp, k0, sr)); S.st_v1 = load8<TIn>(ROW(Vp, k0, 32 + sr));              \
                         S.st_k0 = load8<TIn>(ROW(Kp, k0, sr)); S.st_k1 = load8<TIn>(ROW(Kp, k0, 32 + sr)); } while (0)
#define SWRITE_HK(bf) do { *(bf16x8*)(K_lds + (bf) * SHM_K + kws) = S.st_k0; *(bf16x8*)(K_lds + (bf) * SHM_K + kws + 32 * 256) = S.st_k1; } while (0)
#define SWRITE_HV(bf) do { *(bf16x8*)(V_lds + (bf) * SHM_V + vst0) = S.st_v0; *(bf16x8*)(V_lds + (bf) * SHM_V + vst1) = S.st_v1; } while (0)
#define SWRITE_H(bf) do { SWRITE_HV(bf); SWRITE_HK(bf); } while (0)
#define SLOAD_F(p, k0) do { S.sf0 = *(const f32x4*)ROW(p, k0, sr); S.sf1 = *(const f32x4*)(ROW(p, k0, sr) + 4);                \
                            S.sf2 = *(const f32x4*)ROW(p, k0, 32 + sr); S.sf3 = *(const f32x4*)(ROW(p, k0, 32 + sr) + 4); } while (0)
#define SWRITE_KF(bf) do { *(bf16x8*)(K_lds + (bf) * SHM_K + kws) = pack8(S.sf0, S.sf1); *(bf16x8*)(K_lds + (bf) * SHM_K + kws + 32 * 256) = pack8(S.sf2, S.sf3); } while (0)
#define SWRITE_VF(bf) do { *(bf16x8*)(V_lds + (bf) * SHM_V + vst0) = pack8(S.sf0, S.sf1); *(bf16x8*)(V_lds + (bf) * SHM_V + vst1) = pack8(S.sf2, S.sf3); } while (0)
template <class TIn, class TOut>
__device__ __forceinline__ void causal_swa_prime(const BlockRef<TIn, TOut>& cur, int W, char* lds, Seam<TIn>& S) {
    constexpr bool F32 = same_t<TIn, float>::v;
    int tid_ = threadIdx.x; asm volatile("" : "+v"(tid_));
    const int tid = tid_, wid = __builtin_amdgcn_readfirstlane(tid >> 6), lane = tid & 63, r32 = lane & 31, hi = lane >> 5;
    const int sr = tid >> 4, sc = (tid & 15) * 8, kws = KSWZ(sr, sc * 2); char* K_lds = lds + 2 * SHM_V;
    const int kb0 = cur.jlo * KVBLK;
    for (int d0 = 0; d0 < NQD; ++d0) S.qr[d0] = load8<TIn>(cur.Q + (size_t)(wid * QBLK + r32) * D + d0 * 16 + hi * 8);
    if constexpr (F32) { SLOAD_F((const float*)cur.K, kb0); VMW(); SWRITE_KF(0); SBAR(); SLOAD_F((const float*)cur.V, kb0); }
    else { SLOAD_H(cur.K, cur.V, kb0); VMW(); SWRITE_HK(0); }
    __syncthreads();
}
template <class TIn, class TOut>
__device__ __forceinline__ void causal_swa_block(const BlockRef<TIn, TOut>& cur, const BlockRef<TIn, TOut>& nxt, int skv, int W, char* lds, Seam<TIn>& S) {
    constexpr bool F32 = same_t<TIn, float>::v;
    int tid_ = threadIdx.x; asm volatile("" : "+v"(tid_));
    const int tid = tid_, wid = __builtin_amdgcn_readfirstlane(tid >> 6), lane = tid & 63, r32 = lane & 31, hi = lane >> 5;
    const int j_lo = cur.jlo; const int j_hi = cur.jhi; (void)skv;
    const int NT = j_hi - j_lo;
    const int kbn = nxt.jlo * KVBLK;
    const int qlo = cur.P0 + wid * QBLK, qm = qlo + r32 - 4 * hi;
    char* V_lds = lds; char* K_lds = lds + 2 * SHM_V;
    float* ws = (float*)(lds + 2 * SHM_V + 2 * SHM_K) + wid * 64; float* li_l = ws, * al_l = ws + 32;
    float m_reg = -1e30f, l_reg = 0; f32x16 o[4] = {};
    const int sr = tid >> 4, sc = (tid & 15) * 8, vst0 = v_st(sr, sc), vst1 = v_st(32 + sr, sc), kws = KSWZ(sr, sc * 2);
    const int vb0 = (int)(uintptr_t)V_lds + v_rd_base(lane);
    const TIn* Kh = cur.K; const TIn* Vh = cur.V;
#define RESC(a) do { (void)(a); (void)al_l; } while (0)
#define KBASE(t) ((j_lo + (t)) * KVBLK)
#define ACT(t) (KBASE(t) <= qlo + QBLK - 1 && KBASE(t) + KVBLK - 1 >= qlo - W + 1)
#define MASKT(P0_, P1_, t) do { const int kb_ = KBASE(t); if ((!SK || ACT(t)) && (kb_ + KVBLK - 1 > qlo || kb_ <= qlo + QBLK - 1 - W)) mask_tile(P0_, P1_, qm - kb_, (unsigned)W); } while (0)
    constexpr int NQL = F32 ? 16 : NQD;
    constexpr bool SK = WSKIP && !F32;
#define SEAM_K0() do { VMWN(NQL); if constexpr (F32) { SWRITE_KF(0); SBAR(); SLOAD_F((const float*)nxt.V, kbn); } else { SWRITE_HK(0); } SBAR(); } while (0)
    f32x16 pA0, pA1, pB0, pB1; float mnA, mnB, alA, alB; bf16x8 pa0, pa1, pa2, pa3;
    if constexpr (F32) { VMW(); SWRITE_VF(0); SBAR(); } else { SWRITE_HV(0); SBAR(); }
    if (NT > 1) { if constexpr (F32) SLOAD_F((const float*)Kh, KBASE(1)); else SLOAD_H(Kh, Vh, KBASE(1)); }
    SBAR(); qkt<0, SK>(pA0, pA1, K_lds, r32, hi, S.qr, ACT(0));
    if constexpr (F32) { if (NT > 1) { VMW(); SWRITE_KF(1); SBAR(); SLOAD_F((const float*)Vh, KBASE(1)); } }
    MASKT(pA0, pA1, 0); partialSM(pA0, pA1, m_reg, mnA, alA, cur.cshift);
    if (NT > 1) { VMW(); if constexpr (F32) { SWRITE_VF(1); SBAR(); if (NT > 2) SLOAD_F((const float*)Kh, KBASE(2)); } else SWRITE_H(1); }
    __syncthreads();
#define HALF_STEP(PX0, PX1, mnX, alX, PY0, PY1, alY, t, KB, VB, SB) do {                                                      \
        SBAR(); qkt<KB, SK>(PX0, PX1, K_lds, r32, hi, S.qr, ACT(t));                                             \
        finishSM(PY0, PY1, alY, l_reg, pa0, pa1, pa2, pa3); SBAR();                                                           \
        if ((t) + 1 < NT) { if constexpr (F32) { VMW(); SWRITE_KF(SB); SBAR(); SLOAD_F((const float*)Vh, KBASE((t) + 1)); }  \
                            else { SLOAD_H(Kh, Vh, KBASE((t) + 1)); } SBAR(); }                                               \
        pv_tile<VB, SK>(o, vb0, pa0, pa1, pa2, pa3, ACT((t) - 1)); MASKT(PX0, PX1, (t)); partialSM(PX0, PX1, m_reg, mnX, alX, cur.cshift);                                        \
        __syncthreads();                                                                                                      \
        if ((t) + 1 < NT) { VMW(); if constexpr (F32) { SWRITE_VF(SB); SBAR(); if ((t) + 2 < NT) SLOAD_F((const float*)Kh, KBASE((t) + 2)); } \
                            else { SWRITE_H(SB); } }                                                                          \
        RESC(alX); __syncthreads(); } while (0)
    for (int t = 1; t + 1 < NT; t += 2) {
        HALF_STEP(pB0, pB1, mnB, alB, pA0, pA1, alA, t, 1, 0, 0);
        HALF_STEP(pA0, pA1, mnA, alA, pB0, pB1, alB, t + 1, 0, 1, 1);
    }
    const bool even = (NT & 1) == 0;
    if (even) { SBAR(); qkt<1, SK>(pB0, pB1, K_lds, r32, hi, S.qr, ACT(NT - 1)); SBAR(); }
#define QROW(e) (nxt.Q + (size_t)(wid * QBLK + r32) * D + ((e) >> 1) * 16 + hi * 8 + ((e) & 1) * 4)
    if constexpr (F32) { SLOAD_F((const float*)nxt.K, kbn); SBAR();
#pragma unroll
        for (int e = 0; e < 8; ++e) S.tq[e] = *(const f32x4*)QROW(e); }
    else { SLOAD_H(nxt.K, nxt.V, kbn); SBAR();
#pragma unroll
        for (int d0 = 0; d0 < NQD; ++d0) S.qr[d0] = load8<TIn>(nxt.Q + (size_t)(wid * QBLK + r32) * D + d0 * 16 + hi * 8); }
    SBAR();
    finishSM(pA0, pA1, alA, l_reg, pa0, pa1, pa2, pa3); SBAR();
    if constexpr (F32) {
#pragma unroll
        for (int e = 8; e < 16; ++e) S.tq[e] = *(const f32x4*)QROW(e); SBAR(); }
#undef QROW
    pv_tile<0, SK>(o, vb0, pa0, pa1, pa2, pa3, ACT(even ? NT - 2 : NT - 1));
    if (even) { MASKT(pB0, pB1, NT - 1); partialSM(pB0, pB1, m_reg, mnB, alB, cur.cshift); __syncthreads(); RESC(alB);
        finishSM(pB0, pB1, alB, l_reg, pa0, pa1, pa2, pa3); SBAR(); pv_tile<1, SK>(o, vb0, pa0, pa1, pa2, pa3, ACT(NT - 1)); }
    SBAR(); SEAM_K0();
    if (hi == 0) { li_l[r32] = l_reg; cur.ML[wid * QBLK + r32] = make_float2(0.f, l_reg); } asm volatile("s_waitcnt lgkmcnt(0)" ::: "memory");
    float rli[16];
#pragma unroll
    for (int r = 0; r < 16; ++r) rli[r] = __builtin_amdgcn_rcpf(li_l[crow(r, hi)]);
    TOut* Ow = cur.O + (size_t)(wid * QBLK) * D;
#pragma unroll
    for (int r = 0; r < 16; ++r) { const int orow = crow(r, hi);
#pragma unroll
        for (int d0 = 0; d0 < 4; ++d0) { const float v = o[d0][r] * rli[r];
            if constexpr (same_t<TOut, float>::v) { Ow[(size_t)orow * D + d0 * 32 + r32] = v; }
            else { *(unsigned short*)(lds + LDS_BYTES + wid * 8704 + orow * 272 + (d0 * 32 + r32) * 2) = (unsigned short)(cvtpk(v, v) & 0xffffu); } } }
    if constexpr (!same_t<TOut, float>::v) {
#pragma unroll
        for (int i = 0; i < 8; ++i) { const int row = 4 * i + (lane >> 4), c16 = lane & 15;
            *(u32x4*)((char*)Ow + (size_t)row * (D * 2) + c16 * 16) = *(const u32x4*)(lds + LDS_BYTES + wid * 8704 + row * 272 + c16 * 16); } }
    if constexpr (F32) {
#pragma unroll
        for (int d0 = 0; d0 < NQD; ++d0) S.qr[d0] = pack8(S.tq[2 * d0], S.tq[2 * d0 + 1]); }
    if constexpr (!F32) {
#pragma unroll
        for (int d0 = 0; d0 < NQD; ++d0) asm volatile("" : "+v"(S.qr[d0]));
        asm volatile("" : "+v"(S.st_v0), "+v"(S.st_v1)); }
    __syncthreads();
#undef RESC
#undef KBASE
#undef ACT
#undef MASKT
#undef SEAM_K0
#undef HALF_STEP
}
#undef ROW
#undef VMW
#undef VMWN
#undef SLOAD_H
#undef SWRITE_HK
#undef SWRITE_HV
#undef SWRITE_H
#undef SLOAD_F
#undef SWRITE_KF
#undef SWRITE_VF

struct Item { int bh, qb, jlo, jhi, chunk; };
#ifdef PROBE_RACY
#endif
struct Tensors { const bf16* Q; const bf16* K; const bf16* V; bf16* O01; bf16* O23; float2* ML; float cshift;
#if defined(PROBE_RACY) || defined(PROBE_HALF)
    int racy;
#endif
};
constexpr int SEQ = 8192, NBH = 8;
__device__ __forceinline__ BlockRef<bf16, bf16> mkref(const Tensors& T, const Item& it) {
    BlockRef<bf16, bf16> r; const size_t row0 = (size_t)it.bh * SEQ + (size_t)it.qb * QB;
    r.Q = T.Q + row0 * D; r.K = T.K + (size_t)it.bh * SEQ * D; r.V = T.V + (size_t)it.bh * SEQ * D;
    r.O = (it.chunk < 2 ? T.O01 + (size_t)it.chunk * NBH * SEQ * D : T.O23 + (size_t)(it.chunk - 2) * NBH * SEQ * D) + row0 * D; r.ML = T.ML + (size_t)it.chunk * NBH * SEQ + row0; r.P0 = it.qb * QB; r.jlo = it.jlo; r.jhi = it.jhi; r.cshift = T.cshift;
#ifdef PROBE_RACY
    r.racy = T.racy;
#endif
#ifdef PROBE_HALF
#ifdef PROBE_ONE
    if (T.racy) r.jhi = r.jlo + PROBE_ONE;
#else
    if (T.racy) r.jhi = r.jlo + (r.jhi - r.jlo + 1) / 2;
#endif
#endif
    return r;
}
template <class Sched> __device__ __forceinline__ void attn_phase(char* lds, const Tensors& T, const Sched& S) {
    Item it, itn; if (!S.get(0, it)) return;
    BlockRef<bf16, bf16> cur = mkref(T, it);
    Seam<bf16> Sm;
    causal_swa_prime<bf16, bf16>(cur, 1 << 30, lds, Sm);
    for (int i = 0;; ++i) {
        const bool more = S.get(i + 1, itn);
        const BlockRef<bf16, bf16> nxt = more ? mkref(T, itn) : cur;
        causal_swa_block<bf16, bf16>(cur, nxt, SEQ, 1 << 30, lds, Sm);
        if (!more) break;
        cur = nxt;
    }
}
#undef KSWZ
#undef SBAR
}

constexpr int NWAVES = 8;
#ifndef MK_N_LAUNCHES
#define MK_N_LAUNCHES 1
#endif
#ifndef SPLIT_BAR
#define SPLIT_BAR 0
#endif
#ifndef GROUP_BAR
#define GROUP_BAR 1
#endif
#ifndef CONV_DOWN_LATE
#define CONV_DOWN_LATE (!GROUP_BAR)
#endif
#ifndef CONV_TAIL
#define CONV_TAIL 0
#endif
#ifndef GEMM_ALIGN
#define GEMM_ALIGN true
#endif
#ifndef GEMM_SP2
#define GEMM_SP2 true
#endif
constexpr int BATCH = 2, SEQ = 8192, DM = 1024, DEPTH = 2;
constexpr int M = BATCH * SEQ;
constexpr int Q_LORA = 256, KV_LORA = 128, QK_ROPE = 32, QK_NOPE = 64, QK_HEAD = 96, V_HEAD = 128, NHEAD = 4;
constexpr int SGU_W = 256, POOL_W = 256, CHUNK = 128;
constexpr int IN_W = 1184, ZLD = 1280;
constexpr int ZO_KV = 256, ZO_ROPE = 384, ZO_U = 416, ZO_V = 672, ZO_P = 928;
constexpr int FF = 2816, FF2 = 2 * FF;
constexpr float EPS = 1e-6f;
constexpr float QPRESCALE = 1.4426950408889634f * 0.10206207261596575f;
constexpr int PH_PER_LAYER = 7, NPH = 1 + DEPTH * PH_PER_LAYER;
constexpr int N_LAUNCHES = (MK_N_LAUNCHES == 1) ? 1 : NPH;

constexpr size_t MiB = 1u << 20;
constexpr size_t WS_CTL = 0, CTL_ZERO_BYTES = 64 * 1024 + (size_t)4 * 16384 * 4;
constexpr size_t WS_SSQ = 64 * 1024;
constexpr size_t WS_W = 2 * MiB, LW = 22 * MiB;
constexpr size_t OW_IN = 0, OW_Q = OW_IN + (size_t)ZLD * DM * 2, OW_KV = OW_Q + (size_t)384 * Q_LORA * 2, OW_OUT = OW_KV + (size_t)768 * KV_LORA * 2,
                 OW_GU = OW_OUT + (size_t)DM * DM * 2, OW_DN = OW_GU + (size_t)FF2 * DM * 2, OW_POOL = OW_DN + (size_t)DM * FF * 2, OW_SP = OW_POOL + (size_t)4 * 64 * 64 * 2, OW_END = OW_SP + (size_t)4 * CHUNK * CHUNK * 2;
static_assert(OW_END + 64 <= LW, "weight map");
constexpr size_t WS_CS = 46 * MiB;
constexpr size_t WS_XB = 48 * MiB;
constexpr size_t WS_Z = 80 * MiB;
constexpr size_t WS_MIX = 120 * MiB;
constexpr size_t WS_Q = 152 * MiB, WS_K = 168 * MiB, WS_V = 184 * MiB;
constexpr size_t WS_ML = 200 * MiB;
constexpr size_t WS_H = 152 * MiB;
constexpr size_t WS_END = 240 * MiB;
constexpr size_t OPART_BYTES = (size_t)8 * SEQ * 128 * 2;
constexpr size_t WS_OP01 = 202 * MiB;
static_assert(WS_W + DEPTH * LW <= WS_CS && WS_H + (size_t)M * FF * 2 <= WS_END && WS_END <= 256 * MiB && WS_Z + (size_t)M * ZLD * 2 <= WS_MIX && WS_Z + 2 * OPART_BYTES <= WS_MIX && WS_OP01 + 2 * OPART_BYTES <= 256 * MiB, "d_ws map");
__host__ __device__ constexpr size_t opart_off(int chunk) { return chunk < 2 ? WS_OP01 + (size_t)chunk * OPART_BYTES : WS_Z + (size_t)(chunk - 2) * OPART_BYTES; }
constexpr int CW_TMO = 0, CW_CODE = 1;
constexpr int CW_BAR = 4096;
constexpr int CW_GB = 8192;

constexpr int RING_OFF = 0, RING_BYTES = 163584;
constexpr int LDSCTL_OFF = RING_BYTES, MISC_OFF = LDSCTL_OFF;
constexpr int LDS_BYTES = 163840;
static_assert(MISC_OFF + 64 <= LDS_BYTES, "LDS map");

#define GAS __attribute__((address_space(1)))
#define LAS __attribute__((address_space(3)))
typedef unsigned short bf16;
typedef unsigned v4u __attribute__((ext_vector_type(4)));
typedef float f32x4 __attribute__((ext_vector_type(4)));
typedef short bf16x8 __attribute__((ext_vector_type(8)));
typedef GAS unsigned gu32;
typedef GAS unsigned long long gu64;
#define RLX_AGENT __ATOMIC_RELAXED, __HIP_MEMORY_SCOPE_AGENT
#define LDS_WAIT() asm volatile("s_waitcnt lgkmcnt(0)" ::: "memory")
#define VM_WAIT() asm volatile("s_waitcnt vmcnt(0)" ::: "memory")
__device__ __forceinline__ unsigned long long rt() { return __builtin_amdgcn_s_memrealtime(); }
__device__ __forceinline__ unsigned f2bf(float f) { unsigned u = __builtin_bit_cast(unsigned, f); return (u + 0x7fffu + ((u >> 16) & 1u)) >> 16; }
typedef float f32x2_t __attribute__((ext_vector_type(2))); typedef __bf16 bf16x2_t __attribute__((ext_vector_type(2)));
__device__ __forceinline__ unsigned pk2(float lo, float hi) { f32x2_t v = {lo, hi}; bf16x2_t b = __builtin_convertvector(v, bf16x2_t); return __builtin_bit_cast(unsigned, b); }

#ifndef XB_EARLY_INV
#define XB_EARLY_INV 1
#endif
#ifndef XB_EARLY_WB
#define XB_EARLY_WB 0
#endif
#ifndef XB_FLAT_RELEASE
#define XB_FLAT_RELEASE 1
#endif
#define XB_TMO      128
#define XB_XCNT(j)  (256  + 64 * (j))
#define XB_XSUB(j)  (1280 + 64 * (j))
#define XB_XGEN(j)  (2304 + 64 * (j))
#define XB_TOP      3328
#define XB_TOPGEN   3392
#define XCD_BAR_WORDS 3456
#define XB_SPIN_CAP (1u << 18)

__device__ __forceinline__ unsigned xb_ld(unsigned* p)              { return __hip_atomic_load(p, __ATOMIC_RELAXED, __HIP_MEMORY_SCOPE_AGENT); }
__device__ __forceinline__ unsigned xb_add(unsigned* p, unsigned v) { return __hip_atomic_fetch_add(p, v, __ATOMIC_RELAXED, __HIP_MEMORY_SCOPE_AGENT); }
__device__ __forceinline__ unsigned xb_xcc_id() { return (unsigned)__builtin_amdgcn_s_getreg((3 << 11) | 20) & 0xFu; }
#define XB_SPIN(cond, bar) do { unsigned _sp = 0; while (cond) { __builtin_amdgcn_s_sleep(1); \
    if ((++_sp & 255u) == 0u) { if (xb_ld(&(bar)[XB_TMO])) break; if (_sp > XB_SPIN_CAP) { atomicAdd(&(bar)[XB_TMO], 1u); break; } } } } while (0)

struct XcdBarrier {
    unsigned* bar; unsigned x;
    volatile LAS unsigned* st;
};

__device__ __forceinline__ XcdBarrier xcd_barrier_post(unsigned* bar, volatile LAS unsigned* st) {
    XcdBarrier b; b.bar = bar; b.x = xb_xcc_id(); b.st = st;
    if (threadIdx.x == 0) (void)xb_add(&bar[XB_XCNT(b.x)], 1u);
    return b;
}
__device__ __forceinline__ void xcd_barrier_complete(unsigned* bar, unsigned x, unsigned& nloc, unsigned& nx) {
    const unsigned G = gridDim.x * gridDim.y * gridDim.z;
    unsigned sum, cnt, mine, sp = 0u;
    for (;;) {
        sum = 0u; cnt = 0u; mine = 0u;
#pragma unroll
        for (unsigned j = 0; j < 16; ++j) { const unsigned c = xb_ld(&bar[XB_XCNT(j)]); sum += c; cnt += (c > 0u) ? 1u : 0u; mine = (j == x) ? c : mine; }
        if (sum == G) break;
        __builtin_amdgcn_s_sleep(1);
        if ((++sp & 255u) == 0u) { if (xb_ld(&bar[XB_TMO])) break; if (sp > XB_SPIN_CAP) { atomicAdd(&bar[XB_TMO], 1u); break; } }
    }
    nloc = mine > 0u ? mine : 1u; nx = cnt > 0u ? cnt : 1u;
}

__device__ __forceinline__ void xcd_barrier(const XcdBarrier& b) {
    asm volatile("s_waitcnt vmcnt(0)" ::: "memory");
    __syncthreads();
    if (threadIdx.x == 0) {
        unsigned* bar = b.bar;
        __builtin_amdgcn_s_waitcnt(0);
        unsigned nloc = b.st[0], nx = b.st[1];
        if (nloc == 0u) { xcd_barrier_complete(bar, b.x, nloc, nx); b.st[0] = nloc; b.st[1] = nx; }
        const unsigned old = xb_add(&bar[XB_XSUB(b.x)], 1u);
        const unsigned gen = old / nloc;
        if (old + 1u == (gen + 1u) * nloc) {
            __builtin_amdgcn_fence(__ATOMIC_RELEASE, "agent");
            asm volatile("s_waitcnt vmcnt(0)" ::: "memory");
            const unsigned og = xb_add(&bar[XB_TOP], 1u);
            const unsigned tg = og / nx;
#if XB_EARLY_INV
            if (og + 1u == (tg + 1u) * nx) { xb_add(&bar[XB_TOPGEN], 1u);
                __builtin_amdgcn_fence(__ATOMIC_ACQUIRE, "agent"); }
            else { __builtin_amdgcn_fence(__ATOMIC_ACQUIRE, "agent");
                   XB_SPIN(xb_ld(&bar[XB_TOPGEN]) == tg, bar); }
#else
            if (og + 1u == (tg + 1u) * nx) xb_add(&bar[XB_TOPGEN], 1u);
            else XB_SPIN(xb_ld(&bar[XB_TOPGEN]) == tg, bar);
            __builtin_amdgcn_fence(__ATOMIC_ACQUIRE, "agent");
#endif
#if !(XB_EARLY_INV && XB_FLAT_RELEASE)
            xb_add(&bar[XB_XGEN(b.x)], 1u);
#endif
            asm volatile("s_waitcnt vmcnt(0)" ::: "memory");
        } else {
#if XB_EARLY_WB
            if (old == gen * nloc) { __builtin_amdgcn_fence(__ATOMIC_RELEASE, "agent"); asm volatile("s_waitcnt vmcnt(0)" ::: "memory"); }
#endif
#if XB_EARLY_INV
            __builtin_amdgcn_fence(__ATOMIC_ACQUIRE, "agent");
            asm volatile("s_waitcnt vmcnt(0)" ::: "memory");
#if XB_FLAT_RELEASE
            XB_SPIN(xb_ld(&bar[XB_TOPGEN]) == gen, bar);
#else
            XB_SPIN(xb_ld(&bar[XB_XGEN(b.x)]) == gen, bar);
#endif
#else
            XB_SPIN(xb_ld(&bar[XB_XGEN(b.x)]) == gen, bar);
            __builtin_amdgcn_fence(__ATOMIC_ACQUIRE, "agent");
            asm volatile("s_waitcnt vmcnt(0)" ::: "memory");
#endif
        }
    }
    __syncthreads();
}

__device__ __forceinline__ void xcd_barrier_arrive(const XcdBarrier& b) {
    asm volatile("s_waitcnt vmcnt(0)" ::: "memory");
    __syncthreads();
    if (threadIdx.x == 0) {
        unsigned* bar = b.bar;
        __builtin_amdgcn_s_waitcnt(0);
        const unsigned nloc = b.st[0], nx = b.st[1];
        const unsigned old = xb_add(&bar[XB_XSUB(b.x)], 1u);
        const unsigned gen = old / nloc;
        b.st[2] = gen;
        if (old + 1u == (gen + 1u) * nloc) {
            __builtin_amdgcn_fence(__ATOMIC_RELEASE, "agent");
            asm volatile("s_waitcnt vmcnt(0)" ::: "memory");
            const unsigned og = xb_add(&bar[XB_TOP], 1u);
            const unsigned tg = og / nx;
            if (og + 1u == (tg + 1u) * nx) xb_add(&bar[XB_TOPGEN], 1u);
        }
    }
    __syncthreads();
}
__device__ __forceinline__ void xcd_barrier_wait(const XcdBarrier& b) {
    asm volatile("s_waitcnt vmcnt(0)" ::: "memory");
    __syncthreads();
    if (threadIdx.x == 0) {
        const unsigned gen = b.st[2];
        __builtin_amdgcn_fence(__ATOMIC_ACQUIRE, "agent");
        asm volatile("s_waitcnt vmcnt(0)" ::: "memory");
        XB_SPIN(xb_ld(&b.bar[XB_TOPGEN]) == gen, b.bar);
    }
    __syncthreads();
}

typedef unsigned u32x2 __attribute__((ext_vector_type(2)));
#define CAS __attribute__((address_space(4)))
struct Args { const float* in[23]; float* out; unsigned char* ws; int ph_lo, ph_hi, li, pad; };
struct Frame {
    LAS unsigned char* lds;
    const CAS Args* a;
    int lane, wave;
    int vcu, G;
};
__device__ __forceinline__ float wave_sum(float v) {
#pragma unroll
    for (int o = 1; o < 64; o <<= 1) v += __shfl_xor(v, o);
    return v;
}
__device__ __forceinline__ float wave_sum_dpp(float v) {
#define WS_DPP(ctrl, rmask) v += __builtin_bit_cast(float, __builtin_amdgcn_update_dpp(0, __builtin_bit_cast(int, v), ctrl, rmask, 0xf, false))
    WS_DPP(0x111, 0xf); WS_DPP(0x112, 0xf); WS_DPP(0x114, 0xf); WS_DPP(0x118, 0xf); WS_DPP(0x142, 0xa); WS_DPP(0x143, 0xc);
#undef WS_DPP
    return __builtin_bit_cast(float, __builtin_amdgcn_readlane(__builtin_bit_cast(int, v), 63));
}
__device__ __forceinline__ float quad_sum(float v) { v += __shfl_xor(v, 16); v += __shfl_xor(v, 32); return v; }
__device__ __forceinline__ float bf2f(unsigned short h) { return __builtin_bit_cast(float, (unsigned)h << 16); }
__device__ __forceinline__ float bflo(unsigned w) { return __builtin_bit_cast(float, w << 16); }
__device__ __forceinline__ float bfhi(unsigned w) { return __builtin_bit_cast(float, w & 0xffff0000u); }
__device__ __forceinline__ f32x4 mfma16(bf16x8 a, bf16x8 b, f32x4 c) { return __builtin_amdgcn_mfma_f32_16x16x32_bf16(a, b, c, 0, 0, 0); }
__device__ __forceinline__ u32x2 pk4(f32x4 v) { u32x2 w; w.x = pk2(v[0], v[1]); w.y = pk2(v[2], v[3]); return w; }
__device__ __forceinline__ bf16x8 pk8(const float* v) { v4u w; w.x = pk2(v[0], v[1]); w.y = pk2(v[2], v[3]); w.z = pk2(v[4], v[5]); w.w = pk2(v[6], v[7]); return __builtin_bit_cast(bf16x8, w); }

#define IN_F(i) ((const float*)F.a->in[i])
__device__ __forceinline__ bf16* wsp(const Frame& F, size_t off) { return (bf16*)(F.a->ws + off); }
__device__ __forceinline__ float* ssq_mix(const Frame& F, int l) { return (float*)(F.a->ws + WS_SSQ) + (size_t)(2 * l) * M; }
__device__ __forceinline__ float* ssq_ffn(const Frame& F, int l) { return (float*)(F.a->ws + WS_SSQ) + (size_t)(2 * l + 1) * M; }

__device__ __forceinline__ void p0_tr_item64(const float* W, int ldw, int k0, int n0, int nv, const float* gain, bf16* WT, int ldt, int drow0, LAS float* scr, int lane) {
    const int c4 = 4 * (lane & 15), rr = lane >> 4;
    f32x4 v[16]; float gg[16];
#pragma unroll
    for (int i = 0; i < 16; ++i) gg[i] = gain ? gain[k0 + rr + 4 * i] : 1.0f;
#pragma unroll
    for (int i = 0; i < 16; ++i) { v[i] = (f32x4){0.f, 0.f, 0.f, 0.f}; if (c4 < nv) v[i] = *(const GAS f32x4*)(W + (size_t)(k0 + rr + 4 * i) * ldw + n0 + c4); }
#pragma unroll
    for (int i = 0; i < 16; ++i) { const int kk = rr + 4 * i; const float g = gg[i];
#pragma unroll
        for (int e = 0; e < 4; ++e) scr[kk * 65 + c4 + e] = v[i][e] * g; }
    LDS_WAIT(); asm volatile("" ::: "memory");
    const int c = lane & 7;
#pragma unroll
    for (int j = 0; j < 8; ++j) { const int n = (lane >> 3) + 8 * j; const LAS float* sp = scr + (8 * c) * 65 + n;
        if (n < nv) { v4u o; o.x = pk2(sp[0 * 65], sp[1 * 65]); o.y = pk2(sp[2 * 65], sp[3 * 65]); o.z = pk2(sp[4 * 65], sp[5 * 65]); o.w = pk2(sp[6 * 65], sp[7 * 65]);
            *(GAS v4u*)(WT + (size_t)(drow0 + n) * ldt + k0 + 8 * c) = o; } }
    LDS_WAIT(); asm volatile("" ::: "memory");
}
constexpr int CI_IN = (DM / 64) * ((IN_W + 63) / 64), CI_Q = (Q_LORA / 64) * (384 / 64), CI_KV = (KV_LORA / 64) * (768 / 64), CI_SET0 = CI_IN + CI_Q + CI_KV;
constexpr int CI_OUT = (DM / 64) * (DM / 64), CI_G = (DM / 64) * (FF / 64), CI_DN = (FF / 64) * (DM / 64), CI_SET1 = CI_OUT + 2 * CI_G + CI_DN;
__device__ __forceinline__ void conv_item(Frame& F, int l, int set, int r, LAS float* scr, int lane) {
    unsigned char* wl = F.a->ws + WS_W + (size_t)l * LW;
    if (set == 0) {
        if (r < CI_IN) { const int nb = (IN_W + 63) / 64, kb = r / nb, n0 = 64 * (r % nb);
            p0_tr_item64(IN_F(3) + (size_t)l * DM * IN_W, IN_W, 64 * kb, n0, IN_W - n0 < 64 ? IN_W - n0 : 64, IN_F(2) + l * DM, (bf16*)(wl + OW_IN), DM, n0, scr, lane); return; } r -= CI_IN;
        if (r < CI_Q) { const int nb = 384 / 64, kb = r / nb, n0 = 64 * (r % nb);
            p0_tr_item64(IN_F(5) + (size_t)l * Q_LORA * 384, 384, 64 * kb, n0, 64, IN_F(4) + l * Q_LORA, (bf16*)(wl + OW_Q), Q_LORA, n0, scr, lane); return; } r -= CI_Q;
        { const int nb = 768 / 64, kb = r / nb, n0 = 64 * (r % nb);
            p0_tr_item64(IN_F(7) + (size_t)l * KV_LORA * 768, 768, 64 * kb, n0, 64, IN_F(6) + l * KV_LORA, (bf16*)(wl + OW_KV), KV_LORA, n0, scr, lane); return; }
    }
    if (r < CI_OUT) { const int nb = DM / 64, kb = r / nb, n0 = 64 * (r % nb), k0 = 64 * kb;
        const float* g = k0 < 512 ? IN_F(15) + l * 512 : k0 < 768 ? IN_F(16) + l * 256 - 512 : IN_F(17) + l * 256 - 768;
        p0_tr_item64(IN_F(18) + (size_t)l * DM * DM, DM, k0, n0, 64, g, (bf16*)(wl + OW_OUT), DM, n0, scr, lane); return; } r -= CI_OUT;
    if (r < 2 * CI_G) { const int up = r >= CI_G; if (up) r -= CI_G; const int nb = FF / 64, kb = r / nb, n0 = 64 * (r % nb);
        p0_tr_item64(IN_F(up ? 21 : 20) + (size_t)l * DM * FF, FF, 64 * kb, n0, 64, IN_F(19) + l * DM, (bf16*)(wl + OW_GU), DM, (n0 >> 7) * 256 + (n0 & 127) + (up ? 128 : 0), scr, lane); return; } r -= 2 * CI_G;
    { const int nb = DM / 64, kb = r / nb, n0 = 64 * (r % nb);
        p0_tr_item64(IN_F(22) + (size_t)l * FF * DM, DM, 64 * kb, n0, 64, nullptr, (bf16*)(wl + OW_DN), FF, n0, scr, lane); }
}
__device__ __forceinline__ void conv_set(Frame& F, int l, int set, int wk, int nwk, int first = 0, int last = 1 << 30) {
    LAS float* scr = (LAS float*)(F.lds + RING_OFF + F.wave * 16640);
    const int n = set == 0 ? CI_SET0 : CI_SET1, hi = last < n ? last : n;
    for (int it = first + wk; it < hi; it += nwk) conv_item(F, l, set, it, scr, F.lane);
}
constexpr int CI_SPLIT = 1184;
#ifndef CONV_DEFER
#define CONV_DEFER 1
#endif
__device__ __forceinline__ void p0_prologue(Frame& F) {
    const int gw = F.vcu * NWAVES + F.wave, NGW = F.G * NWAVES, lane = F.lane;
    { const int wk0 = F.wave * F.G + F.vcu;
      for (int l = 0; l < DEPTH; ++l) { conv_set(F, l, 0, (wk0 + NGW - (l * CI_SET0) % NGW) % NGW, NGW); if (!CONV_DEFER) conv_set(F, l, 1, gw, NGW); } }
    { const int gt = gw * 64 + lane, NGT = NGW * 64;
        constexpr int NPAD = DEPTH * (ZLD - IN_W) * DM / 8, NPOOL = DEPTH * 4 * 64 * 64, NTRIL = DEPTH * 4 * CHUNK * CHUNK / 8, NROPE = M * 16;
        const int* pos = (const int*)IN_F(1);
        auto pad_body = [&](int i) { const int l = i / ((ZLD - IN_W) * DM / 8), e = i % ((ZLD - IN_W) * DM / 8);
            *(GAS v4u*)(F.a->ws + WS_W + (size_t)l * LW + OW_IN + (size_t)IN_W * DM * 2 + (size_t)e * 16) = (v4u){0u, 0u, 0u, 0u}; };
        auto pool_ld = [&](int i, float& w, float& sc) { const int l = i >> 14, g = (i >> 12) & 3, d = (i >> 6) & 63, c = i & 63; w = IN_F(13)[(size_t)l * 16384 + (g * 64 + c) * 64 + d]; sc = IN_F(14)[l * POOL_W + g * 64 + d]; };
        auto pool_body = [&](int i, float w, float sc) { const int l = i >> 14, g = (i >> 12) & 3, d = (i >> 6) & 63, c = i & 63;
            ((bf16*)(F.a->ws + WS_W + (size_t)l * LW + OW_POOL))[(g * 64 + d) * 64 + c] = (bf16)f2bf(w * sc); };
        auto tril_ld = [&](int i, f32x4& a, f32x4& b) { const int l = i >> 13, e = (i & 8191) * 8; const float* src = IN_F(11) + (size_t)l * 4 * CHUNK * CHUNK + e; a = *(const f32x4*)src; b = *(const f32x4*)(src + 4); };
        auto tril_body = [&](int i, f32x4 a, f32x4 b) { const int l = i >> 13, e = (i & 8191) * 8, t = (e >> 7) & 127, s0 = e & 127;
            float v[8] = {a[0], a[1], a[2], a[3], b[0], b[1], b[2], b[3]};
#pragma unroll
            for (int j = 0; j < 8; ++j) if (s0 + j > t) v[j] = 0.f;
            *(bf16x8*)(F.a->ws + WS_W + (size_t)l * LW + OW_SP + (size_t)e * 2) = pk8(v); };
        auto rope_body = [&](int i, int pv) { const int m = i >> 4, f = i & 15;
            const float inv = 1.0f / powf(10000.0f, (float)f * (1.0f / 16.0f));
            const float ang = (float)pv * inv;
            const double a = (double)ang, n = rint(a * 0.15915494309189535), y = a - n * 6.283185307179586;
            const float yf = (float)y; ((float*)(F.a->ws + WS_CS))[(size_t)m * 32 + f] = cosf(yf); ((float*)(F.a->ws + WS_CS))[(size_t)m * 32 + 16 + f] = sinf(yf); };
        { float pw = 0.f, psc = 0.f; f32x4 ta = {0.f, 0.f, 0.f, 0.f}, tb = ta; int pv0 = 0, pv1 = 0;
          if (gt < NPOOL) pool_ld(gt, pw, psc);
          if (gt < NTRIL) tril_ld(gt, ta, tb);
          if (gt < NROPE) pv0 = pos[gt >> 4];
          if (gt + NGT < NROPE) pv1 = pos[(gt + NGT) >> 4];
          if (gt < NPAD) pad_body(gt);
          if (gt < NPOOL) pool_body(gt, pw, psc);
          if (gt < NTRIL) tril_body(gt, ta, tb);
          if (gt < NROPE) rope_body(gt, pv0);
          if (gt + NGT < NROPE) rope_body(gt + NGT, pv1); }
        for (int i = gt + NGT; i < NPAD; i += NGT) pad_body(i);
        for (int i = gt + NGT; i < NPOOL; i += NGT) { float w, sc; pool_ld(i, w, sc); pool_body(i, w, sc); }
        for (int i = gt + NGT; i < NTRIL; i += NGT) { f32x4 a, b; tril_ld(i, a, b); tril_body(i, a, b); }
        for (int i = gt + 2 * NGT; i < NROPE; i += NGT) rope_body(i, pos[i >> 4]);
    }
    if (gw < DEPTH) { const int l = gw; float gqm = 0.f, gkm = 0.f; const float* gq = IN_F(8) + l * QK_HEAD; const float* gk = IN_F(9) + l * QK_HEAD;
        for (int i = lane; i < QK_HEAD; i += 64) { gqm = fmaxf(gqm, fabsf(gq[i])); gkm = fmaxf(gkm, fabsf(gk[i])); }
#pragma unroll
        for (int o = 1; o < 64; o <<= 1) { gqm = fmaxf(gqm, __shfl_xor(gqm, o)); gkm = fmaxf(gkm, __shfl_xor(gkm, o)); }
        if (lane == 0) *(float*)(F.a->ws + WS_W + (size_t)l * LW + OW_END) = fmaxf(0.f, 1.4426950408889634f * 9.797958971132712f * gqm * gkm - 64.0f); }
    float* ssq0 = ssq_mix(F, 0);
#ifdef PROBE_TWICE
    for (int i = gw * 64 + lane; i < 3 * M; i += NGW * 64) ssq0[M + i] = 0.f;
#endif
    static_assert(M % (64 * 256) == 0, "x pass: 64 rows per workgroup and round");
    for (int mb = F.vcu * 64; mb < M; mb += F.G * 64)
    for (int j = F.wave >= 3 ? F.wave - 3 : 13 + F.wave; j < (F.wave >= 3 ? 13 : 16); j += (F.wave >= 3 ? 5 : 16)) {
        const int m0 = mb + 4 * j;
        f32x4 v[4][4];
#pragma unroll
        for (int r = 0; r < 4; ++r) { const GAS f32x4* xr = (const GAS f32x4*)(IN_F(0) + (size_t)(m0 + r) * DM) + 2 * lane;
#pragma unroll
            for (int j = 0; j < 2; ++j) { v[r][2 * j] = xr[128 * j]; v[r][2 * j + 1] = xr[128 * j + 1]; } }
#pragma unroll
        for (int r = 0; r < 4; ++r) { float s = 0.f; GAS v4u* o16 = (GAS v4u*)(wsp(F, WS_XB) + (size_t)(m0 + r) * DM) + lane;
#pragma unroll
            for (int j = 0; j < 2; ++j) { const f32x4 x = v[r][2 * j], y = v[r][2 * j + 1];
                s += ((x.x * x.x + x.y * x.y) + (x.z * x.z + x.w * x.w)) + ((y.x * y.x + y.y * y.y) + (y.z * y.z + y.w * y.w));
                o16[64 * j] = (v4u){pk2(x.x, x.y), pk2(x.z, x.w), pk2(y.x, y.y), pk2(y.z, y.w)}; }
            s = wave_sum_dpp(s); if (lane == 0) ssq0[m0 + r] = s; }
    }
}

__device__ __forceinline__ void p2_upproj_unit(Frame& F, int l, int chunk, bool dry = false) {
    int lane_ = F.lane; asm volatile("" : "+v"(lane_));
    const int lane = lane_, tl = lane & 15, kq = lane >> 4;
    const int m0w = chunk * CHUNK + F.wave * 16, m = m0w + tl, b = m >> 13, s0w = m0w & (SEQ - 1);
    const bf16* zrow = wsp(F, WS_Z) + (size_t)m * ZLD;
    const unsigned char* wl = F.a->ws + WS_W + (size_t)l * LW;
    const bf16* Wq = (const bf16*)(wl + OW_Q); const bf16* Wkv = (const bf16*)(wl + OW_KV);
    LAS unsigned char* buf0 = F.lds + RING_OFF; LAS unsigned char* buf1 = F.lds + RING_OFF + 49152;
    LAS unsigned char* stg = F.lds + RING_OFF + 98304 + F.wave * 4352;
#define UP_DMAQ(h_) do { _Pragma("unroll") for (int i = 0; i < 6; ++i) { const int j = F.wave * 6 + i, row = 2 * j + (lane >> 5), slot = lane & 31; \
        __builtin_amdgcn_global_load_lds((const unsigned*)((const unsigned char*)Wq + (size_t)((h_) * QK_HEAD + row) * (Q_LORA * 2) + ((slot ^ (row & 15)) * 16)), (LAS unsigned*)(buf0 + j * 1024), 16, 0, 0); } } while (0)
#define UP_DMAKV(h_) do { _Pragma("unroll") for (int i = 0; i < 6; ++i) { const int j = F.wave * 6 + i, row = 4 * j + (lane >> 4), slot = lane & 15; \
        __builtin_amdgcn_global_load_lds((const unsigned*)((const unsigned char*)Wkv + (size_t)((h_) * 192 + row) * (KV_LORA * 2) + ((slot ^ (row & 15)) * 16)), (LAS unsigned*)(buf1 + j * 1024), 16, 0, 0); } } while (0)
    UP_DMAQ(0);
    bf16x8 zq[8], zkv[4];
#pragma unroll
    for (int ks = 0; ks < 8; ++ks) zq[ks] = *(const bf16x8*)(zrow + ks * 32 + kq * 8);
#pragma unroll
    for (int ks = 0; ks < 4; ++ks) zkv[ks] = *(const bf16x8*)(zrow + ZO_KV + ks * 32 + kq * 8);
    const u32x2 kw0 = *(const u32x2*)(zrow + ZO_ROPE + 4 * kq), kw1 = *(const u32x2*)(zrow + ZO_ROPE + 16 + 4 * kq);
    const float* csr = (const float*)(F.a->ws + WS_CS) + (size_t)m * 32;
    const f32x4 cs = *(const f32x4*)(csr + 4 * kq), sn = *(const f32x4*)(csr + 16 + 4 * kq);
    const float* gq = IN_F(8) + l * QK_HEAD; const float* gk = IN_F(9) + l * QK_HEAD;
    LAS float* gtab = (LAS float*)(F.lds + RING_OFF + 98304 + 8 * 4352);
    if (F.wave == 0) { for (int i = lane; i < 2 * QK_HEAD; i += 64) gtab[i] = i < QK_HEAD ? gq[i] : gk[i - QK_HEAD]; }
#define gqv(nb_) (*(const LAS f32x4*)(gtab + (nb_) * 16 + 4 * kq))
#define gkv(nb_) (*(const LAS f32x4*)(gtab + QK_HEAD + (nb_) * 16 + 4 * kq))
    float sq = 0.f, skv = 0.f;
#pragma unroll
    for (int ks = 0; ks < 8; ++ks)
#pragma unroll
        for (int j = 0; j < 8; ++j) { const float v = bf2f((unsigned short)zq[ks][j]); sq += v * v; }
#pragma unroll
    for (int ks = 0; ks < 4; ++ks)
#pragma unroll
        for (int j = 0; j < 8; ++j) { const float v = bf2f((unsigned short)zkv[ks][j]); skv += v * v; }
    const float r_q = __builtin_amdgcn_rsqf(quad_sum(sq) * (1.0f / Q_LORA) + EPS), r_kv = __builtin_amdgcn_rsqf(quad_sum(skv) * (1.0f / KV_LORA) + EPS);
    const f32x4 kr0 = {bflo(kw0.x), bfhi(kw0.x), bflo(kw0.y), bfhi(kw0.y)}, kr1 = {bflo(kw1.x), bfhi(kw1.x), bflo(kw1.y), bfhi(kw1.y)};
    float skr = (kr0[0] * kr0[0] + kr0[1] * kr0[1]) + (kr0[2] * kr0[2] + kr0[3] * kr0[3]) + (kr1[0] * kr1[0] + kr1[1] * kr1[1]) + (kr1[2] * kr1[2] + kr1[3] * kr1[3]);
    skr = quad_sum(skr);
#define UP_RD(dst_, ad_, OFF_) asm volatile("ds_read_b128 %0, %1 offset:%2" : "=v"(dst_) : "v"(ad_), "i"(OFF_) : "memory")
    const unsigned qbase = (unsigned)(uintptr_t)buf0 + tl * 512, kbase = (unsigned)(uintptr_t)buf1 + tl * 256;
#define UP_RDQ(d_, ks_) do { const unsigned ad_ = qbase + ((((ks_) * 4 + kq) ^ tl) << 4); UP_RD(d_[0], ad_, 0); UP_RD(d_[1], ad_, 8192); UP_RD(d_[2], ad_, 16384); UP_RD(d_[3], ad_, 24576); UP_RD(d_[4], ad_, 32768); UP_RD(d_[5], ad_, 40960); } while (0)
#define UP_RDKV(d_, ks_) do { const unsigned ad_ = kbase + ((((ks_) * 4 + kq) ^ tl) << 4); UP_RD(d_[0], ad_, 0); UP_RD(d_[1], ad_, 4096); UP_RD(d_[2], ad_, 8192); UP_RD(d_[3], ad_, 12288); UP_RD(d_[4], ad_, 16384); UP_RD(d_[5], ad_, 20480); \
        UP_RD(d_[6], ad_, 24576); UP_RD(d_[7], ad_, 28672); UP_RD(d_[8], ad_, 32768); UP_RD(d_[9], ad_, 36864); UP_RD(d_[10], ad_, 40960); UP_RD(d_[11], ad_, 45056); } while (0)
#define UP_PUT(nb_, v_) (*(LAS u32x2*)(stg + tl * 272 + (nb_) * 32 + kq * 8) = pk4(v_))
#ifdef PROBE_DRYSTORE
#define UP_DRY dry
#else
#define UP_DRY false
#endif
#define UP_FLUSH(dst_) do { if (!UP_DRY) { unsigned char* d_ = (unsigned char*)(dst_) + (size_t)(lane >> 4) * 256 + (lane & 15) * 16; _Pragma("unroll") for (int i = 0; i < 4; ++i) \
        *(GAS v4u*)(d_ + i * 1024) = *(const LAS v4u*)(stg + (4 * i + (lane >> 4)) * 272 + (lane & 15) * 16); } } while (0)
    __syncthreads();
#pragma unroll 1
    for (int h = 0; h < NHEAD; ++h) {
        const size_t orow0 = ((size_t)(b * NHEAD + h) * SEQ + s0w) * 128;
#ifdef PROBE_NODMA
        if (!dry)
#endif
        UP_DMAKV(h); asm volatile("" ::: "memory");
        {
            f32x4 acc[6];
#pragma unroll
            for (int nb = 0; nb < 6; ++nb) acc[nb] = (f32x4){0.f, 0.f, 0.f, 0.f};
            {
                bf16x8 fa[6], fb[6];
                UP_RDQ(fa, 0);
#define UP_QSTEP(cur_, nxt_, ks_) do { asm volatile("s_waitcnt lgkmcnt(0)" ::: "memory"); __builtin_amdgcn_sched_barrier(0); if ((ks_) + 1 < 8) UP_RDQ(nxt_, (ks_) + 1); \
                    _Pragma("unroll") for (int nb = 0; nb < 6; ++nb) acc[nb] = mfma16(cur_[nb], zq[ks_], acc[nb]); __builtin_amdgcn_sched_barrier(0); } while (0)
                UP_QSTEP(fa, fb, 0); UP_QSTEP(fb, fa, 1); UP_QSTEP(fa, fb, 2); UP_QSTEP(fb, fa, 3); UP_QSTEP(fa, fb, 4); UP_QSTEP(fb, fa, 5); UP_QSTEP(fa, fb, 6); UP_QSTEP(fb, fa, 7);
#undef UP_QSTEP
            }
            float ss = 0.f;
#pragma unroll
            for (int nb = 0; nb < 6; ++nb) { acc[nb] = acc[nb] * r_q; ss += (acc[nb][0] * acc[nb][0] + acc[nb][1] * acc[nb][1]) + (acc[nb][2] * acc[nb][2] + acc[nb][3] * acc[nb][3]); }
            const float rh = __builtin_amdgcn_rsqf(quad_sum(ss) * (1.0f / QK_HEAD) + EPS);
#pragma unroll
            for (int nb = 0; nb < 6; ++nb) acc[nb] = acc[nb] * (rh * QPRESCALE) * gqv(nb);
            const f32x4 x1 = acc[4], x2 = acc[5]; acc[4] = x1 * cs - x2 * sn; acc[5] = x2 * cs + x1 * sn;
#pragma unroll
            for (int nb = 0; nb < 6; ++nb) UP_PUT(nb, acc[nb]);
            UP_PUT(6, ((f32x4){0.f, 0.f, 0.f, 0.f})); UP_PUT(7, ((f32x4){0.f, 0.f, 0.f, 0.f}));
            UP_FLUSH(wsp(F, WS_Q) + orow0);
        }
        asm volatile("s_waitcnt vmcnt(4) lgkmcnt(0)" ::: "memory"); __builtin_amdgcn_s_barrier(); asm volatile("" ::: "memory");
#ifdef PROBE_NODMA
        if (!dry)
#endif
        if (h + 1 < NHEAD) UP_DMAQ(h + 1);
        asm volatile("" ::: "memory");
        {
            f32x4 acc[12];
#pragma unroll
            for (int nb = 0; nb < 12; ++nb) acc[nb] = (f32x4){0.f, 0.f, 0.f, 0.f};
            {
                bf16x8 fa[12], fb[12];
                UP_RDKV(fa, 0);
#define UP_KSTEP(cur_, nxt_, ks_) do { asm volatile("s_waitcnt lgkmcnt(0)" ::: "memory"); __builtin_amdgcn_sched_barrier(0); if ((ks_) + 1 < 4) UP_RDKV(nxt_, (ks_) + 1); \
                    _Pragma("unroll") for (int nb = 0; nb < 12; ++nb) acc[nb] = mfma16(cur_[nb], zkv[ks_], acc[nb]); __builtin_amdgcn_sched_barrier(0); } while (0)
                UP_KSTEP(fa, fb, 0); UP_KSTEP(fb, fa, 1); UP_KSTEP(fa, fb, 2); UP_KSTEP(fb, fa, 3);
#undef UP_KSTEP
            }
            float ss = 0.f;
#pragma unroll
            for (int nb = 0; nb < 4; ++nb) { acc[nb] = acc[nb] * r_kv; ss += (acc[nb][0] * acc[nb][0] + acc[nb][1] * acc[nb][1]) + (acc[nb][2] * acc[nb][2] + acc[nb][3] * acc[nb][3]); }
            const float rh = __builtin_amdgcn_rsqf((quad_sum(ss) + skr) * (1.0f / QK_HEAD) + EPS);
#pragma unroll
            for (int nb = 0; nb < 4; ++nb) UP_PUT(nb, acc[nb] * rh * gkv(nb));
            const f32x4 x1 = kr0 * rh * gkv(4), x2 = kr1 * rh * gkv(5);
            UP_PUT(4, x1 * cs - x2 * sn); UP_PUT(5, x2 * cs + x1 * sn);
            UP_PUT(6, ((f32x4){0.f, 0.f, 0.f, 0.f})); UP_PUT(7, ((f32x4){0.f, 0.f, 0.f, 0.f}));
            UP_FLUSH(wsp(F, WS_K) + orow0);
#pragma unroll
            for (int nb = 0; nb < 8; ++nb) UP_PUT(nb, acc[4 + nb] * r_kv);
            UP_FLUSH(wsp(F, WS_V) + orow0);
        }
        asm volatile("s_waitcnt vmcnt(8) lgkmcnt(0)" ::: "memory"); __builtin_amdgcn_s_barrier(); asm volatile("" ::: "memory");
    }
#undef gqv
#undef gkv
#undef UP_DMAQ
#undef UP_DMAKV
#undef UP_PUT
#undef UP_RD
#undef UP_RDQ
#undef UP_RDKV
#undef UP_FLUSH
}

constexpr int VS = 136;
__device__ __forceinline__ void p2_sgu_pool_unit(Frame& F, int l, int chunk, int cut = 0) {
    int lane_ = F.lane; asm volatile("" : "+v"(lane_));
    const int lane = lane_, tl = lane & 15, kq = lane >> 4, w = F.wave;
    LAS bf16* vnT = (LAS bf16*)(F.lds + RING_OFF);
    LAS unsigned char* pt = F.lds + RING_OFF + 69632;
    LAS unsigned char* stg = F.lds + RING_OFF + 145152 + w * 2304;
    const bf16* Z = wsp(F, WS_Z);
    const unsigned char* wl = F.a->ws + WS_W + (size_t)l * LW;
    const int t = w * 16 + tl, m = chunk * CHUNK + t, s = m & (SEQ - 1);
    const bf16* zrow = Z + (size_t)m * ZLD;
    v4u pv[9];
    { const int tid = w * 64 + lane, m0 = chunk * CHUNK, s0 = m0 & (SEQ - 1);
#pragma unroll
      for (int i = 0; i < 9; ++i) { const int c = tid + 512 * i, r = c >> 5, k = c & 31; pv[i] = (v4u){0u, 0u, 0u, 0u};
          if (c < 143 * 32 && s0 + r >= 15) pv[i] = *(const GAS v4u*)(Z + (size_t)(m0 - 15 + r) * ZLD + ZO_P + k * 8); } }
    u32x2 vws[16];
#pragma unroll
    for (int i = 0; i < 16; ++i) vws[i] = *(const u32x2*)(Z + (size_t)(chunk * CHUNK + w * 16 + i) * ZLD + ZO_V + 4 * lane);
    const f32x4 gv = *(const f32x4*)(IN_F(10) + l * SGU_W + 4 * lane);
    bf16x8 bfr[4][4];
#pragma unroll
    for (int ks = 0; ks < 4; ++ks)
#pragma unroll
        for (int h = 0; h < 4; ++h) bfr[ks][h] = *(const bf16x8*)(wl + OW_SP + ((size_t)(h * CHUNK + t) * CHUNK + ks * 32 + kq * 8) * 2);
    { float vv[4][16];
#pragma unroll
      for (int i = 0; i < 16; ++i) { const f32x4 v = {bflo(vws[i].x), bfhi(vws[i].x), bflo(vws[i].y), bfhi(vws[i].y)};
          const float r = __builtin_amdgcn_rsqf(wave_sum_dpp((v[0] * v[0] + v[1] * v[1]) + (v[2] * v[2] + v[3] * v[3])) * (1.0f / SGU_W) + EPS);
#pragma unroll
          for (int j = 0; j < 4; ++j) vv[j][i] = v[j] * r * gv[j]; }
#pragma unroll
      for (int j = 0; j < 4; ++j) { *(LAS bf16x8*)(vnT + (j * 64 + lane) * VS + w * 16) = pk8(&vv[j][0]); *(LAS bf16x8*)(vnT + (j * 64 + lane) * VS + w * 16 + 8) = pk8(&vv[j][8]); } }
    { const int tid = w * 64 + lane;
#pragma unroll
      for (int i = 0; i < 9; ++i) { const int c = tid + 512 * i, r = c >> 5, k = c & 31; if (c < 143 * 32) *(LAS v4u*)(pt + r * 528 + k * 16) = pv[i]; } }
    __syncthreads();
#ifdef PROBE_CUT
    if (cut == 1) { __syncthreads(); return; }
#endif
    unsigned char* mixw = (unsigned char*)(wsp(F, WS_MIX) + (size_t)(chunk * CHUNK + w * 16) * DM);
    {
        v4u uw[4][2]; float bsp[4];
#pragma unroll
        for (int h = 0; h < 4; ++h) { bsp[h] = IN_F(12)[(size_t)(l * 4 + h) * CHUNK + t];
#pragma unroll
            for (int e = 0; e < 2; ++e) uw[h][e] = *(const v4u*)(zrow + ZO_U + h * 64 + 16 * kq + 8 * e); }
        f32x4 acc[4][4];
#pragma unroll
        for (int h = 0; h < 4; ++h)
#pragma unroll
            for (int db = 0; db < 4; ++db) acc[h][db] = (f32x4){0.f, 0.f, 0.f, 0.f};
#pragma unroll
        for (int ks = 0; ks < 4; ++ks) {
#pragma unroll
            for (int h = 0; h < 4; ++h)
#pragma unroll
                for (int db = 0; db < 4; ++db) { const bf16x8 a = *(const LAS bf16x8*)(vnT + (db * 64 + h * 16 + tl) * VS + ks * 32 + kq * 8); acc[h][db] = mfma16(a, bfr[ks][h], acc[h][db]); }
            __builtin_amdgcn_sched_barrier(0);
        }
        float ss = 0.f;
#pragma unroll
        for (int h = 0; h < 4; ++h) { const unsigned uu[8] = {uw[h][0].x, uw[h][0].y, uw[h][0].z, uw[h][0].w, uw[h][1].x, uw[h][1].y, uw[h][1].z, uw[h][1].w};
#pragma unroll
            for (int r = 0; r < 4; ++r)
#pragma unroll
                for (int db = 0; db < 4; ++db) { const int c = 4 * r + db; const float u = (c & 1) ? bfhi(uu[c >> 1]) : bflo(uu[c >> 1]); const float g = u * (acc[h][db][r] + bsp[h]); acc[h][db][r] = g; ss += g * g; } }
        const float rB = __builtin_amdgcn_rsqf(quad_sum(ss) * (1.0f / SGU_W) + EPS);
#pragma unroll
        for (int h = 0; h < 4; ++h) { float o[16];
#pragma unroll
            for (int r = 0; r < 4; ++r)
#pragma unroll
                for (int db = 0; db < 4; ++db) o[4 * r + db] = acc[h][db][r] * rB;
            unsigned char* dst = mixw + (size_t)tl * (DM * 2) + (512 + h * 64 + 16 * kq) * 2;
            *(GAS bf16x8*)dst = pk8(&o[0]); *(GAS bf16x8*)(dst + 16) = pk8(&o[8]); }
    }
#ifdef PROBE_CUT
    if (cut == 2) { __syncthreads(); return; }
#endif
    {
        f32x4 acc[4][4];
#pragma unroll
        for (int g = 0; g < 4; ++g)
#pragma unroll
            for (int db = 0; db < 4; ++db) acc[g][db] = (f32x4){0.f, 0.f, 0.f, 0.f};
        const bf16* wp = (const bf16*)(wl + OW_POOL);
        const LAS unsigned char* pb = pt + (15 + t) * 528 + kq * 16;
        bf16x8 wa[2][4], wn[2][4];
#pragma unroll
        for (int ks = 0; ks < 2; ++ks)
#pragma unroll
            for (int db = 0; db < 4; ++db) wa[ks][db] = *(const bf16x8*)(wp + (size_t)(db * 16 + tl) * 64 + ks * 32 + kq * 8);
#pragma unroll
        for (int g = 0; g < 4; ++g) { const int win = 2 << g; const int cnt = (s + 1 < win) ? s + 1 : win; const float rc = 1.0f / (float)cnt;
            if (g < 3) {
#pragma unroll
                for (int ks = 0; ks < 2; ++ks)
#pragma unroll
                    for (int db = 0; db < 4; ++db) wn[ks][db] = *(const bf16x8*)(wp + (size_t)((g + 1) * 64 + db * 16 + tl) * 64 + ks * 32 + kq * 8); }
#pragma unroll
            for (int ks = 0; ks < 2; ++ks) {
                float sum[8], cur[8];
                { const v4u pw = *(const LAS v4u*)(pb + (g * 64 + ks * 32) * 2); const unsigned ww[4] = {pw.x, pw.y, pw.z, pw.w};
#pragma unroll
                  for (int j = 0; j < 4; ++j) { cur[2 * j] = bflo(ww[j]); cur[2 * j + 1] = bfhi(ww[j]); sum[2 * j] = cur[2 * j]; sum[2 * j + 1] = cur[2 * j + 1]; } }
#pragma unroll
                for (int jj = 1; jj < win; ++jj) { const v4u pw = *(const LAS v4u*)(pb - jj * 528 + (g * 64 + ks * 32) * 2); const unsigned ww[4] = {pw.x, pw.y, pw.z, pw.w};
#pragma unroll
                  for (int j = 0; j < 4; ++j) { sum[2 * j] += bflo(ww[j]); sum[2 * j + 1] += bfhi(ww[j]); } }
                float mv[8];
#pragma unroll
                for (int j = 0; j < 8; ++j) mv[j] = sum[j] * rc - cur[j];
                const bf16x8 bfrag = pk8(mv);
#pragma unroll
                for (int db = 0; db < 4; ++db) acc[g][db] = mfma16(wa[ks][db], bfrag, acc[g][db]);
            }
#pragma unroll
            for (int ks = 0; ks < 2; ++ks)
#pragma unroll
                for (int db = 0; db < 4; ++db) wa[ks][db] = wn[ks][db];
            __builtin_amdgcn_sched_barrier(0);
        }
        float ss = 0.f;
#pragma unroll
        for (int g = 0; g < 4; ++g)
#pragma unroll
            for (int db = 0; db < 4; ++db) { const f32x4 y = acc[g][db];
                ss += (y[0] * y[0] + y[1] * y[1]) + (y[2] * y[2] + y[3] * y[3]); }
        const float rC = __builtin_amdgcn_rsqf(quad_sum(ss) * (1.0f / POOL_W) + EPS);
#pragma unroll
        for (int g = 0; g < 4; ++g) {
#pragma unroll
            for (int db = 0; db < 4; ++db) *(LAS u32x2*)(stg + tl * 144 + db * 32 + kq * 8) = pk4(acc[g][db] * rC);
#pragma unroll
            for (int i = 0; i < 2; ++i) *(GAS v4u*)(mixw + (size_t)(8 * i + (lane >> 3)) * (DM * 2) + (768 + g * 64) * 2 + (lane & 7) * 16) = *(const LAS v4u*)(stg + (8 * i + (lane >> 3)) * 144 + (lane & 7) * 16);
        }
    }
    __syncthreads();
}

#ifndef ATT_SPLIT
#define ATT_SPLIT 1
#endif
constexpr int ATT_MAXI = 2;
__device__ const unsigned char att_nsp_tab[32] = {1,1,1,1,1,1,1,1,1,1,1,1,1,1,1,1,1,2,2,2,2,2,2,2,2,2,2,2,2,2,2,2};
__device__ const unsigned char att_tab[32 * ATT_MAXI * 4] = {
    31,0,0,60, 17,0,0,4,
    30,0,0,56, 18,0,0,8,
    29,0,0,52, 19,0,0,12,
    28,0,0,48, 20,0,0,16,
    27,0,0,44, 21,0,0,20,
    26,0,0,40, 22,0,0,24,
    25,0,0,36, 23,0,0,28,
    24,0,0,32, 7,0,0,32,
    16,0,0,68, 255,0,0,0,
    14,0,0,60, 0,0,0,4,
    13,0,0,56, 1,0,0,8,
    12,0,0,52, 2,0,0,12,
    11,0,0,48, 3,0,0,16,
    10,0,0,44, 4,0,0,20,
    9,0,0,40, 5,0,0,24,
    8,0,0,36, 6,0,0,28,
    17,1,4,72, 255,0,0,0,
    18,1,8,76, 255,0,0,0,
    19,1,12,80, 255,0,0,0,
    20,1,16,84, 255,0,0,0,
    21,1,20,88, 255,0,0,0,
    22,1,24,92, 255,0,0,0,
    23,1,28,96, 255,0,0,0,
    24,1,32,100, 255,0,0,0,
    25,1,36,104, 255,0,0,0,
    26,1,40,108, 255,0,0,0,
    27,1,44,112, 255,0,0,0,
    28,1,48,116, 255,0,0,0,
    29,1,52,120, 255,0,0,0,
    30,1,56,124, 255,0,0,0,
    31,1,60,128, 255,0,0,0,
    15,0,0,64, 255,0,0,0,
};
__constant__ const unsigned att_tab32[32 * ATT_MAXI] = {0x3c00001fu, 0x04000011u, 0x3800001eu, 0x08000012u, 0x3400001du, 0x0c000013u, 0x3000001cu, 0x10000014u, 0x2c00001bu, 0x14000015u, 0x2800001au, 0x18000016u, 0x24000019u, 0x1c000017u, 0x20000018u, 0x20000007u, 0x44000010u, 0x000000ffu, 0x3c00000eu, 0x04000000u, 0x3800000du, 0x08000001u, 0x3400000cu, 0x0c000002u, 0x3000000bu, 0x10000003u, 0x2c00000au, 0x14000004u, 0x28000009u, 0x18000005u, 0x24000008u, 0x1c000006u, 0x48040111u, 0x000000ffu, 0x4c080112u, 0x000000ffu, 0x500c0113u, 0x000000ffu, 0x54100114u, 0x000000ffu, 0x58140115u, 0x000000ffu, 0x5c180116u, 0x000000ffu, 0x601c0117u, 0x000000ffu, 0x64200118u, 0x000000ffu, 0x68240119u, 0x000000ffu, 0x6c28011au, 0x000000ffu, 0x702c011bu, 0x000000ffu, 0x7430011cu, 0x000000ffu, 0x7834011du, 0x000000ffu, 0x7c38011eu, 0x000000ffu, 0x803c011fu, 0x000000ffu, 0x4000000fu, 0x000000ffu};
__constant__ const unsigned att_nsp32[32] = {1,1,1,1,1,1,1,1,1,1,1,1,1,1,1,1,1,2,2,2,2,2,2,2,2,2,2,2,2,2,2,2};
__device__ __forceinline__ int att_nsplit(int qb) { return ATT_SPLIT ? (int)att_nsp32[__builtin_amdgcn_readfirstlane(qb)] : 1; }
__device__ __forceinline__ void p4_combine(Frame& F) {
    const int gw = F.vcu * NWAVES + F.wave, NGW = F.G * NWAVES, lane = F.lane, h = lane >> 4, d0 = (lane & 15) * 8;
    const float2* ML = (const float2*)(F.a->ws + WS_ML);
    for (int m0 = gw * 4; m0 < M; m0 += NGW * 4) {
        const int b = m0 >> 13, s0 = m0 & (SEQ - 1), bh = b * NHEAD + h, nsp = att_nsplit(s0 >> 8);
        const size_t row0 = (size_t)bh * SEQ + s0;
        float li[4][4]; v4u ow[4][4];
#pragma unroll
        for (int r = 0; r < 4; ++r)
#pragma unroll
            for (int i = 0; i < 4; ++i) if (i < nsp) { li[r][i] = ML[(size_t)i * 8 * SEQ + row0 + r].y; ow[r][i] = *(const v4u*)(F.a->ws + opart_off(i) + ((row0 + r) * 128 + d0) * 2); }
#pragma unroll
        for (int r = 0; r < 4; ++r) {
            float a[8] = {0.f, 0.f, 0.f, 0.f, 0.f, 0.f, 0.f, 0.f}, wsum = 0.f;
#pragma unroll
            for (int i = 0; i < 4; ++i) if (i < nsp) { const float wgt = li[r][i]; wsum += wgt; const unsigned ww[4] = {ow[r][i].x, ow[r][i].y, ow[r][i].z, ow[r][i].w};
#pragma unroll
                for (int j = 0; j < 4; ++j) { a[2 * j] += wgt * bflo(ww[j]); a[2 * j + 1] += wgt * bfhi(ww[j]); } }
            const float rw = 1.0f / wsum; float ss = 0.f;
#pragma unroll
            for (int j = 0; j < 8; ++j) { a[j] *= rw; ss += a[j] * a[j]; }
            const float rA = __builtin_amdgcn_rsqf(wave_sum_dpp(ss) * (1.0f / 512.0f) + EPS);
#pragma unroll
            for (int j = 0; j < 8; ++j) a[j] *= rA;
            *(bf16x8*)(wsp(F, WS_MIX) + (size_t)(m0 + r) * DM + h * 128 + d0) = pk8(a);
        }
    }
}

struct AttnSchedPaired {
    int bh, idx;
    __device__ __forceinline__ bool get(int i, attn::Item& it) const {
        if (idx >= 16 || i >= 2) return false;
        it.bh = bh; it.qb = (i == 0) ? idx : 31 - idx; it.jlo = 0; it.jhi = 4 * (it.qb + 1); it.chunk = 0; return true;
    }
};
struct AttnSchedSplit {
    int bid, G;
    __device__ __forceinline__ bool get(int i, attn::Item& it) const {
        int cnt = 0;
        for (int slot = bid; slot < 256; slot += G)
#pragma unroll
            for (int j = 0; j < ATT_MAXI; ++j) {
#ifdef PROBE_SPREAD
                const unsigned e = att_tab32[(slot & 31) * ATT_MAXI + j]; const int bh = slot >> 5;
#else
                const unsigned e = att_tab32[(slot >> 3) * ATT_MAXI + j]; const int bh = slot & 7;
#endif
                if ((e & 255u) != 255u) { if (cnt == i) { it.bh = bh; it.qb = (int)(e & 255u); it.chunk = (int)((e >> 8) & 255u); it.jlo = (int)((e >> 16) & 255u); it.jhi = (int)(e >> 24); return true; } ++cnt; } }
        return false;
    }
};

__device__ __forceinline__ XcdBarrier mk_bar(const Frame& F) {
    XcdBarrier b; b.bar = (unsigned*)(F.a->ws + WS_CTL) + CW_BAR; b.x = xb_xcc_id(); b.st = (volatile LAS unsigned*)(F.lds + MISC_OFF) + 8; return b;
}
__device__ __forceinline__ void grid_bar(const Frame& F) { xcd_barrier(mk_bar(F)); }
__device__ __forceinline__ void group_bar(const Frame& F) {
    asm volatile("s_waitcnt vmcnt(0)" ::: "memory");
    __syncthreads();
    if (threadIdx.x == 0) {
        __builtin_amdgcn_s_waitcnt(0);
        unsigned* w = (unsigned*)(F.a->ws + WS_CTL) + CW_GB + 64 * ((int)blockIdx.x & 63);
        volatile LAS unsigned* st = (volatile LAS unsigned*)(F.lds + MISC_OFF) + 8;
        const unsigned same = st[3];
        if (same == 0u) { const unsigned o = __hip_atomic_fetch_or(w + 1, 1u << xb_xcc_id(), __ATOMIC_RELAXED, __HIP_MEMORY_SCOPE_AGENT); asm volatile("" :: "v"(o)); }
        if (same != 1u) { __builtin_amdgcn_fence(__ATOMIC_RELEASE, "agent"); asm volatile("s_waitcnt vmcnt(0)" ::: "memory"); }
        const unsigned old = xb_add(w, 1u), tgt = (old / 4u + 1u) * 4u;
        __builtin_amdgcn_fence(__ATOMIC_ACQUIRE, "agent");
        asm volatile("s_waitcnt vmcnt(0)" ::: "memory");
        XB_SPIN(xb_ld(w) < tgt, (unsigned*)(F.a->ws + WS_CTL) + CW_BAR);
        if (same == 0u) { const unsigned m = xb_ld(w + 1); st[3] = (m & (m - 1u)) == 0u ? 1u : 2u; }
    }
    __syncthreads();
}
#ifndef P2_XLOCAL
#define P2_XLOCAL 1
#endif
__global__ void __launch_bounds__(NWAVES * 64, 2) hybrid_fwd(Args args_) {
    extern __shared__ __attribute__((aligned(16))) unsigned char lds[];
    (void)args_;
    const CAS Args* ap0 = (const CAS Args*)__builtin_amdgcn_kernarg_segment_ptr();
    { const int tid = threadIdx.x;
      for (int u = tid; u < (LDS_BYTES - LDSCTL_OFF) / 4; u += NWAVES * 64) ((LAS unsigned*)((LAS unsigned char*)lds + LDSCTL_OFF))[u] = 0u;
      __syncthreads();
      if (N_LAUNCHES == 1) (void)xcd_barrier_post((unsigned*)(ap0->ws + WS_CTL) + CW_BAR, (volatile LAS unsigned*)((LAS unsigned char*)lds + MISC_OFF) + 8); }
    const int p_lo = ap0->ph_lo;
#ifdef PROBE_TWICE
    int twice_ = 0;
#endif
#ifdef PROBE_Q
    int rep_ = 0;
#endif
#pragma unroll 1
    for (int p = p_lo;; ++p) {
        const CAS Args* ap = ap0; asm volatile("" : "+s"(ap));
        if (p >= ap->ph_hi) break;
        Frame F; F.lds = (LAS unsigned char*)lds; F.a = ap;
        { int tid = threadIdx.x; asm volatile("" : "+v"(tid)); F.lane = tid & 63; F.wave = __builtin_amdgcn_readfirstlane(tid >> 6); }
        F.G = gridDim.x; { const int bx = blockIdx.x; F.vcu = (F.G % 8 == 0) ? (bx % 8) * (F.G / 8) + bx / 8 : bx; }
        const int l = (p - 1) / PH_PER_LAYER, q = (p == 0) ? -1 : (p - 1) % PH_PER_LAYER;
        bool split_done = false;
        unsigned char* wl = F.a->ws + WS_W + (size_t)l * LW;
        if (q == -1) p0_prologue(F);
        else if (q == 0) {
            pg8::Gemm g{wsp(F, WS_XB), (const bf16*)(wl + OW_IN), M, ZLD, DM}; pg8::StaticOrder S; S.init(M, ZLD, F.G, (int)blockIdx.x);
            pg8::EpiScaleBf16 E{wsp(F, WS_Z), ZLD, ssq_mix(F, l), 1.0f / DM, EPS};
            pg8::gemm_phase<pg8::EpiScaleBf16, pg8::StaticOrder, GEMM_ALIGN, GEMM_SP2>(F.lds + RING_OFF, g, S, E);
            if (SPLIT_BAR && N_LAUNCHES == 1 && p + 1 < F.a->ph_hi) { xcd_barrier_arrive(mk_bar(F)); split_done = true; }
            if (CONV_DEFER) {
                const int nwg = (M / 256) * (ZLD / 256), rem = nwg % F.G, c = (int)blockIdx.x;
                const int first = (l > 0 && CONV_TAIL) ? CI_SPLIT : 0, last = CONV_DOWN_LATE ? CI_OUT + 2 * CI_G : CI_SET1;
                if (rem == 0) conv_set(F, l, 1, c * NWAVES + F.wave, F.G * NWAVES, first, last); else if (c >= rem) conv_set(F, l, 1, (c - rem) * NWAVES + F.wave, (F.G - rem) * NWAVES, first, last);
            }
        } else if (q == 1) {
            const int pv = (P2_XLOCAL && F.G == 256) ? (((int)blockIdx.x >> 7) << 7) + 16 * ((int)blockIdx.x & 7) + (((int)blockIdx.x >> 3) & 15) : F.vcu;
#if defined(PROBE_SUB) && PROBE_SUB == 2
            if (rep_ == 0)
#endif
#ifdef PROBE_Q
            for (int u = F.vcu; u < M / CHUNK; u += F.G) p2_upproj_unit(F, l, u, rep_ == 1);
#elif defined(P2_INTERLEAVE)
            for (int v = F.vcu; v < 2 * (M / CHUNK); v += F.G) if (!(v & 1)) p2_upproj_unit(F, l, v >> 1);
#else
            for (int u = pv; u < M / CHUNK; u += F.G) p2_upproj_unit(F, l, u);
#endif
#if defined(PROBE_SUB) && PROBE_SUB == 1
            if (rep_ == 0)
#endif
#ifdef P2_INTERLEAVE
            for (int v = F.vcu; v < 2 * (M / CHUNK); v += F.G) if (v & 1) p2_sgu_pool_unit(F, l, v >> 1);
#else
            for (int u = pv + ((M / CHUNK - pv + F.G - 1) / F.G) * F.G; u < 2 * (M / CHUNK); u += F.G)
#ifdef PROBE_CUT
                p2_sgu_pool_unit(F, l, u - M / CHUNK, rep_ == 1 ? PROBE_CUT : 0);
#else
                p2_sgu_pool_unit(F, l, u - M / CHUNK);
#endif
#endif
        } else if (q == 2) {
            const float cshift = *(const float*)(wl + OW_END);
            const attn::Tensors AT{(const attn::bf16*)wsp(F, WS_Q), (const attn::bf16*)wsp(F, WS_K), (const attn::bf16*)wsp(F, WS_V), (attn::bf16*)(F.a->ws + opart_off(0)), (attn::bf16*)(F.a->ws + opart_off(2)), (float2*)(F.a->ws + WS_ML), cshift
#if defined(PROBE_RACY) || defined(PROBE_HALF)
                , rep_ == 0 ? 1 : 0
#endif
            };
#if ATT_SPLIT
            const AttnSchedSplit S{(int)blockIdx.x, F.G};
            attn::attn_phase<AttnSchedSplit>((char*)lds + RING_OFF, AT, S);
#else
            const AttnSchedPaired S{(int)(blockIdx.x & 7), (int)(blockIdx.x >> 3)};
            attn::attn_phase<AttnSchedPaired>((char*)lds + RING_OFF, AT, S);
#endif
        } else if (q == 3) p4_combine(F);
        else if (q == 5) {
            pg8::Gemm g{wsp(F, WS_XB), (const bf16*)(wl + OW_GU), M, FF2, DM}; pg8::StaticOrder S; S.init(M, FF2, F.G, (int)blockIdx.x);
            pg8::EpiSwiglu E{wsp(F, WS_H), FF, ssq_ffn(F, l), 1.0f / DM, EPS};
#ifdef PROBE_DRYEPI
            if (rep_ == 1) E.H = nullptr;
#endif
#ifdef PROBE_SAMETILE
            if (rep_ == 1) { E.H = nullptr; g.N = 0; }
#endif
#ifdef PROBE_NOMMA
            if (rep_ == 1) { E.H = nullptr; g.M = 0; }
#endif
            pg8::gemm_phase<pg8::EpiSwiglu, pg8::StaticOrder, GEMM_ALIGN, GEMM_SP2>(F.lds + RING_OFF, g, S, E);
            if (CONV_DEFER && CONV_DOWN_LATE) {
                const int nwg = (M / 256) * (FF2 / 256), rem = nwg % F.G, c = (int)blockIdx.x;
                if (rem != 0 && c >= rem) conv_set(F, l, 1, (c - rem) * NWAVES + F.wave, (F.G - rem) * NWAVES, CI_OUT + 2 * CI_G, CI_SET1);
                else if (rem == 0) conv_set(F, l, 1, c * NWAVES + F.wave, F.G * NWAVES, CI_OUT + 2 * CI_G, CI_SET1);
            }
            if (CONV_DEFER && CONV_TAIL && l + 1 < DEPTH) {
                const int nwg = (M / 256) * (FF2 / 256), rem = nwg % F.G, c = (int)blockIdx.x;
                if (rem != 0 && c >= rem) conv_set(F, l + 1, 1, (c - rem) * NWAVES + F.wave, (F.G - rem) * NWAVES, 0, CI_SPLIT);
                else if (rem == 0) conv_set(F, l + 1, 1, c * NWAVES + F.wave, F.G * NWAVES, 0, CI_SPLIT);
            }
        } else {
            const bool dn = q == 6, nx = l + 1 < DEPTH;
            pg8::Gemm g{dn ? wsp(F, WS_H) : wsp(F, WS_MIX), (const bf16*)(wl + (dn ? OW_DN : OW_OUT)), M, DM, dn ? FF : DM}; pg8::StaticOrder S; S.init(M, DM, F.G, (int)blockIdx.x);
            pg8::EpiResid E{wsp(F, WS_XB), (dn && !nx) ? F.a->out : nullptr, (dn && !nx) ? nullptr : wsp(F, WS_XB), dn ? (nx ? ssq_mix(F, l + 1) : nullptr) : ssq_ffn(F, l), DM};
#ifdef PROBE_Q
            if (q == PROBE_Q && rep_ == 0) { E.out = nullptr; E.xb = nullptr; if (E.ssq) E.ssq = (float*)(F.a->ws + 204 * MiB); }
#endif
            pg8::gemm_phase<pg8::EpiResid, pg8::StaticOrder, GEMM_ALIGN, GEMM_SP2>(F.lds + RING_OFF, g, S, E);
        }
        if (split_done) xcd_barrier_wait(mk_bar(F));
        else if (N_LAUNCHES == 1 && p + 1 < F.a->ph_hi) {
            if (GROUP_BAR && F.G == 256 && q >= 4) group_bar(F); else grid_bar(F);
        }
#ifdef PROBE_GBAR
        if (N_LAUNCHES == 1 && p + 1 < F.a->ph_hi && GROUP_BAR && F.G == 256 && q >= 4) { for (int xb_ = 0; xb_ < PROBE_GBAR; ++xb_) group_bar(F); }
#endif
#ifdef PROBE_XBAR
        if (N_LAUNCHES == 1 && p + 1 < F.a->ph_hi) { for (int xb_ = 0; xb_ < PROBE_XBAR; ++xb_) grid_bar(F); }
#endif
#ifdef PROBE_TWICE
        if (p + 1 == F.a->ph_hi && twice_ < PROBE_TWICE) { ++twice_; grid_bar(F); p = -1; }
#endif
#ifdef PROBE_Q
        if (q == PROBE_Q && rep_ == 0) { rep_ = 1; --p; } else rep_ = 0;
#endif
    }
}

extern "C" void kernel_launch(void* const* d_in, const int* in_sizes, int n_in, void* d_out, int out_size, void* d_ws, size_t ws_size, hipStream_t stream) {
    static int grid = 0;
    if (grid == 0) {
        if (n_in != 23 || in_sizes[0] != M * DM || out_size != M * DM || ws_size < WS_END) { fprintf(stderr, "kernel_launch: shape mismatch (n_in %d, in0 %d, out %d, ws %zu)\n", n_in, n_in > 0 ? in_sizes[0] : -1, out_size, ws_size); grid = -1; return; }
        int dev = 0, cus = 0, per_cu = 0;
        if (hipGetDevice(&dev) != hipSuccess || hipDeviceGetAttribute(&cus, hipDeviceAttributeMultiprocessorCount, dev) != hipSuccess) { fprintf(stderr, "kernel_launch: device query failed\n"); grid = -1; return; }
        if (hipFuncSetAttribute((const void*)hybrid_fwd, hipFuncAttributeMaxDynamicSharedMemorySize, LDS_BYTES) != hipSuccess) { fprintf(stderr, "kernel_launch: hipFuncSetAttribute failed\n"); grid = -1; return; }
        if (hipOccupancyMaxActiveBlocksPerMultiprocessor(&per_cu, (const void*)hybrid_fwd, NWAVES * 64, LDS_BYTES) != hipSuccess || per_cu < 1)
            fprintf(stderr, "kernel_launch: note: occupancy query reports %d workgroups per CU\n", per_cu);
        (void)hipGetLastError();
        grid = cus;
        if (grid != 256) fprintf(stderr, "kernel_launch: note: %d CUs (tuned for 256)\n", grid);
    }
    if (grid < 0) return;
    if (hipMemsetAsync((char*)d_ws + WS_CTL, 0, CTL_ZERO_BYTES, stream) != hipSuccess) { fprintf(stderr, "kernel_launch: hipMemsetAsync failed\n"); return; }
#ifdef PROBE_MEMSET2
    for (int i = 0; i < PROBE_MEMSET2; ++i) (void)hipMemsetAsync((char*)d_ws + WS_CTL, 0, CTL_ZERO_BYTES, stream);
#endif
    Args a{};
    for (int i = 0; i < 23; ++i) a.in[i] = (const float*)d_in[i];
    a.out = (float*)d_out; a.ws = (unsigned char*)d_ws;
#ifdef PROBE_PRO
    a.ph_lo = 0; a.ph_hi = 1; a.li = 0;
    hipLaunchKernelGGL(hybrid_fwd, dim3(grid), dim3(NWAVES * 64), LDS_BYTES, stream, a);
    (void)hipMemsetAsync((char*)d_ws + WS_CTL, 0, CTL_ZERO_BYTES, stream);
#endif
    for (int li = 0; li < N_LAUNCHES; ++li) {
        a.ph_lo = (N_LAUNCHES == 1) ? 0 : li; a.ph_hi = (N_LAUNCHES == 1) ? NPH : li + 1; a.li = li;
        hipLaunchKernelGGL(hybrid_fwd, dim3(grid), dim3(NWAVES * 64), LDS_BYTES, stream, a);
        const hipError_t le = hipPeekAtLastError();
        if (le != hipSuccess) { fprintf(stderr, "kernel_launch: launch %d failed: %s\n", li, hipGetErrorName(le)); break; }
    }
}
```

```cpp
#include <hip/hip_runtime.h>
#include <hip/hip_bf16.h>
#include <cstdio>
#include <cstdint>
#ifndef PG8_WGM
#define PG8_WGM 8
#endif

namespace pg8 {
#define PG8_LAS __attribute__((address_space(3)))
typedef unsigned short bf16_t;
typedef short bf16x8 __attribute__((ext_vector_type(8)));
typedef float f32x4 __attribute__((ext_vector_type(4)));
typedef unsigned u32x4 __attribute__((ext_vector_type(4)));
constexpr int BM = 256, BK = 64, HALF = 128, HTB = HALF * BK * 2  , STAGE_BYTES = 8 * HTB, NXCD = 8, WGM = PG8_WGM;

__host__ __device__ __forceinline__ int lds_byte(int r, int c) { const int st = (r >> 4) * 2 + (c >> 5), rr = r & 15, cc = c & 31, ob = rr * 64 + cc * 2; return st * 1024 + (ob ^ (((ob >> 9) & 1) << 5)); }
__host__ __device__ __forceinline__ void stage_rc(int b, int& R, int& C) { const int st = b / 1024, sb = b % 1024, swz = sb ^ (((sb >> 9) & 1) << 5); R = (st >> 1) * 16 + swz / 64; C = (st & 1) * 32 + (swz % 64) / 2; }
__host__ __device__ __forceinline__ int perm32(int rho) { const int n = rho >> 4, i = rho & 15; return 8 * (i >> 2) + 4 * n + (i & 3); }

struct Unit { int pm, pn; };
struct Gemm { const bf16_t* A; const bf16_t* Bt; int M, N, K; };

struct StaticOrder {
    int nM, nN, nwg, G, c;
    __host__ __device__ void init(int M, int N, int G_, int c_) { nM = M / BM; nN = N / BM; nwg = nM * nN; G = G_; c = c_; }
    __host__ __device__ bool next(int i, Unit& u) const {
        const long L = (long)i * G + c; if (L >= nwg) return false;
        int wgid = (int)L; { const int q = nwg / NXCD, r = nwg % NXCD, xcd = wgid % NXCD, off = wgid / NXCD; wgid = (xcd < r ? xcd * (q + 1) : r * (q + 1) + (xcd - r) * q) + off; }
        const int nig = WGM * nN, gid = wgid / nig, fm = gid * WGM, gsz = (nM - fm) < WGM ? (nM - fm) : WGM;
        u.pm = fm + ((wgid % nig) % gsz); u.pn = (wgid % nig) / gsz; return true;
    }
    __device__ __forceinline__ void a_ready(const Unit&) const {}
    __device__ __forceinline__ void done(const Unit&) const {}
};


__device__ __forceinline__ unsigned cvt_pk_bf16(float lo, float hi) { unsigned r; asm volatile("v_cvt_pk_bf16_f32 %0, %1, %2" : "=v"(r) : "v"(lo), "v"(hi)); return r; }
typedef float f32x2 __attribute__((ext_vector_type(2)));

typedef unsigned u32x2 __attribute__((ext_vector_type(2)));
#ifndef EPI_WT
#define EPI_WT 0
#endif
#ifndef RESID_FENCE
#define RESID_FENCE(m) ((m) & 1)
#endif
#ifndef EPI_PRE
#define EPI_PRE true
#endif
__device__ __forceinline__ void st16(void* p, u32x4 v) {
#if EPI_WT
    asm volatile("global_store_dwordx4 %0, %1, off sc1\n\ts_nop 1" :: "v"(p), "v"(v) : "memory");
#else
    *(u32x4*)p = v;
#endif
}
__device__ __forceinline__ void st16f(void* p, f32x4 v) { st16(p, __builtin_bit_cast(u32x4, v)); }
__device__ __forceinline__ void st8(void* p, u32x2 v) {
#if EPI_WT
    asm volatile("global_store_dwordx2 %0, %1, off sc1\n\ts_nop 1" :: "v"(p), "v"(v) : "memory");
#else
    *(u32x2*)p = v;
#endif
}
struct EpiScaleBf16 {
    static constexpr bool PERM = true, AFTER_DRAIN = false, PRE = EPI_PRE;
    bf16_t* O; int ldc; const float* ssq; float inv_n, eps;
    __device__ __forceinline__ void operator()(const f32x4 (&acc)[2][2][4][2], const Unit& u, int wr, int wc, int fr, int fq, const PG8_LAS float* ssl = nullptr) const {
        const int row0 = u.pm * BM + wr * 64 + fr, col0 = u.pn * BM + wc * 32 + 8 * fq;
        float rr[2][4];
#pragma unroll
        for (int ai = 0; ai < 2; ++ai)
#pragma unroll
            for (int m = 0; m < 4; ++m) rr[ai][m] = PRE ? ssl[wr * 64 + fr + ai * HALF + m * 16] : ssq[row0 + ai * HALF + m * 16];
#pragma unroll
        for (int ai = 0; ai < 2; ++ai)
#pragma unroll
            for (int m = 0; m < 4; ++m) { const int row = row0 + ai * HALF + m * 16; const float r = __builtin_amdgcn_rsqf(rr[ai][m] * inv_n + eps); bf16_t* rowp = O + (size_t)row * ldc + col0;
#pragma unroll
                for (int bj = 0; bj < 2; ++bj) { const f32x4 v0 = acc[ai][bj][m][0] * r, v1 = acc[ai][bj][m][1] * r;
                    u32x4 w; w.x = cvt_pk_bf16(v0[0], v0[1]); w.y = cvt_pk_bf16(v0[2], v0[3]); w.z = cvt_pk_bf16(v1[0], v1[1]); w.w = cvt_pk_bf16(v1[2], v1[3]);
                    st16(rowp + bj * HALF, w); } }
    }
};
struct EpiSwiglu {
    static constexpr bool PERM = true, AFTER_DRAIN = false, PRE = EPI_PRE;
    bf16_t* H; int ldh; const float* ssq; float inv_n, eps;
    __device__ __forceinline__ static float swi(float g, float u) { return g * __builtin_amdgcn_rcpf(1.0f + __builtin_amdgcn_exp2f(g * -1.4426950408889634f)) * u; }
    __device__ __forceinline__ void operator()(const f32x4 (&acc)[2][2][4][2], const Unit& u, int wr, int wc, int fr, int fq, const PG8_LAS float* ssl = nullptr) const {
        const int row0 = u.pm * BM + wr * 64 + fr, col0 = u.pn * HALF + wc * 32 + 8 * fq;
#ifdef PROBE_DRYEPI
        if (!H) { asm volatile("" :: "v"(acc[0][0][0][0]), "v"(acc[1][1][3][1])); return; }
#endif
        float rr[2][4];
#pragma unroll
        for (int ai = 0; ai < 2; ++ai)
#pragma unroll
            for (int m = 0; m < 4; ++m) rr[ai][m] = PRE ? ssl[wr * 64 + fr + ai * HALF + m * 16] : ssq[row0 + ai * HALF + m * 16];
#pragma unroll
        for (int ai = 0; ai < 2; ++ai)
#pragma unroll
            for (int m = 0; m < 4; ++m) { const int row = row0 + ai * HALF + m * 16; const float r = __builtin_amdgcn_rsqf(rr[ai][m] * inv_n + eps);
                const f32x4 g0 = acc[ai][0][m][0] * r, g1 = acc[ai][0][m][1] * r, u0 = acc[ai][1][m][0] * r, u1 = acc[ai][1][m][1] * r;
                u32x4 w; w.x = cvt_pk_bf16(swi(g0[0], u0[0]), swi(g0[1], u0[1])); w.y = cvt_pk_bf16(swi(g0[2], u0[2]), swi(g0[3], u0[3]));
                w.z = cvt_pk_bf16(swi(g1[0], u1[0]), swi(g1[1], u1[1])); w.w = cvt_pk_bf16(swi(g1[2], u1[2]), swi(g1[3], u1[3]));
                st16(H + (size_t)row * ldh + col0, w); }
    }
};
struct EpiResid {
    static constexpr bool PERM = true, AFTER_DRAIN = false, PRE = false;
    const bf16_t* base16; float* out; bf16_t* xb; float* ssq; int ldc;
    __device__ __forceinline__ void operator()(const f32x4 (&acc)[2][2][4][2], const Unit& u, int wr, int wc, int fr, int fq) const {
        const int row0 = u.pm * BM + wr * 64 + fr, col0 = u.pn * BM + wc * 32 + 8 * fq;
#pragma unroll
        for (int ai = 0; ai < 2; ++ai) {
            u32x4 bw[4][2];
#pragma unroll
            for (int m = 0; m < 4; ++m)
#pragma unroll
                for (int bj = 0; bj < 2; ++bj) bw[m][bj] = *(const u32x4*)(base16 + (size_t)(row0 + ai * HALF + m * 16) * ldc + col0 + bj * HALF);
            asm volatile("" ::: "memory");
#pragma unroll
            for (int m = 0; m < 4; ++m) { const int row = row0 + ai * HALF + m * 16; const size_t off = (size_t)row * ldc + col0; float s = 0.f;
#pragma unroll
                for (int bj = 0; bj < 2; ++bj) { const u32x4 w4 = bw[m][bj];
                    f32x4 o0 = (f32x4){__builtin_bit_cast(float, w4.x << 16), __builtin_bit_cast(float, w4.x & 0xffff0000u), __builtin_bit_cast(float, w4.y << 16), __builtin_bit_cast(float, w4.y & 0xffff0000u)};
                    f32x4 o1 = (f32x4){__builtin_bit_cast(float, w4.z << 16), __builtin_bit_cast(float, w4.z & 0xffff0000u), __builtin_bit_cast(float, w4.w << 16), __builtin_bit_cast(float, w4.w & 0xffff0000u)};
                    o0 = o0 + acc[ai][bj][m][0]; o1 = o1 + acc[ai][bj][m][1];
                    if (out) { *(f32x4*)(out + off + bj * HALF) = o0; *(f32x4*)(out + off + bj * HALF + 4) = o1; }
                    s += ((o0[0] * o0[0] + o0[1] * o0[1]) + (o0[2] * o0[2] + o0[3] * o0[3])) + ((o1[0] * o1[0] + o1[1] * o1[1]) + (o1[2] * o1[2] + o1[3] * o1[3]));
                    if (xb) { u32x4 w; w.x = cvt_pk_bf16(o0[0], o0[1]); w.y = cvt_pk_bf16(o0[2], o0[3]); w.z = cvt_pk_bf16(o1[0], o1[1]); w.w = cvt_pk_bf16(o1[2], o1[3]); *(u32x4*)(xb + off + bj * HALF) = w; } }
                if (ssq) { s += __shfl_xor(s, 16); s += __shfl_xor(s, 32); if (fq == 0) atomicAdd(ssq + row, s); } }
            asm volatile("" ::: "memory");
        }
    }
};


template <class Epi, class Sched, bool ALIGN_EPI = false, bool SP2 = false>
__device__ __forceinline__ void gemm_phase(PG8_LAS unsigned char* lds, const Gemm g, const Sched& S, const Epi& E) {
    int tid_ = threadIdx.x; asm volatile("" : "+v"(tid_));
    const int tid = tid_, wid = __builtin_amdgcn_readfirstlane(tid >> 6), lane = tid & 63, wr = wid >> 2, wc = wid & 3, fr = lane & 15, fq = lane >> 4;
    const int K = g.K, nt = K / BK;
    unsigned voffA[2], voffB[2];
#pragma unroll
    for (int i = 0; i < 2; ++i) { int R, C; stage_rc(tid * 16 + i * 8192, R, C); const int Rb = Epi::PERM ? ((R & ~31) + perm32(R & 31)) : R;
        voffA[i] = (unsigned)(R * K + C) * 2u; voffB[i] = (unsigned)(Rb * K + C) * 2u; }
    const size_t kstep = (size_t)(BK * 2);
    const size_t hstep = (size_t)HALF * K * 2;
    const size_t tstep = 2 * hstep;
    const unsigned ldsw = (unsigned)wid * 1024u;
    const int aoff = lds_byte(wr * 64 + fr, fq * 8), boff = lds_byte(wc * 32 + fr, fq * 8);
#define PG8_SA(b, h) (((b) * 2 + (h)) * HTB)
#define PG8_SB(b, h) ((4 + (b) * 2 + (h)) * HTB)
#define PG8_STAGE(bufoff, gbase, voff) do { _Pragma("unroll") for (int _i = 0; _i < 2; ++_i) \
        __builtin_amdgcn_global_load_lds((const unsigned*)((const char*)(gbase) + (voff)[_i]), (PG8_LAS unsigned*)(lds + (bufoff) + ldsw + _i * 8192), 16, 0, 0); } while (0)
#define PG8_LDA(dst, b, h) do { _Pragma("unroll") for (int m = 0; m < 4; ++m) _Pragma("unroll") for (int k = 0; k < 2; ++k) dst[m][k] = *(const PG8_LAS bf16x8*)(lds + PG8_SA(b, h) + aoff + m * 2048 + k * 1024); } while (0)
#define PG8_LDB(dst, b, h) do { _Pragma("unroll") for (int n = 0; n < 2; ++n) _Pragma("unroll") for (int k = 0; k < 2; ++k) dst[n][k] = *(const PG8_LAS bf16x8*)(lds + PG8_SB(b, h) + boff + n * 2048 + k * 1024); } while (0)
#ifdef PROBE_NOMMA
#define PG8_MMA_ON (g.M != 0)
#else
#define PG8_MMA_ON true
#endif
#define PG8_MMA(ai, bj, At, Bt) do { if (!PG8_MMA_ON) break; __builtin_amdgcn_s_setprio(1); _Pragma("unroll") for (int m = 0; m < 4; ++m) _Pragma("unroll") for (int n = 0; n < 2; ++n) _Pragma("unroll") for (int k = 0; k < 2; ++k) \
        acc[ai][bj][m][n] = __builtin_amdgcn_mfma_f32_16x16x32_bf16(Bt[n][k], At[m][k], acc[ai][bj][m][n], 0, 0, 0); __builtin_amdgcn_s_setprio(0); } while (0)
#define PG8_WAIT_V(n) asm volatile("s_waitcnt vmcnt(" #n ")" ::: "memory")
#define PG8_WAIT_L(n) asm volatile("s_waitcnt lgkmcnt(" #n ")" ::: "memory")
#define PG8_BAR __builtin_amdgcn_s_barrier()
#define PG8_SCHED __builtin_amdgcn_sched_barrier(0)
    PG8_LAS unsigned char* const ssl_base = lds + STAGE_BYTES;
#define PG8_PRE(u, i) do { if constexpr (Epi::PRE) __builtin_amdgcn_global_load_lds((const unsigned*)(E.ssq + (size_t)(u).pm * BM + (wid & 3) * 64 + lane), \
        (PG8_LAS unsigned*)(ssl_base + ((i) & 1) * 2048 + wid * 256), 4, 0, 0); } while (0)
    Unit cur, nxt; int ui = 0;
    if (!S.next(0, cur)) return;
    f32x4 acc[2][2][4][2];
#pragma unroll
    for (int a = 0; a < 2; ++a)
#pragma unroll
        for (int b = 0; b < 2; ++b)
#pragma unroll
            for (int m = 0; m < 4; ++m)
#pragma unroll
                for (int n = 0; n < 2; ++n) acc[a][b][m][n] = (f32x4){0.f, 0.f, 0.f, 0.f};
    bf16x8 At[4][2], B0[2][2], B1[2][2];
#ifdef PROBE_SAMETILE
    const size_t tsA = (g.N == 0) ? 0 : tstep, tsB = (g.N == 0) ? (PROBE_SAMETILE == 2 ? tstep : 0) : tstep;
#else
    const size_t tsA = tstep, tsB = tstep;
#endif
    const char* cA = (const char*)g.A + (size_t)cur.pm * tsA; const char* cB = (const char*)g.Bt + (size_t)cur.pn * tsB;
    S.a_ready(cur);
    PG8_PRE(cur, 0);
    if constexpr (SP2) {
        PG8_STAGE(PG8_SB(0, 0), cB, voffB); PG8_STAGE(PG8_SB(0, 1), cB + hstep, voffB); PG8_STAGE(PG8_SA(0, 0), cA, voffA); PG8_STAGE(PG8_SA(0, 1), cA + hstep, voffA);
        if (wr == 1) PG8_BAR;
        PG8_WAIT_V(2); PG8_BAR;
        PG8_STAGE(PG8_SB(1, 0), cB + kstep, voffB); PG8_STAGE(PG8_SA(1, 0), cA + kstep, voffA); PG8_STAGE(PG8_SB(1, 1), cB + hstep + kstep, voffB);
        PG8_WAIT_V(6); PG8_BAR;
    } else {
        PG8_STAGE(PG8_SB(0, 0), cB, voffB); PG8_STAGE(PG8_SA(0, 0), cA, voffA); PG8_STAGE(PG8_SB(0, 1), cB + hstep, voffB); PG8_STAGE(PG8_SA(0, 1), cA + hstep, voffA);
        if (wr == 1) PG8_BAR;
        PG8_WAIT_V(4); PG8_BAR;
        PG8_STAGE(PG8_SB(1, 0), cB + kstep, voffB); PG8_STAGE(PG8_SA(1, 0), cA + kstep, voffA); PG8_STAGE(PG8_SB(1, 1), cB + hstep + kstep, voffB);
        PG8_WAIT_V(6); PG8_BAR;
    }
    for (;;) {
        const bool has_next = S.next(ui + 1, nxt);
        const char* nA = has_next ? (const char*)g.A + (size_t)nxt.pm * tsA : cA; const char* nB = has_next ? (const char*)g.Bt + (size_t)nxt.pn * tsB : cB;
        for (int t = 0; t < nt; t += 2) {
            const bool last = (t == nt - 2);
            const char* a1 = cA + (size_t)(t + 1) * kstep;
            const char* a2 = last ? nA : cA + (size_t)(t + 2) * kstep; const char* b2 = last ? nB : cB + (size_t)(t + 2) * kstep;
            const char* a3 = a2 + kstep; const char* b3 = b2 + kstep;
            if (last && has_next) S.a_ready(nxt);
            if constexpr (SP2) {
            PG8_LDB(B0, 0, 0); PG8_LDB(B1, 0, 1); PG8_SCHED; PG8_LDA(At, 0, 0); PG8_STAGE(PG8_SA(1, 1), a1 + hstep, voffA);
            PG8_WAIT_V(8); PG8_WAIT_L(0); PG8_BAR; PG8_MMA(0, 0, At, B0); PG8_MMA(0, 1, At, B1); PG8_BAR; PG8_SCHED;
            PG8_LDA(At, 0, 1); PG8_STAGE(PG8_SB(0, 0), b2, voffB); PG8_STAGE(PG8_SB(0, 1), b2 + hstep, voffB); PG8_STAGE(PG8_SA(0, 0), a2, voffA);
            PG8_WAIT_V(8); PG8_WAIT_L(0); PG8_BAR; PG8_MMA(1, 0, At, B0); PG8_MMA(1, 1, At, B1); PG8_BAR; PG8_SCHED;
            PG8_LDB(B0, 1, 0); PG8_LDB(B1, 1, 1); PG8_SCHED; PG8_LDA(At, 1, 0); PG8_STAGE(PG8_SA(0, 1), a2 + hstep, voffA);
            PG8_WAIT_V(8); PG8_WAIT_L(0); PG8_BAR; PG8_MMA(0, 0, At, B0); PG8_MMA(0, 1, At, B1); PG8_BAR; PG8_SCHED;
            PG8_LDA(At, 1, 1); PG8_STAGE(PG8_SB(1, 0), b3, voffB); PG8_STAGE(PG8_SB(1, 1), b3 + hstep, voffB); PG8_STAGE(PG8_SA(1, 0), a3, voffA);
            PG8_WAIT_V(8); PG8_WAIT_L(0); PG8_BAR; PG8_MMA(1, 0, At, B0); PG8_MMA(1, 1, At, B1); PG8_BAR; PG8_SCHED;
            } else {
            PG8_LDB(B0, 0, 0); PG8_SCHED; PG8_LDA(At, 0, 0); PG8_STAGE(PG8_SA(1, 1), a1 + hstep, voffA);
            PG8_WAIT_L(8); PG8_BAR; PG8_WAIT_L(0); PG8_MMA(0, 0, At, B0); PG8_BAR; PG8_SCHED;
            PG8_LDB(B1, 0, 1); PG8_STAGE(PG8_SB(0, 0), b2, voffB);
            PG8_BAR; PG8_WAIT_L(0); PG8_MMA(0, 1, At, B1); PG8_BAR;
            PG8_LDA(At, 0, 1); PG8_STAGE(PG8_SA(0, 0), a2, voffA);
            PG8_BAR; PG8_WAIT_L(0); PG8_MMA(1, 0, At, B0); PG8_BAR; PG8_SCHED;
            PG8_STAGE(PG8_SB(0, 1), b2 + hstep, voffB);
            PG8_WAIT_V(6); PG8_BAR; PG8_MMA(1, 1, At, B1); PG8_BAR;
            PG8_LDB(B0, 1, 0); PG8_SCHED; PG8_LDA(At, 1, 0); PG8_STAGE(PG8_SA(0, 1), a2 + hstep, voffA);
            PG8_WAIT_L(8); PG8_BAR; PG8_WAIT_L(0); PG8_MMA(0, 0, At, B0); PG8_BAR; PG8_SCHED;
            PG8_LDB(B1, 1, 1); PG8_STAGE(PG8_SB(1, 0), b3, voffB);
            PG8_BAR; PG8_WAIT_L(0); PG8_MMA(0, 1, At, B1); PG8_BAR;
            PG8_LDA(At, 1, 1); PG8_STAGE(PG8_SA(1, 0), a3, voffA);
            PG8_BAR; PG8_WAIT_L(0); PG8_MMA(1, 0, At, B0); PG8_BAR; PG8_SCHED;
            PG8_STAGE(PG8_SB(1, 1), b3 + hstep, voffB);
            PG8_WAIT_V(6); PG8_BAR; PG8_MMA(1, 1, At, B1); PG8_BAR;
            }
        }
        if constexpr (ALIGN_EPI) { if (wr == 0) PG8_BAR; }
        if constexpr (Epi::PRE) { E(acc, cur, wr, wc, fr, fq, (const PG8_LAS float*)(ssl_base + (ui & 1) * 2048)); S.done(cur); }
        else if constexpr (!Epi::AFTER_DRAIN) { E(acc, cur, wr, wc, fr, fq); S.done(cur); }
        if (!has_next) break;
#pragma unroll
        for (int a = 0; a < 2; ++a)
#pragma unroll
            for (int b = 0; b < 2; ++b)
#pragma unroll
                for (int m = 0; m < 4; ++m)
#pragma unroll
                    for (int n = 0; n < 2; ++n) acc[a][b][m][n] = (f32x4){0.f, 0.f, 0.f, 0.f};
        cur = nxt; cA = nA; cB = nB; ++ui;
        PG8_PRE(cur, ui);
        if constexpr (ALIGN_EPI) { if (wr == 1) PG8_BAR; }
    }
    PG8_WAIT_V(0);
    if constexpr (!ALIGN_EPI) { if (wr == 0) PG8_BAR; }
    PG8_BAR;
    if constexpr (Epi::AFTER_DRAIN) { E.fused(acc, cur, wr, wc, fr, fq, lds, wid, lane); S.done(cur); }
#undef PG8_SA
#undef PG8_SB
#undef PG8_STAGE
#undef PG8_LDA
#undef PG8_LDB
#undef PG8_MMA
#undef PG8_WAIT_V
#undef PG8_WAIT_L
#undef PG8_BAR
#undef PG8_SCHED
#undef PG8_PRE
}
}

namespace attn {
constexpr int D = 128, NQD = 6;
constexpr float THR = 8.f;
#ifndef ATT_WSKIP
#define ATT_WSKIP false
#endif
constexpr bool WSKIP = ATT_WSKIP;
constexpr float SCALE = 0.10206207261596575f;
constexpr int NW = 8, QBLK = 32, KVBLK = 64, QB = NW * QBLK;
constexpr int SHM_V = KVBLK * D * 2, SHM_K = KVBLK * D * 2;
constexpr int LDS_BYTES = 2 * SHM_V + 2 * SHM_K + NW * 64 * 4;

using bf16 = __hip_bfloat16;
typedef short bf16x8 __attribute__((ext_vector_type(8)));
typedef short s16x4 __attribute__((ext_vector_type(4)));
typedef float f32x16 __attribute__((ext_vector_type(16)));
typedef float f32x4 __attribute__((ext_vector_type(4)));
typedef unsigned u32x4 __attribute__((ext_vector_type(4)));
template <class A, class Bt> struct same_t { static constexpr bool v = false; };
template <class A> struct same_t<A, A> { static constexpr bool v = true; };

#define KSWZ(row, colB) ((row) * 256 + ((colB) ^ (((row) & 7) << 4)))
#define SBAR() __builtin_amdgcn_sched_barrier(0)
__device__ __forceinline__ int v_st(int k, int c) { const int kk = (k & ~0xC) | ((k & 4) << 1) | ((k & 8) >> 1); return ((kk >> 3) * 4 + (c >> 5)) * 512 + ((kk & 7) * 32 + (c & 31)) * 2; }
__device__ __forceinline__ int v_rd_base(int lane) { return ((lane & 3) << 3) | (((lane >> 2) & 3) << 6) | (((lane >> 4) & 1) << 5) | (((lane >> 5) & 1) << 8); }
constexpr int v_rd_off(int d0, int ks, int half) { return d0 * 512 + ks * 4096 + half * 2048; }
__device__ __forceinline__ int crow(int r, int hi) { return (r & 3) + 8 * (r >> 2) + 4 * hi; }
__device__ __forceinline__ unsigned cvtpk(float lo, float hi) {
    unsigned r; asm volatile("v_cvt_pk_bf16_f32 %0, %1, %2" : "=v"(r) : "v"(lo), "v"(hi)); return r;
}
__device__ __forceinline__ bf16x8 pack8(f32x4 a, f32x4 b) {
    u32x4 w = {cvtpk(a[0], a[1]), cvtpk(a[2], a[3]), cvtpk(b[0], b[1]), cvtpk(b[2], b[3])};
    return *reinterpret_cast<bf16x8*>(&w);
}
template <class T> __device__ __forceinline__ bf16x8 load8(const T* p) {
    if constexpr (same_t<T, float>::v) { return pack8(*(const f32x4*)p, *(const f32x4*)(p + 4)); }
    else { return *reinterpret_cast<const bf16x8*>(p); }
}
__device__ __forceinline__ void mask_tile(f32x16& p0, f32x16& p1, int dq, unsigned W) {
    const float NEG = -__builtin_inff();
#pragma unroll
    for (int r = 0; r < 16; ++r) {
        const int c = (r & 3) + 8 * (r >> 2);
        if ((unsigned)(dq - c) >= W) p0[r] = NEG;
        if ((unsigned)(dq - c - 32) >= W) p1[r] = NEG;
    }
}
__device__ __forceinline__ void partialSM(f32x16& p0, f32x16& p1, float& m_reg, float& mn, float& alpha, float cshift) {
    (void)m_reg; mn = 0.f; alpha = 1.f;
    if (__builtin_expect(cshift != 0.f, 0)) { for (int r = 0; r < 16; ++r) { p0[r] -= cshift; p1[r] -= cshift; } }
    for (int r = 0; r < 16; ++r) p0[r] = __builtin_amdgcn_exp2f(p0[r]);
}
__device__ __forceinline__ void finishSM(f32x16& p0, f32x16& p1, float alpha, float& l_reg, bf16x8& pa0, bf16x8& pa1, bf16x8& pa2, bf16x8& pa3) {
    for (int r = 0; r < 16; ++r) p1[r] = __builtin_amdgcn_exp2f(p1[r]);
    float ps = 0; for (int r = 0; r < 16; ++r) ps += p0[r]; for (int r = 0; r < 16; ++r) ps += p1[r];
    { auto rr = __builtin_amdgcn_permlane32_swap(__float_as_uint(ps), __float_as_uint(ps), false, false);
      ps = __uint_as_float(rr[0]) + __uint_as_float(rr[1]); }
    l_reg += ps; (void)alpha;
#define PK4(P, B_, OUT) do { unsigned a0 = cvtpk(P[B_+0], P[B_+1]), a1 = cvtpk(P[B_+2], P[B_+3]);                          \
        unsigned b0 = cvtpk(P[B_+4], P[B_+5]), b1 = cvtpk(P[B_+6], P[B_+7]);                                             \
        auto r0 = __builtin_amdgcn_permlane32_swap(a0, b0, false, false); auto r1 = __builtin_amdgcn_permlane32_swap(a1, b1, false, false); \
        u32x4 w = {r0[0], r1[0], r0[1], r1[1]}; OUT = *reinterpret_cast<bf16x8*>(&w); } while (0)
    PK4(p0, 0, pa0); PK4(p0, 8, pa1); PK4(p1, 0, pa2); PK4(p1, 8, pa3);
#undef PK4
}
template <int KB, bool SK>
__device__ __forceinline__ void qkt(f32x16& p0, f32x16& p1, const char* K_lds, int r32, int hi, const bf16x8* qr, bool act) {
    if (SK && !act) { const float NEG = -__builtin_inff();
#pragma unroll
        for (int r = 0; r < 16; ++r) { p0[r] = NEG; p1[r] = NEG; } return; }
    p0 = f32x16{}; p1 = f32x16{};
    const char* kb[4];
#pragma unroll
    for (int dd = 0; dd < 4; ++dd) kb[dd] = K_lds + KB * SHM_K + KSWZ(r32, (dd * 16 + hi * 8) * 2);
#pragma unroll
    for (int d0 = 0; d0 < NQD; ++d0) { const char* a = kb[d0 & 3] + (d0 >> 2) * 128;
        bf16x8 b0 = *reinterpret_cast<const bf16x8*>(a);
        bf16x8 b1 = *reinterpret_cast<const bf16x8*>(a + 32 * 256);
        p0 = __builtin_amdgcn_mfma_f32_32x32x16_bf16(b0, qr[d0], p0, 0, 0, 0);
        p1 = __builtin_amdgcn_mfma_f32_32x32x16_bf16(b1, qr[d0], p1, 0, 0, 0); }
}
template <int VB, bool SK>
__device__ __forceinline__ void pv_tile(f32x16* o, int vb0, bf16x8 pa0, bf16x8 pa1, bf16x8 pa2, bf16x8 pa3, bool act) {
    if (SK && !act) return;
#define TRRD(dst, off) asm volatile("ds_read_b64_tr_b16 %0, %1 offset:%2" : "=&v"(dst) : "v"(vb0), "i"(off) : "memory")
#define PV_D0(d0) do { s16x4 l0, l1, l2, l3, h0, h1, h2, h3; constexpr int b_ = VB * SHM_V + v_rd_off(d0, 0, 0);     \
        TRRD(l0, b_); TRRD(h0, b_ + 2048); TRRD(l1, b_ + 4096); TRRD(h1, b_ + 6144); TRRD(l2, b_ + 8192); TRRD(h2, b_ + 10240); TRRD(l3, b_ + 12288); TRRD(h3, b_ + 14336); \
        asm volatile("s_waitcnt lgkmcnt(0)" ::: "memory"); SBAR();                 \
        o[d0] = __builtin_amdgcn_mfma_f32_32x32x16_bf16(pa0, (bf16x8){l0[0], l0[1], l0[2], l0[3], h0[0], h0[1], h0[2], h0[3]}, o[d0], 0, 0, 0);   \
        o[d0] = __builtin_amdgcn_mfma_f32_32x32x16_bf16(pa1, (bf16x8){l1[0], l1[1], l1[2], l1[3], h1[0], h1[1], h1[2], h1[3]}, o[d0], 0, 0, 0);   \
        o[d0] = __builtin_amdgcn_mfma_f32_32x32x16_bf16(pa2, (bf16x8){l2[0], l2[1], l2[2], l2[3], h2[0], h2[1], h2[2], h2[3]}, o[d0], 0, 0, 0);   \
        o[d0] = __builtin_amdgcn_mfma_f32_32x32x16_bf16(pa3, (bf16x8){l3[0], l3[1], l3[2], l3[3], h3[0], h3[1], h3[2], h3[3]}, o[d0], 0, 0, 0); } while (0)
    PV_D0(0); PV_D0(1); PV_D0(2); PV_D0(3);
#undef PV_D0
#undef TRRD
}

template <class TIn, class TOut> struct BlockRef { const TIn* Q; const TIn* K; const TIn* V; TOut* O; float2* ML; int P0; int jlo; int jhi; float cshift; };
template <class TIn> struct Seam {
    bf16x8 qr[NQD];
    bf16x8 st_v0, st_v1, st_k0, st_k1; f32x4 sf0, sf1, sf2, sf3;
    f32x4 tq[1];
};
__device__ __forceinline__ int swa_jlo(int P0, int W) { const int lowk = P0 - W + 1; return lowk > 0 ? lowk / KVBLK : 0; }
#define ROW(p, k0, rr) ((p) + (size_t)((k0) + (rr)) * D + sc)
#define VMW() asm volatile("s_waitcnt vmcnt(0)" ::: "memory")
#define VMWN(n) asm volatile("s_waitcnt vmcnt(%0)" :: "i"(n) : "memory")
#define SLOAD_H(Kp, Vp, k0) do { S.st_v0 = load8<TIn>(ROW(Vp, k0, sr)); S.st_v1 = load8<TIn>(ROW(Vp, k0, 32 + sr));              \
                         S.st_k0 = load8<TIn>(ROW(Kp, k0, sr)); S.st_k1 = load8<TIn>(ROW(Kp, k0, 32 + sr)); } while (0)
#define SWRITE_HK(bf) do { *(bf16x8*)(K_lds + (bf) * SHM_K + kws) = S.st_k0; *(bf16x8*)(K_lds + (bf) * SHM_K + kws + 32 * 256) = S.st_k1; } while (0)
#define SWRITE_HV(bf) do { *(bf16x8*)(V_lds + (bf) * SHM_V + vst0) = S.st_v0; *(bf16x8*)(V_lds + (bf) * SHM_V + vst1) = S.st_v1; } while (0)
#define SWRITE_H(bf) do { SWRITE_HV(bf); SWRITE_HK(bf); } while (0)
#define SLOAD_F(p, k0) do { S.sf0 = *(const f32x4*)ROW(p, k0, sr); S.sf1 = *(const f32x4*)(ROW(p, k0, sr) + 4);                \
                            S.sf2 = *(const f32x4*)ROW(p, k0, 32 + sr); S.sf3 = *(const f32x4*)(ROW(p, k0, 32 + sr) + 4); } while (0)
#define SWRITE_KF(bf) do { *(bf16x8*)(K_lds + (bf) * SHM_K + kws) = pack8(S.sf0, S.sf1); *(bf16x8*)(K_lds + (bf) * SHM_K + kws + 32 * 256) = pack8(S.sf2, S.sf3); } while (0)
#define SWRITE_VF(bf) do { *(bf16x8*)(V_lds + (bf) * SHM_V + vst0) = pack8(S.sf0, S.sf1); *(bf16x8*)(V_lds + (bf) * SHM_V + vst1) = pack8(S.sf2, S.sf3); } while (0)
template <class TIn, class TOut>
__device__ __forceinline__ void causal_swa_prime(const BlockRef<TIn, TOut>& cur, int W, char* lds, Seam<TIn>& S) {
    constexpr bool F32 = same_t<TIn, float>::v;
    int tid_ = threadIdx.x; asm volatile("" : "+v"(tid_));
    const int tid = tid_, wid = __builtin_amdgcn_readfirstlane(tid >> 6), lane = tid & 63, r32 = lane & 31, hi = lane >> 5;
    const int sr = tid >> 4, sc = (tid & 15) * 8, kws = KSWZ(sr, sc * 2); char* K_lds = lds + 2 * SHM_V;
    const int kb0 = cur.jlo * KVBLK;
    for (int d0 = 0; d0 < NQD; ++d0) S.qr[d0] = load8<TIn>(cur.Q + (size_t)(wid * QBLK + r32) * D + d0 * 16 + hi * 8);
    if constexpr (F32) { SLOAD_F((const float*)cur.K, kb0); VMW(); SWRITE_KF(0); SBAR(); SLOAD_F((const float*)cur.V, kb0); }
    else { SLOAD_H(cur.K, cur.V, kb0); VMW(); SWRITE_HK(0); }
    __syncthreads();
}
template <class TIn, class TOut>
__device__ __forceinline__ void causal_swa_block(const BlockRef<TIn, TOut>& cur, const BlockRef<TIn, TOut>& nxt, int skv, int W, char* lds, Seam<TIn>& S) {
    constexpr bool F32 = same_t<TIn, float>::v;
    int tid_ = threadIdx.x; asm volatile("" : "+v"(tid_));
    const int tid = tid_, wid = __builtin_amdgcn_readfirstlane(tid >> 6), lane = tid & 63, r32 = lane & 31, hi = lane >> 5;
    const int j_lo = cur.jlo; const int j_hi = cur.jhi; (void)skv;
    const int NT = j_hi - j_lo;
    const int kbn = nxt.jlo * KVBLK;
    const int qlo = cur.P0 + wid * QBLK, qm = qlo + r32 - 4 * hi;
    char* V_lds = lds; char* K_lds = lds + 2 * SHM_V;
    float* ws = (float*)(lds + 2 * SHM_V + 2 * SHM_K) + wid * 64; float* li_l = ws, * al_l = ws + 32;
    float m_reg = -1e30f, l_reg = 0; f32x16 o[4] = {};
    const int sr = tid >> 4, sc = (tid & 15) * 8, vst0 = v_st(sr, sc), vst1 = v_st(32 + sr, sc), kws = KSWZ(sr, sc * 2);
    const int vb0 = (int)(uintptr_t)V_lds + v_rd_base(lane);
    const TIn* Kh = cur.K; const TIn* Vh = cur.V;
#define RESC(a) do { (void)(a); (void)al_l; } while (0)
#define KBASE(t) ((j_lo + (t)) * KVBLK)
#define ACT(t) (KBASE(t) <= qlo + QBLK - 1 && KBASE(t) + KVBLK - 1 >= qlo - W + 1)
#define MASKT(P0_, P1_, t) do { const int kb_ = KBASE(t); if ((!SK || ACT(t)) && (kb_ + KVBLK - 1 > qlo || kb_ <= qlo + QBLK - 1 - W)) mask_tile(P0_, P1_, qm - kb_, (unsigned)W); } while (0)
    constexpr int NQL = F32 ? 16 : NQD;
    constexpr bool SK = WSKIP && !F32;
#define SEAM_K0() do { VMWN(NQL); if constexpr (F32) { SWRITE_KF(0); SBAR(); SLOAD_F((const float*)nxt.V, kbn); } else { SWRITE_HK(0); } SBAR(); } while (0)
    f32x16 pA0, pA1, pB0, pB1; float mnA, mnB, alA, alB; bf16x8 pa0, pa1, pa2, pa3;
    if constexpr (F32) { VMW(); SWRITE_VF(0); SBAR(); } else { SWRITE_HV(0); SBAR(); }
    if (NT > 1) { if constexpr (F32) SLOAD_F((const float*)Kh, KBASE(1)); else SLOAD_H(Kh, Vh, KBASE(1)); }
    SBAR(); qkt<0, SK>(pA0, pA1, K_lds, r32, hi, S.qr, ACT(0));
    if constexpr (F32) { if (NT > 1) { VMW(); SWRITE_KF(1); SBAR(); SLOAD_F((const float*)Vh, KBASE(1)); } }
    MASKT(pA0, pA1, 0); partialSM(pA0, pA1, m_reg, mnA, alA, cur.cshift);
    if (NT > 1) { VMW(); if constexpr (F32) { SWRITE_VF(1); SBAR(); if (NT > 2) SLOAD_F((const float*)Kh, KBASE(2)); } else SWRITE_H(1); }
    __syncthreads();
#define HALF_STEP(PX0, PX1, mnX, alX, PY0, PY1, alY, t, KB, VB, SB) do {                                                      \
        SBAR(); qkt<KB, SK>(PX0, PX1, K_lds, r32, hi, S.qr, ACT(t));                                             \
        finishSM(PY0, PY1, alY, l_reg, pa0, pa1, pa2, pa3); SBAR();                                                           \
        if ((t) + 1 < NT) { if constexpr (F32) { VMW(); SWRITE_KF(SB); SBAR(); SLOAD_F((const float*)Vh, KBASE((t) + 1)); }  \
                            else { SLOAD_H(Kh, Vh, KBASE((t) + 1)); } SBAR(); }                                               \
        pv_tile<VB, SK>(o, vb0, pa0, pa1, pa2, pa3, ACT((t) - 1)); MASKT(PX0, PX1, (t)); partialSM(PX0, PX1, m_reg, mnX, alX, cur.cshift);                                        \
        __syncthreads();                                                                                                      \
        if ((t) + 1 < NT) { VMW(); if constexpr (F32) { SWRITE_VF(SB); SBAR(); if ((t) + 2 < NT) SLOAD_F((const float*)Kh, KBASE((t) + 2)); } \
                            else { SWRITE_H(SB); } }                                                                          \
        RESC(alX); __syncthreads(); } while (0)
    for (int t = 1; t + 1 < NT; t += 2) {
        HALF_STEP(pB0, pB1, mnB, alB, pA0, pA1, alA, t, 1, 0, 0);
        HALF_STEP(pA0, pA1, mnA, alA, pB0, pB1, alB, t + 1, 0, 1, 1);
    }
    const bool even = (NT & 1) == 0;
    if (even) { SBAR(); qkt<1, SK>(pB0, pB1, K_lds, r32, hi, S.qr, ACT(NT - 1)); SBAR(); }
#define QROW(e) (nxt.Q + (size_t)(wid * QBLK + r32) * D + ((e) >> 1) * 16 + hi * 8 + ((e) & 1) * 4)
    if constexpr (F32) { SLOAD_F((const float*)nxt.K, kbn); SBAR();
#pragma unroll
        for (int e = 0; e < 8; ++e) S.tq[e] = *(const f32x4*)QROW(e); }
    else { SLOAD_H(nxt.K, nxt.V, kbn); SBAR();
#pragma unroll
        for (int d0 = 0; d0 < NQD; ++d0) S.qr[d0] = load8<TIn>(nxt.Q + (size_t)(wid * QBLK + r32) * D + d0 * 16 + hi * 8); }
    SBAR();
    finishSM(pA0, pA1, alA, l_reg, pa0, pa1, pa2, pa3); SBAR();
    if constexpr (F32) {
#pragma unroll
        for (int e = 8; e < 16; ++e) S.tq[e] = *(const f32x4*)QROW(e); SBAR(); }
#undef QROW
    pv_tile<0, SK>(o, vb0, pa0, pa1, pa2, pa3, ACT(even ? NT - 2 : NT - 1));
    if (even) { MASKT(pB0, pB1, NT - 1); partialSM(pB0, pB1, m_reg, mnB, alB, cur.cshift); __syncthreads(); RESC(alB);
        finishSM(pB0, pB1, alB, l_reg, pa0, pa1, pa2, pa3); SBAR(); pv_tile<1, SK>(o, vb0, pa0, pa1, pa2, pa3, ACT(NT - 1)); }
    SBAR(); SEAM_K0();
    if (hi == 0) { li_l[r32] = l_reg; cur.ML[wid * QBLK + r32] = make_float2(0.f, l_reg); } asm volatile("s_waitcnt lgkmcnt(0)" ::: "memory");
    float rli[16];
#pragma unroll
    for (int r = 0; r < 16; ++r) rli[r] = __builtin_amdgcn_rcpf(li_l[crow(r, hi)]);
    TOut* Ow = cur.O + (size_t)(wid * QBLK) * D;
#pragma unroll
    for (int r = 0; r < 16; ++r) { const int orow = crow(r, hi);
#pragma unroll
        for (int d0 = 0; d0 < 4; ++d0) { const float v = o[d0][r] * rli[r];
            if constexpr (same_t<TOut, float>::v) { Ow[(size_t)orow * D + d0 * 32 + r32] = v; }
            else { *(unsigned short*)(lds + LDS_BYTES + wid * 8704 + orow * 272 + (d0 * 32 + r32) * 2) = (unsigned short)(cvtpk(v, v) & 0xffffu); } } }
    if constexpr (!same_t<TOut, float>::v) {
#pragma unroll
        for (int i = 0; i < 8; ++i) { const int row = 4 * i + (lane >> 4), c16 = lane & 15;
            *(u32x4*)((char*)Ow + (size_t)row * (D * 2) + c16 * 16) = *(const u32x4*)(lds + LDS_BYTES + wid * 8704 + row * 272 + c16 * 16); } }
    if constexpr (F32) {
#pragma unroll
        for (int d0 = 0; d0 < NQD; ++d0) S.qr[d0] = pack8(S.tq[2 * d0], S.tq[2 * d0 + 1]); }
    if constexpr (!F32) {
#pragma unroll
        for (int d0 = 0; d0 < NQD; ++d0) asm volatile("" : "+v"(S.qr[d0]));
        asm volatile("" : "+v"(S.st_v0), "+v"(S.st_v1)); }
    __syncthreads();
#undef RESC
#undef KBASE
#undef ACT
#undef MASKT
#undef SEAM_K0
#undef HALF_STEP
}
#undef ROW
#undef VMW
#undef VMWN
#undef SLOAD_H
#undef SWRITE_HK
#undef SWRITE_HV
#undef SWRITE_H
#undef SLOAD_F
#undef SWRITE_KF
#undef SWRITE_VF

struct Item { int bh, qb, jlo, jhi, chunk; };
#ifdef PROBE_RACY
#endif
struct Tensors { const bf16* Q; const bf16* K; const bf16* V; bf16* O01; bf16* O23; float2* ML; float cshift;
#if defined(PROBE_RACY) || defined(PROBE_HALF)
    int racy;
#endif
};
constexpr int SEQ = 8192, NBH = 8;
__device__ __forceinline__ BlockRef<bf16, bf16> mkref(const Tensors& T, const Item& it) {
    BlockRef<bf16, bf16> r; const size_t row0 = (size_t)it.bh * SEQ + (size_t)it.qb * QB;
    r.Q = T.Q + row0 * D; r.K = T.K + (size_t)it.bh * SEQ * D; r.V = T.V + (size_t)it.bh * SEQ * D;
    r.O = (it.chunk < 2 ? T.O01 + (size_t)it.chunk * NBH * SEQ * D : T.O23 + (size_t)(it.chunk - 2) * NBH * SEQ * D) + row0 * D; r.ML = T.ML + (size_t)it.chunk * NBH * SEQ + row0; r.P0 = it.qb * QB; r.jlo = it.jlo; r.jhi = it.jhi; r.cshift = T.cshift;
#ifdef PROBE_RACY
    r.racy = T.racy;
#endif
#ifdef PROBE_HALF
#ifdef PROBE_ONE
    if (T.racy) r.jhi = r.jlo + PROBE_ONE;
#else
    if (T.racy) r.jhi = r.jlo + (r.jhi - r.jlo + 1) / 2;
#endif
#endif
    return r;
}
template <class Sched> __device__ __forceinline__ void attn_phase(char* lds, const Tensors& T, const Sched& S) {
    Item it, itn; if (!S.get(0, it)) return;
    BlockRef<bf16, bf16> cur = mkref(T, it);
    Seam<bf16> Sm;
    causal_swa_prime<bf16, bf16>(cur, 1 << 30, lds, Sm);
    for (int i = 0;; ++i) {
        const bool more = S.get(i + 1, itn);
        const BlockRef<bf16, bf16> nxt = more ? mkref(T, itn) : cur;
        causal_swa_block<bf16, bf16>(cur, nxt, SEQ, 1 << 30, lds, Sm);
        if (!more) break;
        cur = nxt;
    }
}
#undef KSWZ
#undef SBAR
}

constexpr int NWAVES = 8;
#ifndef MK_N_LAUNCHES
#define MK_N_LAUNCHES 1
#endif
#ifndef SPLIT_BAR
#define SPLIT_BAR 0
#endif
#ifndef GROUP_BAR
#define GROUP_BAR 1
#endif
#ifndef CONV_DOWN_LATE
#define CONV_DOWN_LATE (!GROUP_BAR)
#endif
#ifndef CONV_TAIL
#define CONV_TAIL 0
#endif
#ifndef GEMM_ALIGN
#define GEMM_ALIGN true
#endif
#ifndef GEMM_SP2
#define GEMM_SP2 true
#endif
constexpr int BATCH = 2, SEQ = 8192, DM = 1024, DEPTH = 2;
constexpr int M = BATCH * SEQ;
constexpr int Q_LORA = 256, KV_LORA = 128, QK_ROPE = 32, QK_NOPE = 64, QK_HEAD = 96, V_HEAD = 128, NHEAD = 4;
constexpr int SGU_W = 256, POOL_W = 256, CHUNK = 128;
constexpr int IN_W = 1184, ZLD = 1280;
constexpr int ZO_KV = 256, ZO_ROPE = 384, ZO_U = 416, ZO_V = 672, ZO_P = 928;
constexpr int FF = 2816, FF2 = 2 * FF;
constexpr float EPS = 1e-6f;
constexpr float QPRESCALE = 1.4426950408889634f * 0.10206207261596575f;
constexpr int PH_PER_LAYER = 7, NPH = 1 + DEPTH * PH_PER_LAYER;
constexpr int N_LAUNCHES = (MK_N_LAUNCHES == 1) ? 1 : NPH;

constexpr size_t MiB = 1u << 20;
constexpr size_t WS_CTL = 0, CTL_ZERO_BYTES = 64 * 1024 + (size_t)4 * 16384 * 4;
constexpr size_t WS_SSQ = 64 * 1024;
constexpr size_t WS_W = 2 * MiB, LW = 22 * MiB;
constexpr size_t OW_IN = 0, OW_Q = OW_IN + (size_t)ZLD * DM * 2, OW_KV = OW_Q + (size_t)384 * Q_LORA * 2, OW_OUT = OW_KV + (size_t)768 * KV_LORA * 2,
                 OW_GU = OW_OUT + (size_t)DM * DM * 2, OW_DN = OW_GU + (size_t)FF2 * DM * 2, OW_POOL = OW_DN + (size_t)DM * FF * 2, OW_SP = OW_POOL + (size_t)4 * 64 * 64 * 2, OW_END = OW_SP + (size_t)4 * CHUNK * CHUNK * 2;
static_assert(OW_END + 64 <= LW, "weight map");
constexpr size_t WS_CS = 46 * MiB;
constexpr size_t WS_XB = 48 * MiB;
constexpr size_t WS_Z = 80 * MiB;
constexpr size_t WS_MIX = 120 * MiB;
constexpr size_t WS_Q = 152 * MiB, WS_K = 168 * MiB, WS_V = 184 * MiB;
constexpr size_t WS_ML = 200 * MiB;
constexpr size_t WS_H = 152 * MiB;
constexpr size_t WS_END = 240 * MiB;
constexpr size_t OPART_BYTES = (size_t)8 * SEQ * 128 * 2;
constexpr size_t WS_OP01 = 202 * MiB;
static_assert(WS_W + DEPTH * LW <= WS_CS && WS_H + (size_t)M * FF * 2 <= WS_END && WS_END <= 256 * MiB && WS_Z + (size_t)M * ZLD * 2 <= WS_MIX && WS_Z + 2 * OPART_BYTES <= WS_MIX && WS_OP01 + 2 * OPART_BYTES <= 256 * MiB, "d_ws map");
__host__ __device__ constexpr size_t opart_off(int chunk) { return chunk < 2 ? WS_OP01 + (size_t)chunk * OPART_BYTES : WS_Z + (size_t)(chunk - 2) * OPART_BYTES; }
constexpr int CW_TMO = 0, CW_CODE = 1;
constexpr int CW_BAR = 4096;
constexpr int CW_GB = 8192;

constexpr int RING_OFF = 0, RING_BYTES = 163584;
constexpr int LDSCTL_OFF = RING_BYTES, MISC_OFF = LDSCTL_OFF;
constexpr int LDS_BYTES = 163840;
static_assert(MISC_OFF + 64 <= LDS_BYTES, "LDS map");

#define GAS __attribute__((address_space(1)))
#define LAS __attribute__((address_space(3)))
typedef unsigned short bf16;
typedef unsigned v4u __attribute__((ext_vector_type(4)));
typedef float f32x4 __attribute__((ext_vector_type(4)));
typedef short bf16x8 __attribute__((ext_vector_type(8)));
typedef GAS unsigned gu32;
typedef GAS unsigned long long gu64;
#define RLX_AGENT __ATOMIC_RELAXED, __HIP_MEMORY_SCOPE_AGENT
#define LDS_WAIT() asm volatile("s_waitcnt lgkmcnt(0)" ::: "memory")
#define VM_WAIT() asm volatile("s_waitcnt vmcnt(0)" ::: "memory")
__device__ __forceinline__ unsigned long long rt() { return __builtin_amdgcn_s_memrealtime(); }
__device__ __forceinline__ unsigned f2bf(float f) { unsigned u = __builtin_bit_cast(unsigned, f); return (u + 0x7fffu + ((u >> 16) & 1u)) >> 16; }
typedef float f32x2_t __attribute__((ext_vector_type(2))); typedef __bf16 bf16x2_t __attribute__((ext_vector_type(2)));
__device__ __forceinline__ unsigned pk2(float lo, float hi) { f32x2_t v = {lo, hi}; bf16x2_t b = __builtin_convertvector(v, bf16x2_t); return __builtin_bit_cast(unsigned, b); }

#ifndef XB_EARLY_INV
#define XB_EARLY_INV 1
#endif
#ifndef XB_EARLY_WB
#define XB_EARLY_WB 0
#endif
#ifndef XB_FLAT_RELEASE
#define XB_FLAT_RELEASE 1
#endif
#define XB_TMO      128
#define XB_XCNT(j)  (256  + 64 * (j))
#define XB_XSUB(j)  (1280 + 64 * (j))
#define XB_XGEN(j)  (2304 + 64 * (j))
#define XB_TOP      3328
#define XB_TOPGEN   3392
#define XCD_BAR_WORDS 3456
#define XB_SPIN_CAP (1u << 18)

__device__ __forceinline__ unsigned xb_ld(unsigned* p)              { return __hip_atomic_load(p, __ATOMIC_RELAXED, __HIP_MEMORY_SCOPE_AGENT); }
__device__ __forceinline__ unsigned xb_add(unsigned* p, unsigned v) { return __hip_atomic_fetch_add(p, v, __ATOMIC_RELAXED, __HIP_MEMORY_SCOPE_AGENT); }
__device__ __forceinline__ unsigned xb_xcc_id() { return (unsigned)__builtin_amdgcn_s_getreg((3 << 11) | 20) & 0xFu; }
#define XB_SPIN(cond, bar) do { unsigned _sp = 0; while (cond) { __builtin_amdgcn_s_sleep(1); \
    if ((++_sp & 255u) == 0u) { if (xb_ld(&(bar)[XB_TMO])) break; if (_sp > XB_SPIN_CAP) { atomicAdd(&(bar)[XB_TMO], 1u); break; } } } } while (0)

struct XcdBarrier {
    unsigned* bar; unsigned x;
    volatile LAS unsigned* st;
};

__device__ __forceinline__ XcdBarrier xcd_barrier_post(unsigned* bar, volatile LAS unsigned* st) {
    XcdBarrier b; b.bar = bar; b.x = xb_xcc_id(); b.st = st;
    if (threadIdx.x == 0) (void)xb_add(&bar[XB_XCNT(b.x)], 1u);
    return b;
}
__device__ __forceinline__ void xcd_barrier_complete(unsigned* bar, unsigned x, unsigned& nloc, unsigned& nx) {
    const unsigned G = gridDim.x * gridDim.y * gridDim.z;
    unsigned sum, cnt, mine, sp = 0u;
    for (;;) {
        sum = 0u; cnt = 0u; mine = 0u;
#pragma unroll
        for (unsigned j = 0; j < 16; ++j) { const unsigned c = xb_ld(&bar[XB_XCNT(j)]); sum += c; cnt += (c > 0u) ? 1u : 0u; mine = (j == x) ? c : mine; }
        if (sum == G) break;
        __builtin_amdgcn_s_sleep(1);
        if ((++sp & 255u) == 0u) { if (xb_ld(&bar[XB_TMO])) break; if (sp > XB_SPIN_CAP) { atomicAdd(&bar[XB_TMO], 1u); break; } }
    }
    nloc = mine > 0u ? mine : 1u; nx = cnt > 0u ? cnt : 1u;
}

__device__ __forceinline__ void xcd_barrier(const XcdBarrier& b) {
    asm volatile("s_waitcnt vmcnt(0)" ::: "memory");
    __syncthreads();
    if (threadIdx.x == 0) {
        unsigned* bar = b.bar;
        __builtin_amdgcn_s_waitcnt(0);
        unsigned nloc = b.st[0], nx = b.st[1];
        if (nloc == 0u) { xcd_barrier_complete(bar, b.x, nloc, nx); b.st[0] = nloc; b.st[1] = nx; }
        const unsigned old = xb_add(&bar[XB_XSUB(b.x)], 1u);
        const unsigned gen = old / nloc;
        if (old + 1u == (gen + 1u) * nloc) {
            __builtin_amdgcn_fence(__ATOMIC_RELEASE, "agent");
            asm volatile("s_waitcnt vmcnt(0)" ::: "memory");
            const unsigned og = xb_add(&bar[XB_TOP], 1u);
            const unsigned tg = og / nx;
#if XB_EARLY_INV
            if (og + 1u == (tg + 1u) * nx) { xb_add(&bar[XB_TOPGEN], 1u);
                __builtin_amdgcn_fence(__ATOMIC_ACQUIRE, "agent"); }
            else { __builtin_amdgcn_fence(__ATOMIC_ACQUIRE, "agent");
                   XB_SPIN(xb_ld(&bar[XB_TOPGEN]) == tg, bar); }
#else
            if (og + 1u == (tg + 1u) * nx) xb_add(&bar[XB_TOPGEN], 1u);
            else XB_SPIN(xb_ld(&bar[XB_TOPGEN]) == tg, bar);
            __builtin_amdgcn_fence(__ATOMIC_ACQUIRE, "agent");
#endif
#if !(XB_EARLY_INV && XB_FLAT_RELEASE)
            xb_add(&bar[XB_XGEN(b.x)], 1u);
#endif
            asm volatile("s_waitcnt vmcnt(0)" ::: "memory");
        } else {
#if XB_EARLY_WB
            if (old == gen * nloc) { __builtin_amdgcn_fence(__ATOMIC_RELEASE, "agent"); asm volatile("s_waitcnt vmcnt(0)" ::: "memory"); }
#endif
#if XB_EARLY_INV
            __builtin_amdgcn_fence(__ATOMIC_ACQUIRE, "agent");
            asm volatile("s_waitcnt vmcnt(0)" ::: "memory");
#if XB_FLAT_RELEASE
            XB_SPIN(xb_ld(&bar[XB_TOPGEN]) == gen, bar);
#else
            XB_SPIN(xb_ld(&bar[XB_XGEN(b.x)]) == gen, bar);
#endif
#else
            XB_SPIN(xb_ld(&bar[XB_XGEN(b.x)]) == gen, bar);
            __builtin_amdgcn_fence(__ATOMIC_ACQUIRE, "agent");
            asm volatile("s_waitcnt vmcnt(0)" ::: "memory");
#endif
        }
    }
    __syncthreads();
}

__device__ __forceinline__ void xcd_barrier_arrive(const XcdBarrier& b) {
    asm volatile("s_waitcnt vmcnt(0)" ::: "memory");
    __syncthreads();
    if (threadIdx.x == 0) {
        unsigned* bar = b.bar;
        __builtin_amdgcn_s_waitcnt(0);
        const unsigned nloc = b.st[0], nx = b.st[1];
        const unsigned old = xb_add(&bar[XB_XSUB(b.x)], 1u);
        const unsigned gen = old / nloc;
        b.st[2] = gen;
        if (old + 1u == (gen + 1u) * nloc) {
            __builtin_amdgcn_fence(__ATOMIC_RELEASE, "agent");
            asm volatile("s_waitcnt vmcnt(0)" ::: "memory");
            const unsigned og = xb_add(&bar[XB_TOP], 1u);
            const unsigned tg = og / nx;
            if (og + 1u == (tg + 1u) * nx) xb_add(&bar[XB_TOPGEN], 1u);
        }
    }
    __syncthreads();
}
__device__ __forceinline__ void xcd_barrier_wait(const XcdBarrier& b) {
    asm volatile("s_waitcnt vmcnt(0)" ::: "memory");
    __syncthreads();
    if (threadIdx.x == 0) {
        const unsigned gen = b.st[2];
        __builtin_amdgcn_fence(__ATOMIC_ACQUIRE, "agent");
        asm volatile("s_waitcnt vmcnt(0)" ::: "memory");
        XB_SPIN(xb_ld(&b.bar[XB_TOPGEN]) == gen, b.bar);
    }
    __syncthreads();
}

typedef unsigned u32x2 __attribute__((ext_vector_type(2)));
#define CAS __attribute__((address_space(4)))
struct Args { const float* in[23]; float* out; unsigned char* ws; int ph_lo, ph_hi, li, pad; };
struct Frame {
    LAS unsigned char* lds;
    const CAS Args* a;
    int lane, wave;
    int vcu, G;
};
__device__ __forceinline__ float wave_sum(float v) {
#pragma unroll
    for (int o = 1; o < 64; o <<= 1) v += __shfl_xor(v, o);
    return v;
}
__device__ __forceinline__ float wave_sum_dpp(float v) {
#define WS_DPP(ctrl, rmask) v += __builtin_bit_cast(float, __builtin_amdgcn_update_dpp(0, __builtin_bit_cast(int, v), ctrl, rmask, 0xf, false))
    WS_DPP(0x111, 0xf); WS_DPP(0x112, 0xf); WS_DPP(0x114, 0xf); WS_DPP(0x118, 0xf); WS_DPP(0x142, 0xa); WS_DPP(0x143, 0xc);
#undef WS_DPP
    return __builtin_bit_cast(float, __builtin_amdgcn_readlane(__builtin_bit_cast(int, v), 63));
}
__device__ __forceinline__ float quad_sum(float v) { v += __shfl_xor(v, 16); v += __shfl_xor(v, 32); return v; }
__device__ __forceinline__ float bf2f(unsigned short h) { return __builtin_bit_cast(float, (unsigned)h << 16); }
__device__ __forceinline__ float bflo(unsigned w) { return __builtin_bit_cast(float, w << 16); }
__device__ __forceinline__ float bfhi(unsigned w) { return __builtin_bit_cast(float, w & 0xffff0000u); }
__device__ __forceinline__ f32x4 mfma16(bf16x8 a, bf16x8 b, f32x4 c) { return __builtin_amdgcn_mfma_f32_16x16x32_bf16(a, b, c, 0, 0, 0); }
__device__ __forceinline__ u32x2 pk4(f32x4 v) { u32x2 w; w.x = pk2(v[0], v[1]); w.y = pk2(v[2], v[3]); return w; }
__device__ __forceinline__ bf16x8 pk8(const float* v) { v4u w; w.x = pk2(v[0], v[1]); w.y = pk2(v[2], v[3]); w.z = pk2(v[4], v[5]); w.w = pk2(v[6], v[7]); return __builtin_bit_cast(bf16x8, w); }

#define IN_F(i) ((const float*)F.a->in[i])
__device__ __forceinline__ bf16* wsp(const Frame& F, size_t off) { return (bf16*)(F.a->ws + off); }
__device__ __forceinline__ float* ssq_mix(const Frame& F, int l) { return (float*)(F.a->ws + WS_SSQ) + (size_t)(2 * l) * M; }
__device__ __forceinline__ float* ssq_ffn(const Frame& F, int l) { return (float*)(F.a->ws + WS_SSQ) + (size_t)(2 * l + 1) * M; }

__device__ __forceinline__ void p0_tr_item64(const float* W, int ldw, int k0, int n0, int nv, const float* gain, bf16* WT, int ldt, int drow0, LAS float* scr, int lane) {
    const int c4 = 4 * (lane & 15), rr = lane >> 4;
    f32x4 v[16]; float gg[16];
#pragma unroll
    for (int i = 0; i < 16; ++i) gg[i] = gain ? gain[k0 + rr + 4 * i] : 1.0f;
#pragma unroll
    for (int i = 0; i < 16; ++i) { v[i] = (f32x4){0.f, 0.f, 0.f, 0.f}; if (c4 < nv) v[i] = *(const GAS f32x4*)(W + (size_t)(k0 + rr + 4 * i) * ldw + n0 + c4); }
#pragma unroll
    for (int i = 0; i < 16; ++i) { const int kk = rr + 4 * i; const float g = gg[i];
#pragma unroll
        for (int e = 0; e < 4; ++e) scr[kk * 65 + c4 + e] = v[i][e] * g; }
    LDS_WAIT(); asm volatile("" ::: "memory");
    const int c = lane & 7;
#pragma unroll
    for (int j = 0; j < 8; ++j) { const int n = (lane >> 3) + 8 * j; const LAS float* sp = scr + (8 * c) * 65 + n;
        if (n < nv) { v4u o; o.x = pk2(sp[0 * 65], sp[1 * 65]); o.y = pk2(sp[2 * 65], sp[3 * 65]); o.z = pk2(sp[4 * 65], sp[5 * 65]); o.w = pk2(sp[6 * 65], sp[7 * 65]);
            *(GAS v4u*)(WT + (size_t)(drow0 + n) * ldt + k0 + 8 * c) = o; } }
    LDS_WAIT(); asm volatile("" ::: "memory");
}
constexpr int CI_IN = (DM / 64) * ((IN_W + 63) / 64), CI_Q = (Q_LORA / 64) * (384 / 64), CI_KV = (KV_LORA / 64) * (768 / 64), CI_SET0 = CI_IN + CI_Q + CI_KV;
constexpr int CI_OUT = (DM / 64) * (DM / 64), CI_G = (DM / 64) * (FF / 64), CI_DN = (FF / 64) * (DM / 64), CI_SET1 = CI_OUT + 2 * CI_G + CI_DN;
__device__ __forceinline__ void conv_item(Frame& F, int l, int set, int r, LAS float* scr, int lane) {
    unsigned char* wl = F.a->ws + WS_W + (size_t)l * LW;
    if (set == 0) {
        if (r < CI_IN) { const int nb = (IN_W + 63) / 64, kb = r / nb, n0 = 64 * (r % nb);
            p0_tr_item64(IN_F(3) + (size_t)l * DM * IN_W, IN_W, 64 * kb, n0, IN_W - n0 < 64 ? IN_W - n0 : 64, IN_F(2) + l * DM, (bf16*)(wl + OW_IN), DM, n0, scr, lane); return; } r -= CI_IN;
        if (r < CI_Q) { const int nb = 384 / 64, kb = r / nb, n0 = 64 * (r % nb);
            p0_tr_item64(IN_F(5) + (size_t)l * Q_LORA * 384, 384, 64 * kb, n0, 64, IN_F(4) + l * Q_LORA, (bf16*)(wl + OW_Q), Q_LORA, n0, scr, lane); return; } r -= CI_Q;
        { const int nb = 768 / 64, kb = r / nb, n0 = 64 * (r % nb);
            p0_tr_item64(IN_F(7) + (size_t)l * KV_LORA * 768, 768, 64 * kb, n0, 64, IN_F(6) + l * KV_LORA, (bf16*)(wl + OW_KV), KV_LORA, n0, scr, lane); return; }
    }
    if (r < CI_OUT) { const int nb = DM / 64, kb = r / nb, n0 = 64 * (r % nb), k0 = 64 * kb;
        const float* g = k0 < 512 ? IN_F(15) + l * 512 : k0 < 768 ? IN_F(16) + l * 256 - 512 : IN_F(17) + l * 256 - 768;
        p0_tr_item64(IN_F(18) + (size_t)l * DM * DM, DM, k0, n0, 64, g, (bf16*)(wl + OW_OUT), DM, n0, scr, lane); return; } r -= CI_OUT;
    if (r < 2 * CI_G) { const int up = r >= CI_G; if (up) r -= CI_G; const int nb = FF / 64, kb = r / nb, n0 = 64 * (r % nb);
        p0_tr_item64(IN_F(up ? 21 : 20) + (size_t)l * DM * FF, FF, 64 * kb, n0, 64, IN_F(19) + l * DM, (bf16*)(wl + OW_GU), DM, (n0 >> 7) * 256 + (n0 & 127) + (up ? 128 : 0), scr, lane); return; } r -= 2 * CI_G;
    { const int nb = DM / 64, kb = r / nb, n0 = 64 * (r % nb);
        p0_tr_item64(IN_F(22) + (size_t)l * FF * DM, DM, 64 * kb, n0, 64, nullptr, (bf16*)(wl + OW_DN), FF, n0, scr, lane); }
}
__device__ __forceinline__ void conv_set(Frame& F, int l, int set, int wk, int nwk, int first = 0, int last = 1 << 30) {
    LAS float* scr = (LAS float*)(F.lds + RING_OFF + F.wave * 16640);
    const int n = set == 0 ? CI_SET0 : CI_SET1, hi = last < n ? last : n;
    for (int it = first + wk; it < hi; it += nwk) conv_item(F, l, set, it, scr, F.lane);
}
constexpr int CI_SPLIT = 1184;
#ifndef CONV_DEFER
#define CONV_DEFER 1
#endif
__device__ __forceinline__ void p0_prologue(Frame& F) {
    const int gw = F.vcu * NWAVES + F.wave, NGW = F.G * NWAVES, lane = F.lane;
    { const int wk0 = F.wave * F.G + F.vcu;
      for (int l = 0; l < DEPTH; ++l) { conv_set(F, l, 0, (wk0 + NGW - (l * CI_SET0) % NGW) % NGW, NGW); if (!CONV_DEFER) conv_set(F, l, 1, gw, NGW); } }
    { const int gt = gw * 64 + lane, NGT = NGW * 64;
        constexpr int NPAD = DEPTH * (ZLD - IN_W) * DM / 8, NPOOL = DEPTH * 4 * 64 * 64, NTRIL = DEPTH * 4 * CHUNK * CHUNK / 8, NROPE = M * 16;
        const int* pos = (const int*)IN_F(1);
        auto pad_body = [&](int i) { const int l = i / ((ZLD - IN_W) * DM / 8), e = i % ((ZLD - IN_W) * DM / 8);
            *(GAS v4u*)(F.a->ws + WS_W + (size_t)l * LW + OW_IN + (size_t)IN_W * DM * 2 + (size_t)e * 16) = (v4u){0u, 0u, 0u, 0u}; };
        auto pool_ld = [&](int i, float& w, float& sc) { const int l = i >> 14, g = (i >> 12) & 3, d = (i >> 6) & 63, c = i & 63; w = IN_F(13)[(size_t)l * 16384 + (g * 64 + c) * 64 + d]; sc = IN_F(14)[l * POOL_W + g * 64 + d]; };
        auto pool_body = [&](int i, float w, float sc) { const int l = i >> 14, g = (i >> 12) & 3, d = (i >> 6) & 63, c = i & 63;
            ((bf16*)(F.a->ws + WS_W + (size_t)l * LW + OW_POOL))[(g * 64 + d) * 64 + c] = (bf16)f2bf(w * sc); };
        auto tril_ld = [&](int i, f32x4& a, f32x4& b) { const int l = i >> 13, e = (i & 8191) * 8; const float* src = IN_F(11) + (size_t)l * 4 * CHUNK * CHUNK + e; a = *(const f32x4*)src; b = *(const f32x4*)(src + 4); };
        auto tril_body = [&](int i, f32x4 a, f32x4 b) { const int l = i >> 13, e = (i & 8191) * 8, t = (e >> 7) & 127, s0 = e & 127;
            float v[8] = {a[0], a[1], a[2], a[3], b[0], b[1], b[2], b[3]};
#pragma unroll
            for (int j = 0; j < 8; ++j) if (s0 + j > t) v[j] = 0.f;
            *(bf16x8*)(F.a->ws + WS_W + (size_t)l * LW + OW_SP + (size_t)e * 2) = pk8(v); };
        auto rope_body = [&](int i, int pv) { const int m = i >> 4, f = i & 15;
            const float inv = 1.0f / powf(10000.0f, (float)f * (1.0f / 16.0f));
            const float ang = (float)pv * inv;
            const double a = (double)ang, n = rint(a * 0.15915494309189535), y = a - n * 6.283185307179586;
            const float yf = (float)y; ((float*)(F.a->ws + WS_CS))[(size_t)m * 32 + f] = cosf(yf); ((float*)(F.a->ws + WS_CS))[(size_t)m * 32 + 16 + f] = sinf(yf); };
        { float pw = 0.f, psc = 0.f; f32x4 ta = {0.f, 0.f, 0.f, 0.f}, tb = ta; int pv0 = 0, pv1 = 0;
          if (gt < NPOOL) pool_ld(gt, pw, psc);
          if (gt < NTRIL) tril_ld(gt, ta, tb);
          if (gt < NROPE) pv0 = pos[gt >> 4];
          if (gt + NGT < NROPE) pv1 = pos[(gt + NGT) >> 4];
          if (gt < NPAD) pad_body(gt);
          if (gt < NPOOL) pool_body(gt, pw, psc);
          if (gt < NTRIL) tril_body(gt, ta, tb);
          if (gt < NROPE) rope_body(gt, pv0);
          if (gt + NGT < NROPE) rope_body(gt + NGT, pv1); }
        for (int i = gt + NGT; i < NPAD; i += NGT) pad_body(i);
        for (int i = gt + NGT; i < NPOOL; i += NGT) { float w, sc; pool_ld(i, w, sc); pool_body(i, w, sc); }
        for (int i = gt + NGT; i < NTRIL; i += NGT) { f32x4 a, b; tril_ld(i, a, b); tril_body(i, a, b); }
        for (int i = gt + 2 * NGT; i < NROPE; i += NGT) rope_body(i, pos[i >> 4]);
    }
    if (gw < DEPTH) { const int l = gw; float gqm = 0.f, gkm = 0.f; const float* gq = IN_F(8) + l * QK_HEAD; const float* gk = IN_F(9) + l * QK_HEAD;
        for (int i = lane; i < QK_HEAD; i += 64) { gqm = fmaxf(gqm, fabsf(gq[i])); gkm = fmaxf(gkm, fabsf(gk[i])); }
#pragma unroll
        for (int o = 1; o < 64; o <<= 1) { gqm = fmaxf(gqm, __shfl_xor(gqm, o)); gkm = fmaxf(gkm, __shfl_xor(gkm, o)); }
        if (lane == 0) *(float*)(F.a->ws + WS_W + (size_t)l * LW + OW_END) = fmaxf(0.f, 1.4426950408889634f * 9.797958971132712f * gqm * gkm - 64.0f); }
    float* ssq0 = ssq_mix(F, 0);
#ifdef PROBE_TWICE
    for (int i = gw * 64 + lane; i < 3 * M; i += NGW * 64) ssq0[M + i] = 0.f;
#endif
    static_assert(M % (64 * 256) == 0, "x pass: 64 rows per workgroup and round");
    for (int mb = F.vcu * 64; mb < M; mb += F.G * 64)
    for (int j = F.wave >= 3 ? F.wave - 3 : 13 + F.wave; j < (F.wave >= 3 ? 13 : 16); j += (F.wave >= 3 ? 5 : 16)) {
        const int m0 = mb + 4 * j;
        f32x4 v[4][4];
#pragma unroll
        for (int r = 0; r < 4; ++r) { const GAS f32x4* xr = (const GAS f32x4*)(IN_F(0) + (size_t)(m0 + r) * DM) + 2 * lane;
#pragma unroll
            for (int j = 0; j < 2; ++j) { v[r][2 * j] = xr[128 * j]; v[r][2 * j + 1] = xr[128 * j + 1]; } }
#pragma unroll
        for (int r = 0; r < 4; ++r) { float s = 0.f; GAS v4u* o16 = (GAS v4u*)(wsp(F, WS_XB) + (size_t)(m0 + r) * DM) + lane;
#pragma unroll
            for (int j = 0; j < 2; ++j) { const f32x4 x = v[r][2 * j], y = v[r][2 * j + 1];
                s += ((x.x * x.x + x.y * x.y) + (x.z * x.z + x.w * x.w)) + ((y.x * y.x + y.y * y.y) + (y.z * y.z + y.w * y.w));
                o16[64 * j] = (v4u){pk2(x.x, x.y), pk2(x.z, x.w), pk2(y.x, y.y), pk2(y.z, y.w)}; }
            s = wave_sum_dpp(s); if (lane == 0) ssq0[m0 + r] = s; }
    }
}

__device__ __forceinline__ void p2_upproj_unit(Frame& F, int l, int chunk, bool dry = false) {
    int lane_ = F.lane; asm volatile("" : "+v"(lane_));
    const int lane = lane_, tl = lane & 15, kq = lane >> 4;
    const int m0w = chunk * CHUNK + F.wave * 16, m = m0w + tl, b = m >> 13, s0w = m0w & (SEQ - 1);
    const bf16* zrow = wsp(F, WS_Z) + (size_t)m * ZLD;
    const unsigned char* wl = F.a->ws + WS_W + (size_t)l * LW;
    const bf16* Wq = (const bf16*)(wl + OW_Q); const bf16* Wkv = (const bf16*)(wl + OW_KV);
    LAS unsigned char* buf0 = F.lds + RING_OFF; LAS unsigned char* buf1 = F.lds + RING_OFF + 49152;
    LAS unsigned char* stg = F.lds + RING_OFF + 98304 + F.wave * 4352;
#define UP_DMAQ(h_) do { _Pragma("unroll") for (int i = 0; i < 6; ++i) { const int j = F.wave * 6 + i, row = 2 * j + (lane >> 5), slot = lane & 31; \
        __builtin_amdgcn_global_load_lds((const unsigned*)((const unsigned char*)Wq + (size_t)((h_) * QK_HEAD + row) * (Q_LORA * 2) + ((slot ^ (row & 15)) * 16)), (LAS unsigned*)(buf0 + j * 1024), 16, 0, 0); } } while (0)
#define UP_DMAKV(h_) do { _Pragma("unroll") for (int i = 0; i < 6; ++i) { const int j = F.wave * 6 + i, row = 4 * j + (lane >> 4), slot = lane & 15; \
        __builtin_amdgcn_global_load_lds((const unsigned*)((const unsigned char*)Wkv + (size_t)((h_) * 192 + row) * (KV_LORA * 2) + ((slot ^ (row & 15)) * 16)), (LAS unsigned*)(buf1 + j * 1024), 16, 0, 0); } } while (0)
    UP_DMAQ(0);
    bf16x8 zq[8], zkv[4];
#pragma unroll
    for (int ks = 0; ks < 8; ++ks) zq[ks] = *(const bf16x8*)(zrow + ks * 32 + kq * 8);
#pragma unroll
    for (int ks = 0; ks < 4; ++ks) zkv[ks] = *(const bf16x8*)(zrow + ZO_KV + ks * 32 + kq * 8);
    const u32x2 kw0 = *(const u32x2*)(zrow + ZO_ROPE + 4 * kq), kw1 = *(const u32x2*)(zrow + ZO_ROPE + 16 + 4 * kq);
    const float* csr = (const float*)(F.a->ws + WS_CS) + (size_t)m * 32;
    const f32x4 cs = *(const f32x4*)(csr + 4 * kq), sn = *(const f32x4*)(csr + 16 + 4 * kq);
    const float* gq = IN_F(8) + l * QK_HEAD; const float* gk = IN_F(9) + l * QK_HEAD;
    LAS float* gtab = (LAS float*)(F.lds + RING_OFF + 98304 + 8 * 4352);
    if (F.wave == 0) { for (int i = lane; i < 2 * QK_HEAD; i += 64) gtab[i] = i < QK_HEAD ? gq[i] : gk[i - QK_HEAD]; }
#define gqv(nb_) (*(const LAS f32x4*)(gtab + (nb_) * 16 + 4 * kq))
#define gkv(nb_) (*(const LAS f32x4*)(gtab + QK_HEAD + (nb_) * 16 + 4 * kq))
    float sq = 0.f, skv = 0.f;
#pragma unroll
    for (int ks = 0; ks < 8; ++ks)
#pragma unroll
        for (int j = 0; j < 8; ++j) { const float v = bf2f((unsigned short)zq[ks][j]); sq += v * v; }
#pragma unroll
    for (int ks = 0; ks < 4; ++ks)
#pragma unroll
        for (int j = 0; j < 8; ++j) { const float v = bf2f((unsigned short)zkv[ks][j]); skv += v * v; }
    const float r_q = __builtin_amdgcn_rsqf(quad_sum(sq) * (1.0f / Q_LORA) + EPS), r_kv = __builtin_amdgcn_rsqf(quad_sum(skv) * (1.0f / KV_LORA) + EPS);
    const f32x4 kr0 = {bflo(kw0.x), bfhi(kw0.x), bflo(kw0.y), bfhi(kw0.y)}, kr1 = {bflo(kw1.x), bfhi(kw1.x), bflo(kw1.y), bfhi(kw1.y)};
    float skr = (kr0[0] * kr0[0] + kr0[1] * kr0[1]) + (kr0[2] * kr0[2] + kr0[3] * kr0[3]) + (kr1[0] * kr1[0] + kr1[1] * kr1[1]) + (kr1[2] * kr1[2] + kr1[3] * kr1[3]);
    skr = quad_sum(skr);
#define UP_RD(dst_, ad_, OFF_) asm volatile("ds_read_b128 %0, %1 offset:%2" : "=v"(dst_) : "v"(ad_), "i"(OFF_) : "memory")
    const unsigned qbase = (unsigned)(uintptr_t)buf0 + tl * 512, kbase = (unsigned)(uintptr_t)buf1 + tl * 256;
#define UP_RDQ(d_, ks_) do { const unsigned ad_ = qbase + ((((ks_) * 4 + kq) ^ tl) << 4); UP_RD(d_[0], ad_, 0); UP_RD(d_[1], ad_, 8192); UP_RD(d_[2], ad_, 16384); UP_RD(d_[3], ad_, 24576); UP_RD(d_[4], ad_, 32768); UP_RD(d_[5], ad_, 40960); } while (0)
#define UP_RDKV(d_, ks_) do { const unsigned ad_ = kbase + ((((ks_) * 4 + kq) ^ tl) << 4); UP_RD(d_[0], ad_, 0); UP_RD(d_[1], ad_, 4096); UP_RD(d_[2], ad_, 8192); UP_RD(d_[3], ad_, 12288); UP_RD(d_[4], ad_, 16384); UP_RD(d_[5], ad_, 20480); \
        UP_RD(d_[6], ad_, 24576); UP_RD(d_[7], ad_, 28672); UP_RD(d_[8], ad_, 32768); UP_RD(d_[9], ad_, 36864); UP_RD(d_[10], ad_, 40960); UP_RD(d_[11], ad_, 45056); } while (0)
#define UP_PUT(nb_, v_) (*(LAS u32x2*)(stg + tl * 272 + (nb_) * 32 + kq * 8) = pk4(v_))
#ifdef PROBE_DRYSTORE
#define UP_DRY dry
#else
#define UP_DRY false
#endif
#define UP_FLUSH(dst_) do { if (!UP_DRY) { unsigned char* d_ = (unsigned char*)(dst_) + (size_t)(lane >> 4) * 256 + (lane & 15) * 16; _Pragma("unroll") for (int i = 0; i < 4; ++i) \
        *(GAS v4u*)(d_ + i * 1024) = *(const LAS v4u*)(stg + (4 * i + (lane >> 4)) * 272 + (lane & 15) * 16); } } while (0)
    __syncthreads();
#pragma unroll 1
    for (int h = 0; h < NHEAD; ++h) {
        const size_t orow0 = ((size_t)(b * NHEAD + h) * SEQ + s0w) * 128;
#ifdef PROBE_NODMA
        if (!dry)
#endif
        UP_DMAKV(h); asm volatile("" ::: "memory");
        {
            f32x4 acc[6];
#pragma unroll
            for (int nb = 0; nb < 6; ++nb) acc[nb] = (f32x4){0.f, 0.f, 0.f, 0.f};
            {
                bf16x8 fa[6], fb[6];
                UP_RDQ(fa, 0);
#define UP_QSTEP(cur_, nxt_, ks_) do { asm volatile("s_waitcnt lgkmcnt(0)" ::: "memory"); __builtin_amdgcn_sched_barrier(0); if ((ks_) + 1 < 8) UP_RDQ(nxt_, (ks_) + 1); \
                    _Pragma("unroll") for (int nb = 0; nb < 6; ++nb) acc[nb] = mfma16(cur_[nb], zq[ks_], acc[nb]); __builtin_amdgcn_sched_barrier(0); } while (0)
                UP_QSTEP(fa, fb, 0); UP_QSTEP(fb, fa, 1); UP_QSTEP(fa, fb, 2); UP_QSTEP(fb, fa, 3); UP_QSTEP(fa, fb, 4); UP_QSTEP(fb, fa, 5); UP_QSTEP(fa, fb, 6); UP_QSTEP(fb, fa, 7);
#undef UP_QSTEP
            }
            float ss = 0.f;
#pragma unroll
            for (int nb = 0; nb < 6; ++nb) { acc[nb] = acc[nb] * r_q; ss += (acc[nb][0] * acc[nb][0] + acc[nb][1] * acc[nb][1]) + (acc[nb][2] * acc[nb][2] + acc[nb][3] * acc[nb][3]); }
            const float rh = __builtin_amdgcn_rsqf(quad_sum(ss) * (1.0f / QK_HEAD) + EPS);
#pragma unroll
            for (int nb = 0; nb < 6; ++nb) acc[nb] = acc[nb] * (rh * QPRESCALE) * gqv(nb);
            const f32x4 x1 = acc[4], x2 = acc[5]; acc[4] = x1 * cs - x2 * sn; acc[5] = x2 * cs + x1 * sn;
#pragma unroll
            for (int nb = 0; nb < 6; ++nb) UP_PUT(nb, acc[nb]);
            UP_PUT(6, ((f32x4){0.f, 0.f, 0.f, 0.f})); UP_PUT(7, ((f32x4){0.f, 0.f, 0.f, 0.f}));
            UP_FLUSH(wsp(F, WS_Q) + orow0);
        }
        asm volatile("s_waitcnt vmcnt(4) lgkmcnt(0)" ::: "memory"); __builtin_amdgcn_s_barrier(); asm volatile("" ::: "memory");
#ifdef PROBE_NODMA
        if (!dry)
#endif
        if (h + 1 < NHEAD) UP_DMAQ(h + 1);
        asm volatile("" ::: "memory");
        {
            f32x4 acc[12];
#pragma unroll
            for (int nb = 0; nb < 12; ++nb) acc[nb] = (f32x4){0.f, 0.f, 0.f, 0.f};
            {
                bf16x8 fa[12], fb[12];
                UP_RDKV(fa, 0);
#define UP_KSTEP(cur_, nxt_, ks_) do { asm volatile("s_waitcnt lgkmcnt(0)" ::: "memory"); __builtin_amdgcn_sched_barrier(0); if ((ks_) + 1 < 4) UP_RDKV(nxt_, (ks_) + 1); \
                    _Pragma("unroll") for (int nb = 0; nb < 12; ++nb) acc[nb] = mfma16(cur_[nb], zkv[ks_], acc[nb]); __builtin_amdgcn_sched_barrier(0); } while (0)
                UP_KSTEP(fa, fb, 0); UP_KSTEP(fb, fa, 1); UP_KSTEP(fa, fb, 2); UP_KSTEP(fb, fa, 3);
#undef UP_KSTEP
            }
            float ss = 0.f;
#pragma unroll
            for (int nb = 0; nb < 4; ++nb) { acc[nb] = acc[nb] * r_kv; ss += (acc[nb][0] * acc[nb][0] + acc[nb][1] * acc[nb][1]) + (acc[nb][2] * acc[nb][2] + acc[nb][3] * acc[nb][3]); }
            const float rh = __builtin_amdgcn_rsqf((quad_sum(ss) + skr) * (1.0f / QK_HEAD) + EPS);
#pragma unroll
            for (int nb = 0; nb < 4; ++nb) UP_PUT(nb, acc[nb] * rh * gkv(nb));
            const f32x4 x1 = kr0 * rh * gkv(4), x2 = kr1 * rh * gkv(5);
            UP_PUT(4, x1 * cs - x2 * sn); UP_PUT(5, x2 * cs + x1 * sn);
            UP_PUT(6, ((f32x4){0.f, 0.f, 0.f, 0.f})); UP_PUT(7, ((f32x4){0.f, 0.f, 0.f, 0.f}));
            UP_FLUSH(wsp(F, WS_K) + orow0);
#pragma unroll
            for (int nb = 0; nb < 8; ++nb) UP_PUT(nb, acc[4 + nb] * r_kv);
            UP_FLUSH(wsp(F, WS_V) + orow0);
        }
        asm volatile("s_waitcnt vmcnt(8) lgkmcnt(0)" ::: "memory"); __builtin_amdgcn_s_barrier(); asm volatile("" ::: "memory");
    }
#undef gqv
#undef gkv
#undef UP_DMAQ
#undef UP_DMAKV
#undef UP_PUT
#undef UP_RD
#undef UP_RDQ
#undef UP_RDKV
#undef UP_FLUSH
}

constexpr int VS = 136;
__device__ __forceinline__ void p2_sgu_pool_unit(Frame& F, int l, int chunk, int cut = 0) {
    int lane_ = F.lane; asm volatile("" : "+v"(lane_));
    const int lane = lane_, tl = lane & 15, kq = lane >> 4, w = F.wave;
    LAS bf16* vnT = (LAS bf16*)(F.lds + RING_OFF);
    LAS unsigned char* pt = F.lds + RING_OFF + 69632;
    LAS unsigned char* stg = F.lds + RING_OFF + 145152 + w * 2304;
    const bf16* Z = wsp(F, WS_Z);
    const unsigned char* wl = F.a->ws + WS_W + (size_t)l * LW;
    const int t = w * 16 + tl, m = chunk * CHUNK + t, s = m & (SEQ - 1);
    const bf16* zrow = Z + (size_t)m * ZLD;
    v4u pv[9];
    { const int tid = w * 64 + lane, m0 = chunk * CHUNK, s0 = m0 & (SEQ - 1);
#pragma unroll
      for (int i = 0; i < 9; ++i) { const int c = tid + 512 * i, r = c >> 5, k = c & 31; pv[i] = (v4u){0u, 0u, 0u, 0u};
          if (c < 143 * 32 && s0 + r >= 15) pv[i] = *(const GAS v4u*)(Z + (size_t)(m0 - 15 + r) * ZLD + ZO_P + k * 8); } }
    u32x2 vws[16];
#pragma unroll
    for (int i = 0; i < 16; ++i) vws[i] = *(const u32x2*)(Z + (size_t)(chunk * CHUNK + w * 16 + i) * ZLD + ZO_V + 4 * lane);
    const f32x4 gv = *(const f32x4*)(IN_F(10) + l * SGU_W + 4 * lane);
    bf16x8 bfr[4][4];
#pragma unroll
    for (int ks = 0; ks < 4; ++ks)
#pragma unroll
        for (int h = 0; h < 4; ++h) bfr[ks][h] = *(const bf16x8*)(wl + OW_SP + ((size_t)(h * CHUNK + t) * CHUNK + ks * 32 + kq * 8) * 2);
    { float vv[4][16];
#pragma unroll
      for (int i = 0; i < 16; ++i) { const f32x4 v = {bflo(vws[i].x), bfhi(vws[i].x), bflo(vws[i].y), bfhi(vws[i].y)};
          const float r = __builtin_amdgcn_rsqf(wave_sum_dpp((v[0] * v[0] + v[1] * v[1]) + (v[2] * v[2] + v[3] * v[3])) * (1.0f / SGU_W) + EPS);
#pragma unroll
          for (int j = 0; j < 4; ++j) vv[j][i] = v[j] * r * gv[j]; }
#pragma unroll
      for (int j = 0; j < 4; ++j) { *(LAS bf16x8*)(vnT + (j * 64 + lane) * VS + w * 16) = pk8(&vv[j][0]); *(LAS bf16x8*)(vnT + (j * 64 + lane) * VS + w * 16 + 8) = pk8(&vv[j][8]); } }
    { const int tid = w * 64 + lane;
#pragma unroll
      for (int i = 0; i < 9; ++i) { const int c = tid + 512 * i, r = c >> 5, k = c & 31; if (c < 143 * 32) *(LAS v4u*)(pt + r * 528 + k * 16) = pv[i]; } }
    __syncthreads();
#ifdef PROBE_CUT
    if (cut == 1) { __syncthreads(); return; }
#endif
    unsigned char* mixw = (unsigned char*)(wsp(F, WS_MIX) + (size_t)(chunk * CHUNK + w * 16) * DM);
    {
        v4u uw[4][2]; float bsp[4];
#pragma unroll
        for (int h = 0; h < 4; ++h) { bsp[h] = IN_F(12)[(size_t)(l * 4 + h) * CHUNK + t];
#pragma unroll
            for (int e = 0; e < 2; ++e) uw[h][e] = *(const v4u*)(zrow + ZO_U + h * 64 + 16 * kq + 8 * e); }
        f32x4 acc[4][4];
#pragma unroll
        for (int h = 0; h < 4; ++h)
#pragma unroll
            for (int db = 0; db < 4; ++db) acc[h][db] = (f32x4){0.f, 0.f, 0.f, 0.f};
#pragma unroll
        for (int ks = 0; ks < 4; ++ks) {
#pragma unroll
            for (int h = 0; h < 4; ++h)
#pragma unroll
                for (int db = 0; db < 4; ++db) { const bf16x8 a = *(const LAS bf16x8*)(vnT + (db * 64 + h * 16 + tl) * VS + ks * 32 + kq * 8); acc[h][db] = mfma16(a, bfr[ks][h], acc[h][db]); }
            __builtin_amdgcn_sched_barrier(0);
        }
        float ss = 0.f;
#pragma unroll
        for (int h = 0; h < 4; ++h) { const unsigned uu[8] = {uw[h][0].x, uw[h][0].y, uw[h][0].z, uw[h][0].w, uw[h][1].x, uw[h][1].y, uw[h][1].z, uw[h][1].w};
#pragma unroll
            for (int r = 0; r < 4; ++r)
#pragma unroll
                for (int db = 0; db < 4; ++db) { const int c = 4 * r + db; const float u = (c & 1) ? bfhi(uu[c >> 1]) : bflo(uu[c >> 1]); const float g = u * (acc[h][db][r] + bsp[h]); acc[h][db][r] = g; ss += g * g; } }
        const float rB = __builtin_amdgcn_rsqf(quad_sum(ss) * (1.0f / SGU_W) + EPS);
#pragma unroll
        for (int h = 0; h < 4; ++h) { float o[16];
#pragma unroll
            for (int r = 0; r < 4; ++r)
#pragma unroll
                for (int db = 0; db < 4; ++db) o[4 * r + db] = acc[h][db][r] * rB;
            unsigned char* dst = mixw + (size_t)tl * (DM * 2) + (512 + h * 64 + 16 * kq) * 2;
            *(GAS bf16x8*)dst = pk8(&o[0]); *(GAS bf16x8*)(dst + 16) = pk8(&o[8]); }
    }
#ifdef PROBE_CUT
    if (cut == 2) { __syncthreads(); return; }
#endif
    {
        f32x4 acc[4][4];
#pragma unroll
        for (int g = 0; g < 4; ++g)
#pragma unroll
            for (int db = 0; db < 4; ++db) acc[g][db] = (f32x4){0.f, 0.f, 0.f, 0.f};
        const bf16* wp = (const bf16*)(wl + OW_POOL);
        const LAS unsigned char* pb = pt + (15 + t) * 528 + kq * 16;
        bf16x8 wa[2][4], wn[2][4];
#pragma unroll
        for (int ks = 0; ks < 2; ++ks)
#pragma unroll
            for (int db = 0; db < 4; ++db) wa[ks][db] = *(const bf16x8*)(wp + (size_t)(db * 16 + tl) * 64 + ks * 32 + kq * 8);
#pragma unroll
        for (int g = 0; g < 4; ++g) { const int win = 2 << g; const int cnt = (s + 1 < win) ? s + 1 : win; const float rc = 1.0f / (float)cnt;
            if (g < 3) {
#pragma unroll
                for (int ks = 0; ks < 2; ++ks)
#pragma unroll
                    for (int db = 0; db < 4; ++db) wn[ks][db] = *(const bf16x8*)(wp + (size_t)((g + 1) * 64 + db * 16 + tl) * 64 + ks * 32 + kq * 8); }
#pragma unroll
            for (int ks = 0; ks < 2; ++ks) {
                float sum[8], cur[8];
                { const v4u pw = *(const LAS v4u*)(pb + (g * 64 + ks * 32) * 2); const unsigned ww[4] = {pw.x, pw.y, pw.z, pw.w};
#pragma unroll
                  for (int j = 0; j < 4; ++j) { cur[2 * j] = bflo(ww[j]); cur[2 * j + 1] = bfhi(ww[j]); sum[2 * j] = cur[2 * j]; sum[2 * j + 1] = cur[2 * j + 1]; } }
#pragma unroll
                for (int jj = 1; jj < win; ++jj) { const v4u pw = *(const LAS v4u*)(pb - jj * 528 + (g * 64 + ks * 32) * 2); const unsigned ww[4] = {pw.x, pw.y, pw.z, pw.w};
#pragma unroll
                  for (int j = 0; j < 4; ++j) { sum[2 * j] += bflo(ww[j]); sum[2 * j + 1] += bfhi(ww[j]); } }
                float mv[8];
#pragma unroll
                for (int j = 0; j < 8; ++j) mv[j] = sum[j] * rc - cur[j];
                const bf16x8 bfrag = pk8(mv);
#pragma unroll
                for (int db = 0; db < 4; ++db) acc[g][db] = mfma16(wa[ks][db], bfrag, acc[g][db]);
            }
#pragma unroll
            for (int ks = 0; ks < 2; ++ks)
#pragma unroll
                for (int db = 0; db < 4; ++db) wa[ks][db] = wn[ks][db];
            __builtin_amdgcn_sched_barrier(0);
        }
        float ss = 0.f;
#pragma unroll
        for (int g = 0; g < 4; ++g)
#pragma unroll
            for (int db = 0; db < 4; ++db) { const f32x4 y = acc[g][db];
                ss += (y[0] * y[0] + y[1] * y[1]) + (y[2] * y[2] + y[3] * y[3]); }
        const float rC = __builtin_amdgcn_rsqf(quad_sum(ss) * (1.0f / POOL_W) + EPS);
#pragma unroll
        for (int g = 0; g < 4; ++g) {
#pragma unroll
            for (int db = 0; db < 4; ++db) *(LAS u32x2*)(stg + tl * 144 + db * 32 + kq * 8) = pk4(acc[g][db] * rC);
#pragma unroll
            for (int i = 0; i < 2; ++i) *(GAS v4u*)(mixw + (size_t)(8 * i + (lane >> 3)) * (DM * 2) + (768 + g * 64) * 2 + (lane & 7) * 16) = *(const LAS v4u*)(stg + (8 * i + (lane >> 3)) * 144 + (lane & 7) * 16);
        }
    }
    __syncthreads();
}

#ifndef ATT_SPLIT
#define ATT_SPLIT 1
#endif
constexpr int ATT_MAXI = 2;
__device__ const unsigned char att_nsp_tab[32] = {1,1,1,1,1,1,1,1,1,1,1,1,1,1,1,1,1,2,2,2,2,2,2,2,2,2,2,2,2,2,2,2};
__device__ const unsigned char att_tab[32 * ATT_MAXI * 4] = {
    31,0,0,60, 17,0,0,4,
    30,0,0,56, 18,0,0,8,
    29,0,0,52, 19,0,0,12,
    28,0,0,48, 20,0,0,16,
    27,0,0,44, 21,0,0,20,
    26,0,0,40, 22,0,0,24,
    25,0,0,36, 23,0,0,28,
    24,0,0,32, 7,0,0,32,
    16,0,0,68, 255,0,0,0,
    14,0,0,60, 0,0,0,4,
    13,0,0,56, 1,0,0,8,
    12,0,0,52, 2,0,0,12,
    11,0,0,48, 3,0,0,16,
    10,0,0,44, 4,0,0,20,
    9,0,0,40, 5,0,0,24,
    8,0,0,36, 6,0,0,28,
    17,1,4,72, 255,0,0,0,
    18,1,8,76, 255,0,0,0,
    19,1,12,80, 255,0,0,0,
    20,1,16,84, 255,0,0,0,
    21,1,20,88, 255,0,0,0,
    22,1,24,92, 255,0,0,0,
    23,1,28,96, 255,0,0,0,
    24,1,32,100, 255,0,0,0,
    25,1,36,104, 255,0,0,0,
    26,1,40,108, 255,0,0,0,
    27,1,44,112, 255,0,0,0,
    28,1,48,116, 255,0,0,0,
    29,1,52,120, 255,0,0,0,
    30,1,56,124, 255,0,0,0,
    31,1,60,128, 255,0,0,0,
    15,0,0,64, 255,0,0,0,
};
__constant__ const unsigned att_tab32[32 * ATT_MAXI] = {0x3c00001fu, 0x04000011u, 0x3800001eu, 0x08000012u, 0x3400001du, 0x0c000013u, 0x3000001cu, 0x10000014u, 0x2c00001bu, 0x14000015u, 0x2800001au, 0x18000016u, 0x24000019u, 0x1c000017u, 0x20000018u, 0x20000007u, 0x44000010u, 0x000000ffu, 0x3c00000eu, 0x04000000u, 0x3800000du, 0x08000001u, 0x3400000cu, 0x0c000002u, 0x3000000bu, 0x10000003u, 0x2c00000au, 0x14000004u, 0x28000009u, 0x18000005u, 0x24000008u, 0x1c000006u, 0x48040111u, 0x000000ffu, 0x4c080112u, 0x000000ffu, 0x500c0113u, 0x000000ffu, 0x54100114u, 0x000000ffu, 0x58140115u, 0x000000ffu, 0x5c180116u, 0x000000ffu, 0x601c0117u, 0x000000ffu, 0x64200118u, 0x000000ffu, 0x68240119u, 0x000000ffu, 0x6c28011au, 0x000000ffu, 0x702c011bu, 0x000000ffu, 0x7430011cu, 0x000000ffu, 0x7834011du, 0x000000ffu, 0x7c38011eu, 0x000000ffu, 0x803c011fu, 0x000000ffu, 0x4000000fu, 0x000000ffu};
__constant__ const unsigned att_nsp32[32] = {1,1,1,1,1,1,1,1,1,1,1,1,1,1,1,1,1,2,2,2,2,2,2,2,2,2,2,2,2,2,2,2};
__device__ __forceinline__ int att_nsplit(int qb) { return ATT_SPLIT ? (int)att_nsp32[__builtin_amdgcn_readfirstlane(qb)] : 1; }
__device__ __forceinline__ void p4_combine(Frame& F) {
    const int gw = F.vcu * NWAVES + F.wave, NGW = F.G * NWAVES, lane = F.lane, h = lane >> 4, d0 = (lane & 15) * 8;
    const float2* ML = (const float2*)(F.a->ws + WS_ML);
    for (int m8 = gw * 8; m8 < M; m8 += NGW * 8)
    for (int m0 = m8; m0 < m8 + 8; m0 += 4) {
        const int b = m0 >> 13, s0 = m0 & (SEQ - 1), bh = b * NHEAD + h, nsp = att_nsplit(s0 >> 8);
        const size_t row0 = (size_t)bh * SEQ + s0;
        float li[4][4]; v4u ow[4][4];
#pragma unroll
        for (int r = 0; r < 4; ++r)
#pragma unroll
            for (int i = 0; i < 4; ++i) if (i < nsp) { li[r][i] = ML[(size_t)i * 8 * SEQ + row0 + r].y; ow[r][i] = *(const v4u*)(F.a->ws + opart_off(i) + ((row0 + r) * 128 + d0) * 2); }
#pragma unroll
        for (int r = 0; r < 4; ++r) {
            float a[8] = {0.f, 0.f, 0.f, 0.f, 0.f, 0.f, 0.f, 0.f}, wsum = 0.f;
#pragma unroll
            for (int i = 0; i < 4; ++i) if (i < nsp) { const float wgt = li[r][i]; wsum += wgt; const unsigned ww[4] = {ow[r][i].x, ow[r][i].y, ow[r][i].z, ow[r][i].w};
#pragma unroll
                for (int j = 0; j < 4; ++j) { a[2 * j] += wgt * bflo(ww[j]); a[2 * j + 1] += wgt * bfhi(ww[j]); } }
            const float rw = 1.0f / wsum; float ss = 0.f;
#pragma unroll
            for (int j = 0; j < 8; ++j) { a[j] *= rw; ss += a[j] * a[j]; }
            const float rA = __builtin_amdgcn_rsqf(wave_sum_dpp(ss) * (1.0f / 512.0f) + EPS);
#pragma unroll
            for (int j = 0; j < 8; ++j) a[j] *= rA;
            *(bf16x8*)(wsp(F, WS_MIX) + (size_t)(m0 + r) * DM + h * 128 + d0) = pk8(a);
        }
    }
}

struct AttnSchedPaired {
    int bh, idx;
    __device__ __forceinline__ bool get(int i, attn::Item& it) const {
        if (idx >= 16 || i >= 2) return false;
        it.bh = bh; it.qb = (i == 0) ? idx : 31 - idx; it.jlo = 0; it.jhi = 4 * (it.qb + 1); it.chunk = 0; return true;
    }
};
struct AttnSchedSplit {
    int bid, G;
    __device__ __forceinline__ bool get(int i, attn::Item& it) const {
        int cnt = 0;
        for (int slot = bid; slot < 256; slot += G)
#pragma unroll
            for (int j = 0; j < ATT_MAXI; ++j) {
#ifdef PROBE_SPREAD
                const unsigned e = att_tab32[(slot & 31) * ATT_MAXI + j]; const int bh = slot >> 5;
#else
                const unsigned e = att_tab32[(slot >> 3) * ATT_MAXI + j]; const int bh = slot & 7;
#endif
                if ((e & 255u) != 255u) { if (cnt == i) { it.bh = bh; it.qb = (int)(e & 255u); it.chunk = (int)((e >> 8) & 255u); it.jlo = (int)((e >> 16) & 255u); it.jhi = (int)(e >> 24); return true; } ++cnt; } }
        return false;
    }
};

__device__ __forceinline__ XcdBarrier mk_bar(const Frame& F) {
    XcdBarrier b; b.bar = (unsigned*)(F.a->ws + WS_CTL) + CW_BAR; b.x = xb_xcc_id(); b.st = (volatile LAS unsigned*)(F.lds + MISC_OFF) + 8; return b;
}
__device__ __forceinline__ void grid_bar(const Frame& F) { xcd_barrier(mk_bar(F)); }
__device__ __forceinline__ void group_bar(const Frame& F) {
    asm volatile("s_waitcnt vmcnt(0)" ::: "memory");
    __syncthreads();
    if (threadIdx.x == 0) {
        __builtin_amdgcn_s_waitcnt(0);
        unsigned* w = (unsigned*)(F.a->ws + WS_CTL) + CW_GB + 64 * ((int)blockIdx.x & 63);
        volatile LAS unsigned* st = (volatile LAS unsigned*)(F.lds + MISC_OFF) + 8;
        const unsigned same = st[3];
        if (same == 0u) { const unsigned o = __hip_atomic_fetch_or(w + 1, 1u << xb_xcc_id(), __ATOMIC_RELAXED, __HIP_MEMORY_SCOPE_AGENT); asm volatile("" :: "v"(o)); }
        if (same != 1u) { __builtin_amdgcn_fence(__ATOMIC_RELEASE, "agent"); asm volatile("s_waitcnt vmcnt(0)" ::: "memory"); }
        const unsigned old = xb_add(w, 1u), tgt = (old / 4u + 1u) * 4u;
        __builtin_amdgcn_fence(__ATOMIC_ACQUIRE, "agent");
        asm volatile("s_waitcnt vmcnt(0)" ::: "memory");
        XB_SPIN(xb_ld(w) < tgt, (unsigned*)(F.a->ws + WS_CTL) + CW_BAR);
        if (same == 0u) { const unsigned m = xb_ld(w + 1); st[3] = (m & (m - 1u)) == 0u ? 1u : 2u; }
    }
    __syncthreads();
}
#ifndef P2_XLOCAL
#define P2_XLOCAL 1
#endif
__global__ void __launch_bounds__(NWAVES * 64, 2) hybrid_fwd(Args args_) {
    extern __shared__ __attribute__((aligned(16))) unsigned char lds[];
    (void)args_;
    const CAS Args* ap0 = (const CAS Args*)__builtin_amdgcn_kernarg_segment_ptr();
    { const int tid = threadIdx.x;
      for (int u = tid; u < (LDS_BYTES - LDSCTL_OFF) / 4; u += NWAVES * 64) ((LAS unsigned*)((LAS unsigned char*)lds + LDSCTL_OFF))[u] = 0u;
      __syncthreads();
      if (N_LAUNCHES == 1) (void)xcd_barrier_post((unsigned*)(ap0->ws + WS_CTL) + CW_BAR, (volatile LAS unsigned*)((LAS unsigned char*)lds + MISC_OFF) + 8); }
    const int p_lo = ap0->ph_lo;
#ifdef PROBE_TWICE
    int twice_ = 0;
#endif
#ifdef PROBE_Q
    int rep_ = 0;
#endif
#pragma unroll 1
    for (int p = p_lo;; ++p) {
        const CAS Args* ap = ap0; asm volatile("" : "+s"(ap));
        if (p >= ap->ph_hi) break;
        Frame F; F.lds = (LAS unsigned char*)lds; F.a = ap;
        { int tid = threadIdx.x; asm volatile("" : "+v"(tid)); F.lane = tid & 63; F.wave = __builtin_amdgcn_readfirstlane(tid >> 6); }
        F.G = gridDim.x; { const int bx = blockIdx.x; F.vcu = (F.G % 8 == 0) ? (bx % 8) * (F.G / 8) + bx / 8 : bx; }
        const int l = (p - 1) / PH_PER_LAYER, q = (p == 0) ? -1 : (p - 1) % PH_PER_LAYER;
        bool split_done = false;
        unsigned char* wl = F.a->ws + WS_W + (size_t)l * LW;
        if (q == -1) p0_prologue(F);
        else if (q == 0) {
            pg8::Gemm g{wsp(F, WS_XB), (const bf16*)(wl + OW_IN), M, ZLD, DM}; pg8::StaticOrder S; S.init(M, ZLD, F.G, (int)blockIdx.x);
            pg8::EpiScaleBf16 E{wsp(F, WS_Z), ZLD, ssq_mix(F, l), 1.0f / DM, EPS};
            pg8::gemm_phase<pg8::EpiScaleBf16, pg8::StaticOrder, GEMM_ALIGN, GEMM_SP2>(F.lds + RING_OFF, g, S, E);
            if (SPLIT_BAR && N_LAUNCHES == 1 && p + 1 < F.a->ph_hi) { xcd_barrier_arrive(mk_bar(F)); split_done = true; }
            if (CONV_DEFER) {
                const int nwg = (M / 256) * (ZLD / 256), rem = nwg % F.G, c = (int)blockIdx.x;
                const int first = (l > 0 && CONV_TAIL) ? CI_SPLIT : 0, last = CONV_DOWN_LATE ? CI_OUT + 2 * CI_G : CI_SET1;
                if (rem == 0) conv_set(F, l, 1, c * NWAVES + F.wave, F.G * NWAVES, first, last); else if (c >= rem) conv_set(F, l, 1, (c - rem) * NWAVES + F.wave, (F.G - rem) * NWAVES, first, last);
            }
        } else if (q == 1) {
            const int pv = (P2_XLOCAL && F.G == 256) ? (((int)blockIdx.x >> 7) << 7) + 16 * ((int)blockIdx.x & 7) + (((int)blockIdx.x >> 3) & 15) : F.vcu;
#if defined(PROBE_SUB) && PROBE_SUB == 2
            if (rep_ == 0)
#endif
#ifdef PROBE_Q
            for (int u = F.vcu; u < M / CHUNK; u += F.G) p2_upproj_unit(F, l, u, rep_ == 1);
#elif defined(P2_INTERLEAVE)
            for (int v = F.vcu; v < 2 * (M / CHUNK); v += F.G) if (!(v & 1)) p2_upproj_unit(F, l, v >> 1);
#else
            for (int u = pv; u < M / CHUNK; u += F.G) p2_upproj_unit(F, l, u);
#endif
#if defined(PROBE_SUB) && PROBE_SUB == 1
            if (rep_ == 0)
#endif
#ifdef P2_INTERLEAVE
            for (int v = F.vcu; v < 2 * (M / CHUNK); v += F.G) if (v & 1) p2_sgu_pool_unit(F, l, v >> 1);
#else
            for (int u = pv + ((M / CHUNK - pv + F.G - 1) / F.G) * F.G; u < 2 * (M / CHUNK); u += F.G)
#ifdef PROBE_CUT
                p2_sgu_pool_unit(F, l, u - M / CHUNK, rep_ == 1 ? PROBE_CUT : 0);
#else
                p2_sgu_pool_unit(F, l, u - M / CHUNK);
#endif
#endif
        } else if (q == 2) {
            const float cshift = *(const float*)(wl + OW_END);
            const attn::Tensors AT{(const attn::bf16*)wsp(F, WS_Q), (const attn::bf16*)wsp(F, WS_K), (const attn::bf16*)wsp(F, WS_V), (attn::bf16*)(F.a->ws + opart_off(0)), (attn::bf16*)(F.a->ws + opart_off(2)), (float2*)(F.a->ws + WS_ML), cshift
#if defined(PROBE_RACY) || defined(PROBE_HALF)
                , rep_ == 0 ? 1 : 0
#endif
            };
#if ATT_SPLIT
            const AttnSchedSplit S{(int)blockIdx.x, F.G};
            attn::attn_phase<AttnSchedSplit>((char*)lds + RING_OFF, AT, S);
#else
            const AttnSchedPaired S{(int)(blockIdx.x & 7), (int)(blockIdx.x >> 3)};
            attn::attn_phase<AttnSchedPaired>((char*)lds + RING_OFF, AT, S);
#endif
        } else if (q == 3) p4_combine(F);
        else if (q == 5) {
            pg8::Gemm g{wsp(F, WS_XB), (const bf16*)(wl + OW_GU), M, FF2, DM}; pg8::StaticOrder S; S.init(M, FF2, F.G, (int)blockIdx.x);
            pg8::EpiSwiglu E{wsp(F, WS_H), FF, ssq_ffn(F, l), 1.0f / DM, EPS};
#ifdef PROBE_DRYEPI
            if (rep_ == 1) E.H = nullptr;
#endif
#ifdef PROBE_SAMETILE
            if (rep_ == 1) { E.H = nullptr; g.N = 0; }
#endif
#ifdef PROBE_NOMMA
            if (rep_ == 1) { E.H = nullptr; g.M = 0; }
#endif
            pg8::gemm_phase<pg8::EpiSwiglu, pg8::StaticOrder, GEMM_ALIGN, GEMM_SP2>(F.lds + RING_OFF, g, S, E);
            if (CONV_DEFER && CONV_DOWN_LATE) {
                const int nwg = (M / 256) * (FF2 / 256), rem = nwg % F.G, c = (int)blockIdx.x;
                if (rem != 0 && c >= rem) conv_set(F, l, 1, (c - rem) * NWAVES + F.wave, (F.G - rem) * NWAVES, CI_OUT + 2 * CI_G, CI_SET1);
                else if (rem == 0) conv_set(F, l, 1, c * NWAVES + F.wave, F.G * NWAVES, CI_OUT + 2 * CI_G, CI_SET1);
            }
            if (CONV_DEFER && CONV_TAIL && l + 1 < DEPTH) {
                const int nwg = (M / 256) * (FF2 / 256), rem = nwg % F.G, c = (int)blockIdx.x;
                if (rem != 0 && c >= rem) conv_set(F, l + 1, 1, (c - rem) * NWAVES + F.wave, (F.G - rem) * NWAVES, 0, CI_SPLIT);
                else if (rem == 0) conv_set(F, l + 1, 1, c * NWAVES + F.wave, F.G * NWAVES, 0, CI_SPLIT);
            }
        } else {
            const bool dn = q == 6, nx = l + 1 < DEPTH;
            pg8::Gemm g{dn ? wsp(F, WS_H) : wsp(F, WS_MIX), (const bf16*)(wl + (dn ? OW_DN : OW_OUT)), M, DM, dn ? FF : DM}; pg8::StaticOrder S; S.init(M, DM, F.G, (int)blockIdx.x);
            pg8::EpiResid E{wsp(F, WS_XB), (dn && !nx) ? F.a->out : nullptr, (dn && !nx) ? nullptr : wsp(F, WS_XB), dn ? (nx ? ssq_mix(F, l + 1) : nullptr) : ssq_ffn(F, l), DM};
#ifdef PROBE_Q
            if (q == PROBE_Q && rep_ == 0) { E.out = nullptr; E.xb = nullptr; if (E.ssq) E.ssq = (float*)(F.a->ws + 204 * MiB); }
#endif
            pg8::gemm_phase<pg8::EpiResid, pg8::StaticOrder, GEMM_ALIGN, GEMM_SP2>(F.lds + RING_OFF, g, S, E);
        }
        if (split_done) xcd_barrier_wait(mk_bar(F));
        else if (N_LAUNCHES == 1 && p + 1 < F.a->ph_hi) {
            if (GROUP_BAR && F.G == 256 && q >= 4) group_bar(F); else grid_bar(F);
        }
#ifdef PROBE_GBAR
        if (N_LAUNCHES == 1 && p + 1 < F.a->ph_hi && GROUP_BAR && F.G == 256 && q >= 4) { for (int xb_ = 0; xb_ < PROBE_GBAR; ++xb_) group_bar(F); }
#endif
#ifdef PROBE_XBAR
        if (N_LAUNCHES == 1 && p + 1 < F.a->ph_hi) { for (int xb_ = 0; xb_ < PROBE_XBAR; ++xb_) grid_bar(F); }
#endif
#ifdef PROBE_TWICE
        if (p + 1 == F.a->ph_hi && twice_ < PROBE_TWICE) { ++twice_; grid_bar(F); p = -1; }
#endif
#ifdef PROBE_Q
        if (q == PROBE_Q && rep_ == 0) { rep_ = 1; --p; } else rep_ = 0;
#endif
    }
}

extern "C" void kernel_launch(void* const* d_in, const int* in_sizes, int n_in, void* d_out, int out_size, void* d_ws, size_t ws_size, hipStream_t stream) {
    static int grid = 0;
    if (grid == 0) {
        if (n_in != 23 || in_sizes[0] != M * DM || out_size != M * DM || ws_size < WS_END) { fprintf(stderr, "kernel_launch: shape mismatch (n_in %d, in0 %d, out %d, ws %zu)\n", n_in, n_in > 0 ? in_sizes[0] : -1, out_size, ws_size); grid = -1; return; }
        int dev = 0, cus = 0, per_cu = 0;
        if (hipGetDevice(&dev) != hipSuccess || hipDeviceGetAttribute(&cus, hipDeviceAttributeMultiprocessorCount, dev) != hipSuccess) { fprintf(stderr, "kernel_launch: device query failed\n"); grid = -1; return; }
        if (hipFuncSetAttribute((const void*)hybrid_fwd, hipFuncAttributeMaxDynamicSharedMemorySize, LDS_BYTES) != hipSuccess) { fprintf(stderr, "kernel_launch: hipFuncSetAttribute failed\n"); grid = -1; return; }
        if (hipOccupancyMaxActiveBlocksPerMultiprocessor(&per_cu, (const void*)hybrid_fwd, NWAVES * 64, LDS_BYTES) != hipSuccess || per_cu < 1)
            fprintf(stderr, "kernel_launch: note: occupancy query reports %d workgroups per CU\n", per_cu);
        (void)hipGetLastError();
        grid = cus;
        if (grid != 256) fprintf(stderr, "kernel_launch: note: %d CUs (tuned for 256)\n", grid);
    }
    if (grid < 0) return;
    if (hipMemsetAsync((char*)d_ws + WS_CTL, 0, CTL_ZERO_BYTES, stream) != hipSuccess) { fprintf(stderr, "kernel_launch: hipMemsetAsync failed\n"); return; }
#ifdef PROBE_MEMSET2
    for (int i = 0; i < PROBE_MEMSET2; ++i) (void)hipMemsetAsync((char*)d_ws + WS_CTL, 0, CTL_ZERO_BYTES, stream);
#endif
    Args a{};
    for (int i = 0; i < 23; ++i) a.in[i] = (const float*)d_in[i];
    a.out = (float*)d_out; a.ws = (unsigned char*)d_ws;
#ifdef PROBE_PRO
    a.ph_lo = 0; a.ph_hi = 1; a.li = 0;
    hipLaunchKernelGGL(hybrid_fwd, dim3(grid), dim3(NWAVES * 64), LDS_BYTES, stream, a);
    (void)hipMemsetAsync((char*)d_ws + WS_CTL, 0, CTL_ZERO_BYTES, stream);
#endif
    for (int li = 0; li < N_LAUNCHES; ++li) {
        a.ph_lo = (N_LAUNCHES == 1) ? 0 : li; a.ph_hi = (N_LAUNCHES == 1) ? NPH : li + 1; a.li = li;
        hipLaunchKernelGGL(hybrid_fwd, dim3(grid), dim3(NWAVES * 64), LDS_BYTES, stream, a);
        const hipError_t le = hipPeekAtLastError();
        if (le != hipSuccess) { fprintf(stderr, "kernel_launch: launch %d failed: %s\n", li, hipGetErrorName(le)); break; }
    }
}
```

```cpp
#include <hip/hip_runtime.h>
#include <hip/hip_bf16.h>
#include <cstdio>
#include <cstdint>
#ifndef PG8_WGM
#define PG8_WGM 8
#endif

namespace pg8 {
#define PG8_LAS __attribute__((address_space(3)))
typedef unsigned short bf16_t;
typedef short bf16x8 __attribute__((ext_vector_type(8)));
typedef float f32x4 __attribute__((ext_vector_type(4)));
typedef unsigned u32x4 __attribute__((ext_vector_type(4)));
constexpr int BM = 256, BK = 64, HALF = 128, HTB = HALF * BK * 2  , STAGE_BYTES = 8 * HTB, NXCD = 8, WGM = PG8_WGM;

__host__ __device__ __forceinline__ int lds_byte(int r, int c) { const int st = (r >> 4) * 2 + (c >> 5), rr = r & 15, cc = c & 31, ob = rr * 64 + cc * 2; return st * 1024 + (ob ^ (((ob >> 9) & 1) << 5)); }
__host__ __device__ __forceinline__ void stage_rc(int b, int& R, int& C) { const int st = b / 1024, sb = b % 1024, swz = sb ^ (((sb >> 9) & 1) << 5); R = (st >> 1) * 16 + swz / 64; C = (st & 1) * 32 + (swz % 64) / 2; }
__host__ __device__ __forceinline__ int perm32(int rho) { const int n = rho >> 4, i = rho & 15; return 8 * (i >> 2) + 4 * n + (i & 3); }

struct Unit { int pm, pn; };
struct Gemm { const bf16_t* A; const bf16_t* Bt; int M, N, K; };

struct StaticOrder {
    int nM, nN, nwg, G, c;
    __host__ __device__ void init(int M, int N, int G_, int c_) { nM = M / BM; nN = N / BM; nwg = nM * nN; G = G_; c = c_; }
    __host__ __device__ bool next(int i, Unit& u) const {
        const long L = (long)i * G + c; if (L >= nwg) return false;
        int wgid = (int)L; { const int q = nwg / NXCD, r = nwg % NXCD, xcd = wgid % NXCD, off = wgid / NXCD; wgid = (xcd < r ? xcd * (q + 1) : r * (q + 1) + (xcd - r) * q) + off; }
        const int nig = WGM * nN, gid = wgid / nig, fm = gid * WGM, gsz = (nM - fm) < WGM ? (nM - fm) : WGM;
        u.pm = fm + ((wgid % nig) % gsz); u.pn = (wgid % nig) / gsz; return true;
    }
    __device__ __forceinline__ void a_ready(const Unit&) const {}
    __device__ __forceinline__ void done(const Unit&) const {}
};


__device__ __forceinline__ unsigned cvt_pk_bf16(float lo, float hi) { unsigned r; asm volatile("v_cvt_pk_bf16_f32 %0, %1, %2" : "=v"(r) : "v"(lo), "v"(hi)); return r; }
typedef float f32x2 __attribute__((ext_vector_type(2)));

typedef unsigned u32x2 __attribute__((ext_vector_type(2)));
#ifndef EPI_WT
#define EPI_WT 0
#endif
#ifndef RESID_FENCE
#define RESID_FENCE(m) ((m) & 1)
#endif
#ifndef EPI_PRE
#define EPI_PRE true
#endif
__device__ __forceinline__ void st16(void* p, u32x4 v) {
#if EPI_WT
    asm volatile("global_store_dwordx4 %0, %1, off sc1\n\ts_nop 1" :: "v"(p), "v"(v) : "memory");
#else
    *(u32x4*)p = v;
#endif
}
__device__ __forceinline__ void st16f(void* p, f32x4 v) { st16(p, __builtin_bit_cast(u32x4, v)); }
__device__ __forceinline__ void st8(void* p, u32x2 v) {
#if EPI_WT
    asm volatile("global_store_dwordx2 %0, %1, off sc1\n\ts_nop 1" :: "v"(p), "v"(v) : "memory");
#else
    *(u32x2*)p = v;
#endif
}
struct EpiScaleBf16 {
    static constexpr bool PERM = true, AFTER_DRAIN = false, PRE = EPI_PRE;
    bf16_t* O; int ldc; const float* ssq; float inv_n, eps;
    __device__ __forceinline__ void operator()(const f32x4 (&acc)[2][2][4][2], const Unit& u, int wr, int wc, int fr, int fq, const PG8_LAS float* ssl = nullptr) const {
        const int row0 = u.pm * BM + wr * 64 + fr, col0 = u.pn * BM + wc * 32 + 8 * fq;
        float rr[2][4];
#pragma unroll
        for (int ai = 0; ai < 2; ++ai)
#pragma unroll
            for (int m = 0; m < 4; ++m) rr[ai][m] = PRE ? ssl[wr * 64 + fr + ai * HALF + m * 16] : ssq[row0 + ai * HALF + m * 16];
#pragma unroll
        for (int ai = 0; ai < 2; ++ai)
#pragma unroll
            for (int m = 0; m < 4; ++m) { const int row = row0 + ai * HALF + m * 16; const float r = __builtin_amdgcn_rsqf(rr[ai][m] * inv_n + eps); bf16_t* rowp = O + (size_t)row * ldc + col0;
#pragma unroll
                for (int bj = 0; bj < 2; ++bj) { const f32x4 v0 = acc[ai][bj][m][0] * r, v1 = acc[ai][bj][m][1] * r;
                    u32x4 w; w.x = cvt_pk_bf16(v0[0], v0[1]); w.y = cvt_pk_bf16(v0[2], v0[3]); w.z = cvt_pk_bf16(v1[0], v1[1]); w.w = cvt_pk_bf16(v1[2], v1[3]);
                    st16(rowp + bj * HALF, w); } }
    }
};
struct EpiSwiglu {
    static constexpr bool PERM = true, AFTER_DRAIN = false, PRE = EPI_PRE;
    bf16_t* H; int ldh; const float* ssq; float inv_n, eps;
    __device__ __forceinline__ static float swi(float g, float u) { return g * __builtin_amdgcn_rcpf(1.0f + __builtin_amdgcn_exp2f(g * -1.4426950408889634f)) * u; }
    __device__ __forceinline__ void operator()(const f32x4 (&acc)[2][2][4][2], const Unit& u, int wr, int wc, int fr, int fq, const PG8_LAS float* ssl = nullptr) const {
        const int row0 = u.pm * BM + wr * 64 + fr, col0 = u.pn * HALF + wc * 32 + 8 * fq;
#ifdef PROBE_DRYEPI
        if (!H) { asm volatile("" :: "v"(acc[0][0][0][0]), "v"(acc[1][1][3][1])); return; }
#endif
        float rr[2][4];
#pragma unroll
        for (int ai = 0; ai < 2; ++ai)
#pragma unroll
            for (int m = 0; m < 4; ++m) rr[ai][m] = PRE ? ssl[wr * 64 + fr + ai * HALF + m * 16] : ssq[row0 + ai * HALF + m * 16];
#pragma unroll
        for (int ai = 0; ai < 2; ++ai)
#pragma unroll
            for (int m = 0; m < 4; ++m) { const int row = row0 + ai * HALF + m * 16; const float r = __builtin_amdgcn_rsqf(rr[ai][m] * inv_n + eps);
                const f32x4 g0 = acc[ai][0][m][0] * r, g1 = acc[ai][0][m][1] * r, u0 = acc[ai][1][m][0] * r, u1 = acc[ai][1][m][1] * r;
                u32x4 w; w.x = cvt_pk_bf16(swi(g0[0], u0[0]), swi(g0[1], u0[1])); w.y = cvt_pk_bf16(swi(g0[2], u0[2]), swi(g0[3], u0[3]));
                w.z = cvt_pk_bf16(swi(g1[0], u1[0]), swi(g1[1], u1[1])); w.w = cvt_pk_bf16(swi(g1[2], u1[2]), swi(g1[3], u1[3]));
                st16(H + (size_t)row * ldh + col0, w); }
    }
};
struct EpiResid {
    static constexpr bool PERM = true, AFTER_DRAIN = false, PRE = false;
    const bf16_t* base16; float* out; bf16_t* xb; float* ssq; int ldc;
    __device__ __forceinline__ void operator()(const f32x4 (&acc)[2][2][4][2], const Unit& u, int wr, int wc, int fr, int fq) const {
        const int row0 = u.pm * BM + wr * 64 + fr, col0 = u.pn * BM + wc * 32 + 8 * fq;
        u32x4 bwa[2][4][2];
#pragma unroll
        for (int ai = 0; ai < 2; ++ai)
#pragma unroll
            for (int m = 0; m < 4; ++m)
#pragma unroll
                for (int bj = 0; bj < 2; ++bj) bwa[ai][m][bj] = *(const u32x4*)(base16 + (size_t)(row0 + ai * HALF + m * 16) * ldc + col0 + bj * HALF);
        asm volatile("" ::: "memory");
#pragma unroll
        for (int ai = 0; ai < 2; ++ai) {
            const u32x4 (&bw)[4][2] = bwa[ai];
            float sk = 0.f;
#pragma unroll
            for (int m = 0; m < 4; ++m) { const int row = row0 + ai * HALF + m * 16; const size_t off = (size_t)row * ldc + col0; float s = 0.f;
#pragma unroll
                for (int bj = 0; bj < 2; ++bj) { const u32x4 w4 = bw[m][bj];
                    f32x4 o0 = (f32x4){__builtin_bit_cast(float, w4.x << 16), __builtin_bit_cast(float, w4.x & 0xffff0000u), __builtin_bit_cast(float, w4.y << 16), __builtin_bit_cast(float, w4.y & 0xffff0000u)};
                    f32x4 o1 = (f32x4){__builtin_bit_cast(float, w4.z << 16), __builtin_bit_cast(float, w4.z & 0xffff0000u), __builtin_bit_cast(float, w4.w << 16), __builtin_bit_cast(float, w4.w & 0xffff0000u)};
                    o0 = o0 + acc[ai][bj][m][0]; o1 = o1 + acc[ai][bj][m][1];
                    if (out) { __builtin_nontemporal_store(o0, (f32x4*)(out + off + bj * HALF)); __builtin_nontemporal_store(o1, (f32x4*)(out + off + bj * HALF + 4)); }
                    s += ((o0[0] * o0[0] + o0[1] * o0[1]) + (o0[2] * o0[2] + o0[3] * o0[3])) + ((o1[0] * o1[0] + o1[1] * o1[1]) + (o1[2] * o1[2] + o1[3] * o1[3]));
                    if (xb) { u32x4 w; w.x = cvt_pk_bf16(o0[0], o0[1]); w.y = cvt_pk_bf16(o0[2], o0[3]); w.z = cvt_pk_bf16(o1[0], o1[1]); w.w = cvt_pk_bf16(o1[2], o1[3]); *(u32x4*)(xb + off + bj * HALF) = w; } }
                if (ssq) { s += __shfl_xor(s, 16); s += __shfl_xor(s, 32); sk = (fq == m) ? s : sk; } }
            if (ssq) atomicAdd(ssq + row0 + ai * HALF + fq * 16, sk);
            asm volatile("" ::: "memory");
        }
    }
};


template <class Epi, class Sched, bool ALIGN_EPI = false, bool SP2 = false>
__device__ __forceinline__ void gemm_phase(PG8_LAS unsigned char* lds, const Gemm g, const Sched& S, const Epi& E) {
    int tid_ = threadIdx.x; asm volatile("" : "+v"(tid_));
    const int tid = tid_, wid = __builtin_amdgcn_readfirstlane(tid >> 6), lane = tid & 63, wr = wid >> 2, wc = wid & 3, fr = lane & 15, fq = lane >> 4;
    const int K = g.K, nt = K / BK;
    unsigned voffA[2], voffB[2];
#pragma unroll
    for (int i = 0; i < 2; ++i) { int R, C; stage_rc(tid * 16 + i * 8192, R, C); const int Rb = Epi::PERM ? ((R & ~31) + perm32(R & 31)) : R;
        voffA[i] = (unsigned)(R * K + C) * 2u; voffB[i] = (unsigned)(Rb * K + C) * 2u; }
    const size_t kstep = (size_t)(BK * 2);
    const size_t hstep = (size_t)HALF * K * 2;
    const size_t tstep = 2 * hstep;
    const unsigned ldsw = (unsigned)wid * 1024u;
    const int aoff = lds_byte(wr * 64 + fr, fq * 8), boff = lds_byte(wc * 32 + fr, fq * 8);
#define PG8_SA(b, h) (((b) * 2 + (h)) * HTB)
#define PG8_SB(b, h) ((4 + (b) * 2 + (h)) * HTB)
#define PG8_STAGE(bufoff, gbase, voff) do { _Pragma("unroll") for (int _i = 0; _i < 2; ++_i) \
        __builtin_amdgcn_global_load_lds((const unsigned*)((const char*)(gbase) + (voff)[_i]), (PG8_LAS unsigned*)(lds + (bufoff) + ldsw + _i * 8192), 16, 0, 0); } while (0)
#define PG8_LDA(dst, b, h) do { _Pragma("unroll") for (int m = 0; m < 4; ++m) _Pragma("unroll") for (int k = 0; k < 2; ++k) dst[m][k] = *(const PG8_LAS bf16x8*)(lds + PG8_SA(b, h) + aoff + m * 2048 + k * 1024); } while (0)
#define PG8_LDB(dst, b, h) do { _Pragma("unroll") for (int n = 0; n < 2; ++n) _Pragma("unroll") for (int k = 0; k < 2; ++k) dst[n][k] = *(const PG8_LAS bf16x8*)(lds + PG8_SB(b, h) + boff + n * 2048 + k * 1024); } while (0)
#ifdef PROBE_NOMMA
#define PG8_MMA_ON (g.M != 0)
#else
#define PG8_MMA_ON true
#endif
#define PG8_MMA(ai, bj, At, Bt) do { if (!PG8_MMA_ON) break; __builtin_amdgcn_s_setprio(1); _Pragma("unroll") for (int m = 0; m < 4; ++m) _Pragma("unroll") for (int n = 0; n < 2; ++n) _Pragma("unroll") for (int k = 0; k < 2; ++k) \
        acc[ai][bj][m][n] = __builtin_amdgcn_mfma_f32_16x16x32_bf16(Bt[n][k], At[m][k], acc[ai][bj][m][n], 0, 0, 0); __builtin_amdgcn_s_setprio(0); } while (0)
#define PG8_WAIT_V(n) asm volatile("s_waitcnt vmcnt(" #n ")" ::: "memory")
#define PG8_WAIT_L(n) asm volatile("s_waitcnt lgkmcnt(" #n ")" ::: "memory")
#define PG8_BAR __builtin_amdgcn_s_barrier()
#define PG8_SCHED __builtin_amdgcn_sched_barrier(0)
    PG8_LAS unsigned char* const ssl_base = lds + STAGE_BYTES;
#define PG8_PRE(u, i) do { if constexpr (Epi::PRE) __builtin_amdgcn_global_load_lds((const unsigned*)(E.ssq + (size_t)(u).pm * BM + (wid & 3) * 64 + lane), \
        (PG8_LAS unsigned*)(ssl_base + ((i) & 1) * 2048 + wid * 256), 4, 0, 0); } while (0)
    Unit cur, nxt; int ui = 0;
    if (!S.next(0, cur)) return;
    f32x4 acc[2][2][4][2];
#pragma unroll
    for (int a = 0; a < 2; ++a)
#pragma unroll
        for (int b = 0; b < 2; ++b)
#pragma unroll
            for (int m = 0; m < 4; ++m)
#pragma unroll
                for (int n = 0; n < 2; ++n) acc[a][b][m][n] = (f32x4){0.f, 0.f, 0.f, 0.f};
    bf16x8 At[4][2], B0[2][2], B1[2][2];
#ifdef PROBE_SAMETILE
    const size_t tsA = (g.N == 0) ? 0 : tstep, tsB = (g.N == 0) ? (PROBE_SAMETILE == 2 ? tstep : 0) : tstep;
#else
    const size_t tsA = tstep, tsB = tstep;
#endif
    const char* cA = (const char*)g.A + (size_t)cur.pm * tsA; const char* cB = (const char*)g.Bt + (size_t)cur.pn * tsB;
    S.a_ready(cur);
    PG8_PRE(cur, 0);
    if constexpr (SP2) {
        PG8_STAGE(PG8_SB(0, 0), cB, voffB); PG8_STAGE(PG8_SB(0, 1), cB + hstep, voffB); PG8_STAGE(PG8_SA(0, 0), cA, voffA); PG8_STAGE(PG8_SA(0, 1), cA + hstep, voffA);
        if (wr == 1) PG8_BAR;
        PG8_WAIT_V(2); PG8_BAR;
        PG8_STAGE(PG8_SB(1, 0), cB + kstep, voffB); PG8_STAGE(PG8_SA(1, 0), cA + kstep, voffA); PG8_STAGE(PG8_SB(1, 1), cB + hstep + kstep, voffB);
        PG8_WAIT_V(6); PG8_BAR;
    } else {
        PG8_STAGE(PG8_SB(0, 0), cB, voffB); PG8_STAGE(PG8_SA(0, 0), cA, voffA); PG8_STAGE(PG8_SB(0, 1), cB + hstep, voffB); PG8_STAGE(PG8_SA(0, 1), cA + hstep, voffA);
        if (wr == 1) PG8_BAR;
        PG8_WAIT_V(4); PG8_BAR;
        PG8_STAGE(PG8_SB(1, 0), cB + kstep, voffB); PG8_STAGE(PG8_SA(1, 0), cA + kstep, voffA); PG8_STAGE(PG8_SB(1, 1), cB + hstep + kstep, voffB);
        PG8_WAIT_V(6); PG8_BAR;
    }
    for (;;) {
        const bool has_next = S.next(ui + 1, nxt);
        const char* nA = has_next ? (const char*)g.A + (size_t)nxt.pm * tsA : cA; const char* nB = has_next ? (const char*)g.Bt + (size_t)nxt.pn * tsB : cB;
        for (int t = 0; t < nt; t += 2) {
            const bool last = (t == nt - 2);
            const char* a1 = cA + (size_t)(t + 1) * kstep;
            const char* a2 = last ? nA : cA + (size_t)(t + 2) * kstep; const char* b2 = last ? nB : cB + (size_t)(t + 2) * kstep;
            const char* a3 = a2 + kstep; const char* b3 = b2 + kstep;
            if (last && has_next) S.a_ready(nxt);
            if constexpr (SP2) {
            PG8_LDB(B0, 0, 0); PG8_LDB(B1, 0, 1); PG8_SCHED; PG8_LDA(At, 0, 0); PG8_STAGE(PG8_SA(1, 1), a1 + hstep, voffA);
            PG8_WAIT_V(8); PG8_WAIT_L(0); PG8_BAR; PG8_MMA(0, 0, At, B0); PG8_MMA(0, 1, At, B1); PG8_BAR; PG8_SCHED;
            PG8_LDA(At, 0, 1); PG8_STAGE(PG8_SB(0, 0), b2, voffB); PG8_STAGE(PG8_SB(0, 1), b2 + hstep, voffB); PG8_STAGE(PG8_SA(0, 0), a2, voffA);
            PG8_WAIT_V(8); PG8_WAIT_L(0); PG8_BAR; PG8_MMA(1, 0, At, B0); PG8_MMA(1, 1, At, B1); PG8_BAR; PG8_SCHED;
            PG8_LDB(B0, 1, 0); PG8_LDB(B1, 1, 1); PG8_SCHED; PG8_LDA(At, 1, 0); PG8_STAGE(PG8_SA(0, 1), a2 + hstep, voffA);
            PG8_WAIT_V(8); PG8_WAIT_L(0); PG8_BAR; PG8_MMA(0, 0, At, B0); PG8_MMA(0, 1, At, B1); PG8_BAR; PG8_SCHED;
            PG8_LDA(At, 1, 1); PG8_STAGE(PG8_SB(1, 0), b3, voffB); PG8_STAGE(PG8_SB(1, 1), b3 + hstep, voffB); PG8_STAGE(PG8_SA(1, 0), a3, voffA);
            PG8_WAIT_V(8); PG8_WAIT_L(0); PG8_BAR; PG8_MMA(1, 0, At, B0); PG8_MMA(1, 1, At, B1); PG8_BAR; PG8_SCHED;
            } else {
            PG8_LDB(B0, 0, 0); PG8_SCHED; PG8_LDA(At, 0, 0); PG8_STAGE(PG8_SA(1, 1), a1 + hstep, voffA);
            PG8_WAIT_L(8); PG8_BAR; PG8_WAIT_L(0); PG8_MMA(0, 0, At, B0); PG8_BAR; PG8_SCHED;
            PG8_LDB(B1, 0, 1); PG8_STAGE(PG8_SB(0, 0), b2, voffB);
            PG8_BAR; PG8_WAIT_L(0); PG8_MMA(0, 1, At, B1); PG8_BAR;
            PG8_LDA(At, 0, 1); PG8_STAGE(PG8_SA(0, 0), a2, voffA);
            PG8_BAR; PG8_WAIT_L(0); PG8_MMA(1, 0, At, B0); PG8_BAR; PG8_SCHED;
            PG8_STAGE(PG8_SB(0, 1), b2 + hstep, voffB);
            PG8_WAIT_V(6); PG8_BAR; PG8_MMA(1, 1, At, B1); PG8_BAR;
            PG8_LDB(B0, 1, 0); PG8_SCHED; PG8_LDA(At, 1, 0); PG8_STAGE(PG8_SA(0, 1), a2 + hstep, voffA);
            PG8_WAIT_L(8); PG8_BAR; PG8_WAIT_L(0); PG8_MMA(0, 0, At, B0); PG8_BAR; PG8_SCHED;
            PG8_LDB(B1, 1, 1); PG8_STAGE(PG8_SB(1, 0), b3, voffB);
            PG8_BAR; PG8_WAIT_L(0); PG8_MMA(0, 1, At, B1); PG8_BAR;
            PG8_LDA(At, 1, 1); PG8_STAGE(PG8_SA(1, 0), a3, voffA);
            PG8_BAR; PG8_WAIT_L(0); PG8_MMA(1, 0, At, B0); PG8_BAR; PG8_SCHED;
            PG8_STAGE(PG8_SB(1, 1), b3 + hstep, voffB);
            PG8_WAIT_V(6); PG8_BAR; PG8_MMA(1, 1, At, B1); PG8_BAR;
            }
        }
        if constexpr (ALIGN_EPI) { if (wr == 0) PG8_BAR; }
        if constexpr (Epi::PRE) { E(acc, cur, wr, wc, fr, fq, (const PG8_LAS float*)(ssl_base + (ui & 1) * 2048)); S.done(cur); }
        else if constexpr (!Epi::AFTER_DRAIN) { E(acc, cur, wr, wc, fr, fq); S.done(cur); }
        if (!has_next) break;
#pragma unroll
        for (int a = 0; a < 2; ++a)
#pragma unroll
            for (int b = 0; b < 2; ++b)
#pragma unroll
                for (int m = 0; m < 4; ++m)
#pragma unroll
                    for (int n = 0; n < 2; ++n) acc[a][b][m][n] = (f32x4){0.f, 0.f, 0.f, 0.f};
        cur = nxt; cA = nA; cB = nB; ++ui;
        PG8_PRE(cur, ui);
        if constexpr (ALIGN_EPI) { if (wr == 1) PG8_BAR; }
    }
    PG8_WAIT_V(0);
    if constexpr (!ALIGN_EPI) { if (wr == 0) PG8_BAR; }
    PG8_BAR;
    if constexpr (Epi::AFTER_DRAIN) { E.fused(acc, cur, wr, wc, fr, fq, lds, wid, lane); S.done(cur); }
#undef PG8_SA
#undef PG8_SB
#undef PG8_STAGE
#undef PG8_LDA
#undef PG8_LDB
#undef PG8_MMA
#undef PG8_WAIT_V
#undef PG8_WAIT_L
#undef PG8_BAR
#undef PG8_SCHED
#undef PG8_PRE
}
}

namespace attn {
constexpr int D = 128, NQD = 6;
constexpr float THR = 8.f;
#ifndef ATT_WSKIP
#define ATT_WSKIP false
#endif
constexpr bool WSKIP = ATT_WSKIP;
constexpr float SCALE = 0.10206207261596575f;
constexpr int NW = 8, QBLK = 32, KVBLK = 64, QB = NW * QBLK;
constexpr int SHM_V = KVBLK * D * 2, SHM_K = KVBLK * D * 2;
constexpr int LDS_BYTES = 2 * SHM_V + 2 * SHM_K + NW * 64 * 4;

using bf16 = __hip_bfloat16;
typedef short bf16x8 __attribute__((ext_vector_type(8)));
typedef short s16x4 __attribute__((ext_vector_type(4)));
typedef float f32x16 __attribute__((ext_vector_type(16)));
typedef float f32x4 __attribute__((ext_vector_type(4)));
typedef unsigned u32x4 __attribute__((ext_vector_type(4)));
template <class A, class Bt> struct same_t { static constexpr bool v = false; };
template <class A> struct same_t<A, A> { static constexpr bool v = true; };

#define KSWZ(row, colB) ((row) * 256 + ((colB) ^ (((row) & 7) << 4)))
#define SBAR() __builtin_amdgcn_sched_barrier(0)
__device__ __forceinline__ int v_st(int k, int c) { const int kk = (k & ~0xC) | ((k & 4) << 1) | ((k & 8) >> 1); return ((kk >> 3) * 4 + (c >> 5)) * 512 + ((kk & 7) * 32 + (c & 31)) * 2; }
__device__ __forceinline__ int v_rd_base(int lane) { return ((lane & 3) << 3) | (((lane >> 2) & 3) << 6) | (((lane >> 4) & 1) << 5) | (((lane >> 5) & 1) << 8); }
constexpr int v_rd_off(int d0, int ks, int half) { return d0 * 512 + ks * 4096 + half * 2048; }
__device__ __forceinline__ int crow(int r, int hi) { return (r & 3) + 8 * (r >> 2) + 4 * hi; }
__device__ __forceinline__ unsigned cvtpk(float lo, float hi) {
    unsigned r; asm volatile("v_cvt_pk_bf16_f32 %0, %1, %2" : "=v"(r) : "v"(lo), "v"(hi)); return r;
}
__device__ __forceinline__ bf16x8 pack8(f32x4 a, f32x4 b) {
    u32x4 w = {cvtpk(a[0], a[1]), cvtpk(a[2], a[3]), cvtpk(b[0], b[1]), cvtpk(b[2], b[3])};
    return *reinterpret_cast<bf16x8*>(&w);
}
template <class T> __device__ __forceinline__ bf16x8 load8(const T* p) {
    if constexpr (same_t<T, float>::v) { return pack8(*(const f32x4*)p, *(const f32x4*)(p + 4)); }
    else { return *reinterpret_cast<const bf16x8*>(p); }
}
__device__ __forceinline__ void mask_tile(f32x16& p0, f32x16& p1, int dq, unsigned W) {
    const float NEG = -__builtin_inff();
#pragma unroll
    for (int r = 0; r < 16; ++r) {
        const int c = (r & 3) + 8 * (r >> 2);
        if ((unsigned)(dq - c) >= W) p0[r] = NEG;
        if ((unsigned)(dq - c - 32) >= W) p1[r] = NEG;
    }
}
__device__ __forceinline__ void partialSM(f32x16& p0, f32x16& p1, float& m_reg, float& mn, float& alpha, float cshift) {
    (void)m_reg; mn = 0.f; alpha = 1.f;
    if (__builtin_expect(cshift != 0.f, 0)) { for (int r = 0; r < 16; ++r) { p0[r] -= cshift; p1[r] -= cshift; } }
    for (int r = 0; r < 16; ++r) p0[r] = __builtin_amdgcn_exp2f(p0[r]);
}
__device__ __forceinline__ void finishSM(f32x16& p0, f32x16& p1, float alpha, float& l_reg, bf16x8& pa0, bf16x8& pa1, bf16x8& pa2, bf16x8& pa3) {
    for (int r = 0; r < 16; ++r) p1[r] = __builtin_amdgcn_exp2f(p1[r]);
    float ps = 0; for (int r = 0; r < 16; ++r) ps += p0[r]; for (int r = 0; r < 16; ++r) ps += p1[r];
    { auto rr = __builtin_amdgcn_permlane32_swap(__float_as_uint(ps), __float_as_uint(ps), false, false);
      ps = __uint_as_float(rr[0]) + __uint_as_float(rr[1]); }
    l_reg += ps; (void)alpha;
#define PK4(P, B_, OUT) do { unsigned a0 = cvtpk(P[B_+0], P[B_+1]), a1 = cvtpk(P[B_+2], P[B_+3]);                          \
        unsigned b0 = cvtpk(P[B_+4], P[B_+5]), b1 = cvtpk(P[B_+6], P[B_+7]);                                             \
        auto r0 = __builtin_amdgcn_permlane32_swap(a0, b0, false, false); auto r1 = __builtin_amdgcn_permlane32_swap(a1, b1, false, false); \
        u32x4 w = {r0[0], r1[0], r0[1], r1[1]}; OUT = *reinterpret_cast<bf16x8*>(&w); } while (0)
    PK4(p0, 0, pa0); PK4(p0, 8, pa1); PK4(p1, 0, pa2); PK4(p1, 8, pa3);
#undef PK4
}
template <int KB, bool SK>
__device__ __forceinline__ void qkt(f32x16& p0, f32x16& p1, const char* K_lds, int r32, int hi, const bf16x8* qr, bool act) {
    if (SK && !act) { const float NEG = -__builtin_inff();
#pragma unroll
        for (int r = 0; r < 16; ++r) { p0[r] = NEG; p1[r] = NEG; } return; }
    p0 = f32x16{}; p1 = f32x16{};
    const char* kb[4];
#pragma unroll
    for (int dd = 0; dd < 4; ++dd) kb[dd] = K_lds + KB * SHM_K + KSWZ(r32, (dd * 16 + hi * 8) * 2);
#pragma unroll
    for (int d0 = 0; d0 < NQD; ++d0) { const char* a = kb[d0 & 3] + (d0 >> 2) * 128;
        bf16x8 b0 = *reinterpret_cast<const bf16x8*>(a);
        bf16x8 b1 = *reinterpret_cast<const bf16x8*>(a + 32 * 256);
        p0 = __builtin_amdgcn_mfma_f32_32x32x16_bf16(b0, qr[d0], p0, 0, 0, 0);
        p1 = __builtin_amdgcn_mfma_f32_32x32x16_bf16(b1, qr[d0], p1, 0, 0, 0); }
}
template <int VB, bool SK>
__device__ __forceinline__ void pv_tile(f32x16* o, int vb0, bf16x8 pa0, bf16x8 pa1, bf16x8 pa2, bf16x8 pa3, bool act) {
    if (SK && !act) return;
#define TRRD(dst, off) asm volatile("ds_read_b64_tr_b16 %0, %1 offset:%2" : "=&v"(dst) : "v"(vb0), "i"(off) : "memory")
#define PV_D0(d0) do { s16x4 l0, l1, l2, l3, h0, h1, h2, h3; constexpr int b_ = VB * SHM_V + v_rd_off(d0, 0, 0);     \
        TRRD(l0, b_); TRRD(h0, b_ + 2048); TRRD(l1, b_ + 4096); TRRD(h1, b_ + 6144); TRRD(l2, b_ + 8192); TRRD(h2, b_ + 10240); TRRD(l3, b_ + 12288); TRRD(h3, b_ + 14336); \
        asm volatile("s_waitcnt lgkmcnt(0)" ::: "memory"); SBAR();                 \
        o[d0] = __builtin_amdgcn_mfma_f32_32x32x16_bf16(pa0, (bf16x8){l0[0], l0[1], l0[2], l0[3], h0[0], h0[1], h0[2], h0[3]}, o[d0], 0, 0, 0);   \
        o[d0] = __builtin_amdgcn_mfma_f32_32x32x16_bf16(pa1, (bf16x8){l1[0], l1[1], l1[2], l1[3], h1[0], h1[1], h1[2], h1[3]}, o[d0], 0, 0, 0);   \
        o[d0] = __builtin_amdgcn_mfma_f32_32x32x16_bf16(pa2, (bf16x8){l2[0], l2[1], l2[2], l2[3], h2[0], h2[1], h2[2], h2[3]}, o[d0], 0, 0, 0);   \
        o[d0] = __builtin_amdgcn_mfma_f32_32x32x16_bf16(pa3, (bf16x8){l3[0], l3[1], l3[2], l3[3], h3[0], h3[1], h3[2], h3[3]}, o[d0], 0, 0, 0); } while (0)
    PV_D0(0); PV_D0(1); PV_D0(2); PV_D0(3);
#undef PV_D0
#undef TRRD
}

template <class TIn, class TOut> struct BlockRef { const TIn* Q; const TIn* K; const TIn* V; TOut* O; float2* ML; int P0; int jlo; int jhi; float cshift; };
template <class TIn> struct Seam {
    bf16x8 qr[NQD];
    bf16x8 st_v0, st_v1, st_k0, st_k1; f32x4 sf0, sf1, sf2, sf3;
    f32x4 tq[1];
};
__device__ __forceinline__ int swa_jlo(int P0, int W) { const int lowk = P0 - W + 1; return lowk > 0 ? lowk / KVBLK : 0; }
#define ROW(p, k0, rr) ((p) + (size_t)((k0) + (rr)) * D + sc)
#define VMW() asm volatile("s_waitcnt vmcnt(0)" ::: "memory")
#define VMWN(n) asm volatile("s_waitcnt vmcnt(%0)" :: "i"(n) : "memory")
#define SLOAD_H(Kp, Vp, k0) do { S.st_v0 = load8<TIn>(ROW(Vp, k0, sr)); S.st_v1 = load8<TIn>(ROW(Vp, k0, 32 + sr));              \
                         S.st_k0 = load8<TIn>(ROW(Kp, k0, sr)); S.st_k1 = load8<TIn>(ROW(Kp, k0, 32 + sr)); } while (0)
#define SWRITE_HK(bf) do { *(bf16x8*)(K_lds + (bf) * SHM_K + kws) = S.st_k0; *(bf16x8*)(K_lds + (bf) * SHM_K + kws + 32 * 256) = S.st_k1; } while (0)
#define SWRITE_HV(bf) do { *(bf16x8*)(V_lds + (bf) * SHM_V + vst0) = S.st_v0; *(bf16x8*)(V_lds + (bf) * SHM_V + vst1) = S.st_v1; } while (0)
#define SWRITE_H(bf) do { SWRITE_HV(bf); SWRITE_HK(bf); } while (0)
#define SLOAD_F(p, k0) do { S.sf0 = *(const f32x4*)ROW(p, k0, sr); S.sf1 = *(const f32x4*)(ROW(p, k0, sr) + 4);                \
                            S.sf2 = *(const f32x4*)ROW(p, k0, 32 + sr); S.sf3 = *(const f32x4*)(ROW(p, k0, 32 + sr) + 4); } while (0)
#define SWRITE_KF(bf) do { *(bf16x8*)(K_lds + (bf) * SHM_K + kws) = pack8(S.sf0, S.sf1); *(bf16x8*)(K_lds + (bf) * SHM_K + kws + 32 * 256) = pack8(S.sf2, S.sf3); } while (0)
#define SWRITE_VF(bf) do { *(bf16x8*)(V_lds + (bf) * SHM_V + vst0) = pack8(S.sf0, S.sf1); *(bf16x8*)(V_lds + (bf) * SHM_V + vst1) = pack8(S.sf2, S.sf3); } while (0)
template <class TIn, class TOut>
__device__ __forceinline__ void causal_swa_prime(const BlockRef<TIn, TOut>& cur, int W, char* lds, Seam<TIn>& S) {
    constexpr bool F32 = same_t<TIn, float>::v;
    int tid_ = threadIdx.x; asm volatile("" : "+v"(tid_));
    const int tid = tid_, wid = __builtin_amdgcn_readfirstlane(tid >> 6), lane = tid & 63, r32 = lane & 31, hi = lane >> 5;
    const int sr = tid >> 4, sc = (tid & 15) * 8, kws = KSWZ(sr, sc * 2); char* K_lds = lds + 2 * SHM_V;
    const int kb0 = cur.jlo * KVBLK;
    for (int d0 = 0; d0 < NQD; ++d0) S.qr[d0] = load8<TIn>(cur.Q + (size_t)(wid * QBLK + r32) * D + d0 * 16 + hi * 8);
    if constexpr (F32) { SLOAD_F((const float*)cur.K, kb0); VMW(); SWRITE_KF(0); SBAR(); SLOAD_F((const float*)cur.V, kb0); }
    else { SLOAD_H(cur.K, cur.V, kb0); VMW(); SWRITE_HK(0); }
    __syncthreads();
}
template <class TIn, class TOut>
__device__ __forceinline__ void causal_swa_block(const BlockRef<TIn, TOut>& cur, const BlockRef<TIn, TOut>& nxt, int skv, int W, char* lds, Seam<TIn>& S) {
    constexpr bool F32 = same_t<TIn, float>::v;
    int tid_ = threadIdx.x; asm volatile("" : "+v"(tid_));
    const int tid = tid_, wid = __builtin_amdgcn_readfirstlane(tid >> 6), lane = tid & 63, r32 = lane & 31, hi = lane >> 5;
    const int j_lo = cur.jlo; const int j_hi = cur.jhi; (void)skv;
    const int NT = j_hi - j_lo;
    const int kbn = nxt.jlo * KVBLK;
    const int qlo = cur.P0 + wid * QBLK, qm = qlo + r32 - 4 * hi;
    char* V_lds = lds; char* K_lds = lds + 2 * SHM_V;
    float* ws = (float*)(lds + 2 * SHM_V + 2 * SHM_K) + wid * 64; float* li_l = ws, * al_l = ws + 32;
    float m_reg = -1e30f, l_reg = 0; f32x16 o[4] = {};
    const int sr = tid >> 4, sc = (tid & 15) * 8, vst0 = v_st(sr, sc), vst1 = v_st(32 + sr, sc), kws = KSWZ(sr, sc * 2);
    const int vb0 = (int)(uintptr_t)V_lds + v_rd_base(lane);
    const TIn* Kh = cur.K; const TIn* Vh = cur.V;
#define RESC(a) do { (void)(a); (void)al_l; } while (0)
#define KBASE(t) ((j_lo + (t)) * KVBLK)
#define ACT(t) (KBASE(t) <= qlo + QBLK - 1 && KBASE(t) + KVBLK - 1 >= qlo - W + 1)
#define MASKT(P0_, P1_, t) do { const int kb_ = KBASE(t); if ((!SK || ACT(t)) && (kb_ + KVBLK - 1 > qlo || kb_ <= qlo + QBLK - 1 - W)) mask_tile(P0_, P1_, qm - kb_, (unsigned)W); } while (0)
    constexpr int NQL = F32 ? 16 : NQD;
    constexpr bool SK = WSKIP && !F32;
#define SEAM_K0() do { VMWN(NQL); if constexpr (F32) { SWRITE_KF(0); SBAR(); SLOAD_F((const float*)nxt.V, kbn); } else { SWRITE_HK(0); } SBAR(); } while (0)
    f32x16 pA0, pA1, pB0, pB1; float mnA, mnB, alA, alB; bf16x8 pa0, pa1, pa2, pa3;
    if constexpr (F32) { VMW(); SWRITE_VF(0); SBAR(); } else { SWRITE_HV(0); SBAR(); }
    if (NT > 1) { if constexpr (F32) SLOAD_F((const float*)Kh, KBASE(1)); else SLOAD_H(Kh, Vh, KBASE(1)); }
    SBAR(); qkt<0, SK>(pA0, pA1, K_lds, r32, hi, S.qr, ACT(0));
    if constexpr (F32) { if (NT > 1) { VMW(); SWRITE_KF(1); SBAR(); SLOAD_F((const float*)Vh, KBASE(1)); } }
    MASKT(pA0, pA1, 0); partialSM(pA0, pA1, m_reg, mnA, alA, cur.cshift);
    if (NT > 1) { VMW(); if constexpr (F32) { SWRITE_VF(1); SBAR(); if (NT > 2) SLOAD_F((const float*)Kh, KBASE(2)); } else SWRITE_H(1); }
    __syncthreads();
#define HALF_STEP(PX0, PX1, mnX, alX, PY0, PY1, alY, t, KB, VB, SB) do {                                                      \
        SBAR(); qkt<KB, SK>(PX0, PX1, K_lds, r32, hi, S.qr, ACT(t));                                             \
        finishSM(PY0, PY1, alY, l_reg, pa0, pa1, pa2, pa3); SBAR();                                                           \
        if ((t) + 1 < NT) { if constexpr (F32) { VMW(); SWRITE_KF(SB); SBAR(); SLOAD_F((const float*)Vh, KBASE((t) + 1)); }  \
                            else { SLOAD_H(Kh, Vh, KBASE((t) + 1)); } SBAR(); }                                               \
        pv_tile<VB, SK>(o, vb0, pa0, pa1, pa2, pa3, ACT((t) - 1)); MASKT(PX0, PX1, (t)); partialSM(PX0, PX1, m_reg, mnX, alX, cur.cshift);                                        \
        __syncthreads();                                                                                                      \
        if ((t) + 1 < NT) { VMW(); if constexpr (F32) { SWRITE_VF(SB); SBAR(); if ((t) + 2 < NT) SLOAD_F((const float*)Kh, KBASE((t) + 2)); } \
                            else { SWRITE_H(SB); } }                                                                          \
        RESC(alX); __syncthreads(); } while (0)
    for (int t = 1; t + 1 < NT; t += 2) {
        HALF_STEP(pB0, pB1, mnB, alB, pA0, pA1, alA, t, 1, 0, 0);
        HALF_STEP(pA0, pA1, mnA, alA, pB0, pB1, alB, t + 1, 0, 1, 1);
    }
    const bool even = (NT & 1) == 0;
    if (even) { SBAR(); qkt<1, SK>(pB0, pB1, K_lds, r32, hi, S.qr, ACT(NT - 1)); SBAR(); }
#define QROW(e) (nxt.Q + (size_t)(wid * QBLK + r32) * D + ((e) >> 1) * 16 + hi * 8 + ((e) & 1) * 4)
    if constexpr (F32) { SLOAD_F((const float*)nxt.K, kbn); SBAR();
#pragma unroll
        for (int e = 0; e < 8; ++e) S.tq[e] = *(const f32x4*)QROW(e); }
    else { SLOAD_H(nxt.K, nxt.V, kbn); SBAR();
#pragma unroll
        for (int d0 = 0; d0 < NQD; ++d0) S.qr[d0] = load8<TIn>(nxt.Q + (size_t)(wid * QBLK + r32) * D + d0 * 16 + hi * 8); }
    SBAR();
    finishSM(pA0, pA1, alA, l_reg, pa0, pa1, pa2, pa3); SBAR();
    if constexpr (F32) {
#pragma unroll
        for (int e = 8; e < 16; ++e) S.tq[e] = *(const f32x4*)QROW(e); SBAR(); }
#undef QROW
    pv_tile<0, SK>(o, vb0, pa0, pa1, pa2, pa3, ACT(even ? NT - 2 : NT - 1));
    if (even) { MASKT(pB0, pB1, NT - 1); partialSM(pB0, pB1, m_reg, mnB, alB, cur.cshift); __syncthreads(); RESC(alB);
        finishSM(pB0, pB1, alB, l_reg, pa0, pa1, pa2, pa3); SBAR(); pv_tile<1, SK>(o, vb0, pa0, pa1, pa2, pa3, ACT(NT - 1)); }
    SBAR(); SEAM_K0();
    if (hi == 0) { li_l[r32] = l_reg; cur.ML[wid * QBLK + r32] = make_float2(0.f, l_reg); } asm volatile("s_waitcnt lgkmcnt(0)" ::: "memory");
    float rli[16];
#pragma unroll
    for (int r = 0; r < 16; ++r) rli[r] = __builtin_amdgcn_rcpf(li_l[crow(r, hi)]);
    TOut* Ow = cur.O + (size_t)(wid * QBLK) * D;
#pragma unroll
    for (int r = 0; r < 16; ++r) { const int orow = crow(r, hi);
#pragma unroll
        for (int d0 = 0; d0 < 4; ++d0) { const float v = o[d0][r] * rli[r];
            if constexpr (same_t<TOut, float>::v) { Ow[(size_t)orow * D + d0 * 32 + r32] = v; }
            else { *(unsigned short*)(lds + LDS_BYTES + wid * 8704 + orow * 272 + (d0 * 32 + r32) * 2) = (unsigned short)(cvtpk(v, v) & 0xffffu); } } }
    if constexpr (!same_t<TOut, float>::v) {
#pragma unroll
        for (int i = 0; i < 8; ++i) { const int row = 4 * i + (lane >> 4), c16 = lane & 15;
            *(u32x4*)((char*)Ow + (size_t)row * (D * 2) + c16 * 16) = *(const u32x4*)(lds + LDS_BYTES + wid * 8704 + row * 272 + c16 * 16); } }
    if constexpr (F32) {
#pragma unroll
        for (int d0 = 0; d0 < NQD; ++d0) S.qr[d0] = pack8(S.tq[2 * d0], S.tq[2 * d0 + 1]); }
    if constexpr (!F32) {
#pragma unroll
        for (int d0 = 0; d0 < NQD; ++d0) asm volatile("" : "+v"(S.qr[d0]));
        asm volatile("" : "+v"(S.st_v0), "+v"(S.st_v1)); }
    __syncthreads();
#undef RESC
#undef KBASE
#undef ACT
#undef MASKT
#undef SEAM_K0
#undef HALF_STEP
}
#undef ROW
#undef VMW
#undef VMWN
#undef SLOAD_H
#undef SWRITE_HK
#undef SWRITE_HV
#undef SWRITE_H
#undef SLOAD_F
#undef SWRITE_KF
#undef SWRITE_VF

struct Item { int bh, qb, jlo, jhi, chunk; };
#ifdef PROBE_RACY
#endif
struct Tensors { const bf16* Q; const bf16* K; const bf16* V; bf16* O01; bf16* O23; float2* ML; float cshift;
#if defined(PROBE_RACY) || defined(PROBE_HALF)
    int racy;
#endif
};
constexpr int SEQ = 8192, NBH = 8;
__device__ __forceinline__ BlockRef<bf16, bf16> mkref(const Tensors& T, const Item& it) {
    BlockRef<bf16, bf16> r; const size_t row0 = (size_t)it.bh * SEQ + (size_t)it.qb * QB;
    r.Q = T.Q + row0 * D; r.K = T.K + (size_t)it.bh * SEQ * D; r.V = T.V + (size_t)it.bh * SEQ * D;
    r.O = (it.chunk < 2 ? T.O01 + (size_t)it.chunk * NBH * SEQ * D : T.O23 + (size_t)(it.chunk - 2) * NBH * SEQ * D) + row0 * D; r.ML = T.ML + (size_t)it.chunk * NBH * SEQ + row0; r.P0 = it.qb * QB; r.jlo = it.jlo; r.jhi = it.jhi; r.cshift = T.cshift;
#ifdef PROBE_RACY
    r.racy = T.racy;
#endif
#ifdef PROBE_HALF
#ifdef PROBE_ONE
    if (T.racy) r.jhi = r.jlo + PROBE_ONE;
#else
    if (T.racy) r.jhi = r.jlo + (r.jhi - r.jlo + 1) / 2;
#endif
#endif
    return r;
}
template <class Sched> __device__ __forceinline__ void attn_phase(char* lds, const Tensors& T, const Sched& S) {
    Item it, itn; if (!S.get(0, it)) return;
    BlockRef<bf16, bf16> cur = mkref(T, it);
    Seam<bf16> Sm;
    causal_swa_prime<bf16, bf16>(cur, 1 << 30, lds, Sm);
    for (int i = 0;; ++i) {
        const bool more = S.get(i + 1, itn);
        const BlockRef<bf16, bf16> nxt = more ? mkref(T, itn) : cur;
        causal_swa_block<bf16, bf16>(cur, nxt, SEQ, 1 << 30, lds, Sm);
        if (!more) break;
        cur = nxt;
    }
}
#undef KSWZ
#undef SBAR
}

constexpr int NWAVES = 8;
#ifndef MK_N_LAUNCHES
#define MK_N_LAUNCHES 1
#endif
#ifndef SPLIT_BAR
#define SPLIT_BAR 0
#endif
#ifndef GROUP_BAR
#define GROUP_BAR 1
#endif
#ifndef CONV_DOWN_LATE
#define CONV_DOWN_LATE (!GROUP_BAR)
#endif
#ifndef CONV_TAIL
#define CONV_TAIL 1
#endif
#ifndef GEMM_ALIGN
#define GEMM_ALIGN true
#endif
#ifndef GEMM_SP2
#define GEMM_SP2 true
#endif
constexpr int BATCH = 2, SEQ = 8192, DM = 1024, DEPTH = 2;
constexpr int M = BATCH * SEQ;
constexpr int Q_LORA = 256, KV_LORA = 128, QK_ROPE = 32, QK_NOPE = 64, QK_HEAD = 96, V_HEAD = 128, NHEAD = 4;
constexpr int SGU_W = 256, POOL_W = 256, CHUNK = 128;
constexpr int IN_W = 1184, ZLD = 1280;
constexpr int ZO_KV = 256, ZO_ROPE = 384, ZO_U = 416, ZO_V = 672, ZO_P = 928;
constexpr int FF = 2816, FF2 = 2 * FF;
constexpr float EPS = 1e-6f;
constexpr float QPRESCALE = 1.4426950408889634f * 0.10206207261596575f;
constexpr int PH_PER_LAYER = 7, NPH = 1 + DEPTH * PH_PER_LAYER;
constexpr int N_LAUNCHES = (MK_N_LAUNCHES == 1) ? 1 : NPH;

constexpr size_t MiB = 1u << 20;
constexpr size_t WS_CTL = 0, CTL_ZERO_BYTES = 64 * 1024 + (size_t)4 * 16384 * 4;
constexpr size_t WS_SSQ = 64 * 1024;
constexpr size_t WS_W = 2 * MiB, LW = 22 * MiB;
constexpr size_t OW_IN = 0, OW_Q = OW_IN + (size_t)ZLD * DM * 2, OW_KV = OW_Q + (size_t)384 * Q_LORA * 2, OW_OUT = OW_KV + (size_t)768 * KV_LORA * 2,
                 OW_GU = OW_OUT + (size_t)DM * DM * 2, OW_DN = OW_GU + (size_t)FF2 * DM * 2, OW_POOL = OW_DN + (size_t)DM * FF * 2, OW_SP = OW_POOL + (size_t)4 * 64 * 64 * 2, OW_END = OW_SP + (size_t)4 * CHUNK * CHUNK * 2;
static_assert(OW_END + 64 <= LW, "weight map");
constexpr size_t WS_CS = 46 * MiB;
constexpr size_t WS_XB = 48 * MiB;
constexpr size_t WS_Z = 80 * MiB;
constexpr size_t WS_MIX = 120 * MiB;
constexpr size_t WS_Q = 152 * MiB, WS_K = 168 * MiB, WS_V = 184 * MiB;
constexpr size_t WS_ML = 200 * MiB;
constexpr size_t WS_H = 152 * MiB;
constexpr size_t WS_END = 240 * MiB;
constexpr size_t OPART_BYTES = (size_t)8 * SEQ * 128 * 2;
constexpr size_t WS_OP01 = 202 * MiB;
static_assert(WS_W + DEPTH * LW <= WS_CS && WS_H + (size_t)M * FF * 2 <= WS_END && WS_END <= 256 * MiB && WS_Z + (size_t)M * ZLD * 2 <= WS_MIX && WS_Z + 2 * OPART_BYTES <= WS_MIX && WS_OP01 + 2 * OPART_BYTES <= 256 * MiB, "d_ws map");
__host__ __device__ constexpr size_t opart_off(int chunk) { return chunk < 2 ? WS_OP01 + (size_t)chunk * OPART_BYTES : WS_Z + (size_t)(chunk - 2) * OPART_BYTES; }
constexpr int CW_TMO = 0, CW_CODE = 1;
constexpr int CW_BAR = 4096;
constexpr int CW_GB = 8192;

constexpr int RING_OFF = 0, RING_BYTES = 163584;
constexpr int LDSCTL_OFF = RING_BYTES, MISC_OFF = LDSCTL_OFF;
constexpr int LDS_BYTES = 163840;
static_assert(MISC_OFF + 64 <= LDS_BYTES, "LDS map");

#define GAS __attribute__((address_space(1)))
#define LAS __attribute__((address_space(3)))
typedef unsigned short bf16;
typedef unsigned v4u __attribute__((ext_vector_type(4)));
typedef float f32x4 __attribute__((ext_vector_type(4)));
typedef short bf16x8 __attribute__((ext_vector_type(8)));
typedef GAS unsigned gu32;
typedef GAS unsigned long long gu64;
#define RLX_AGENT __ATOMIC_RELAXED, __HIP_MEMORY_SCOPE_AGENT
#define LDS_WAIT() asm volatile("s_waitcnt lgkmcnt(0)" ::: "memory")
#define VM_WAIT() asm volatile("s_waitcnt vmcnt(0)" ::: "memory")
__device__ __forceinline__ unsigned long long rt() { return __builtin_amdgcn_s_memrealtime(); }
__device__ __forceinline__ unsigned f2bf(float f) { unsigned u = __builtin_bit_cast(unsigned, f); return (u + 0x7fffu + ((u >> 16) & 1u)) >> 16; }
typedef float f32x2_t __attribute__((ext_vector_type(2))); typedef __bf16 bf16x2_t __attribute__((ext_vector_type(2)));
__device__ __forceinline__ unsigned pk2(float lo, float hi) { f32x2_t v = {lo, hi}; bf16x2_t b = __builtin_convertvector(v, bf16x2_t); return __builtin_bit_cast(unsigned, b); }

#ifndef XB_EARLY_INV
#define XB_EARLY_INV 1
#endif
#ifndef XB_EARLY_WB
#define XB_EARLY_WB 0
#endif
#ifndef XB_FLAT_RELEASE
#define XB_FLAT_RELEASE 1
#endif
#define XB_TMO      128
#define XB_XCNT(j)  (256  + 64 * (j))
#define XB_XSUB(j)  (1280 + 64 * (j))
#define XB_XGEN(j)  (2304 + 64 * (j))
#define XB_TOP      3328
#define XB_TOPGEN   3392
#define XCD_BAR_WORDS 3456
#define XB_SPIN_CAP (1u << 18)

__device__ __forceinline__ unsigned xb_ld(unsigned* p)              { return __hip_atomic_load(p, __ATOMIC_RELAXED, __HIP_MEMORY_SCOPE_AGENT); }
__device__ __forceinline__ unsigned xb_add(unsigned* p, unsigned v) { return __hip_atomic_fetch_add(p, v, __ATOMIC_RELAXED, __HIP_MEMORY_SCOPE_AGENT); }
__device__ __forceinline__ unsigned xb_xcc_id() { return (unsigned)__builtin_amdgcn_s_getreg((3 << 11) | 20) & 0xFu; }
#define XB_SPIN(cond, bar) do { unsigned _sp = 0; while (cond) { __builtin_amdgcn_s_sleep(1); \
    if ((++_sp & 255u) == 0u) { if (xb_ld(&(bar)[XB_TMO])) break; if (_sp > XB_SPIN_CAP) { atomicAdd(&(bar)[XB_TMO], 1u); break; } } } } while (0)

#define XB_WAIT2(ptr, NOTDONE, bar) do { unsigned* _p = (ptr); unsigned _v = xb_ld(_p); unsigned _a = _v; if (NOTDONE) { __builtin_amdgcn_s_sleep(4); unsigned _sp = 0; \
    for (;;) { const unsigned _b = xb_ld(_p); _v = _a; if (!(NOTDONE)) break; _a = xb_ld(_p); _v = _b; if (!(NOTDONE)) break; \
        if ((++_sp & 255u) == 0u) { if (xb_ld(&(bar)[XB_TMO])) break; if (_sp > XB_SPIN_CAP) { atomicAdd(&(bar)[XB_TMO], 1u); break; } } } } } while (0)

struct XcdBarrier {
    unsigned* bar; unsigned x;
    volatile LAS unsigned* st;
};

__device__ __forceinline__ XcdBarrier xcd_barrier_post(unsigned* bar, volatile LAS unsigned* st) {
    XcdBarrier b; b.bar = bar; b.x = xb_xcc_id(); b.st = st;
    if (threadIdx.x == 0) (void)xb_add(&bar[XB_XCNT(b.x)], 1u);
    return b;
}
__device__ __forceinline__ void xcd_barrier_complete(unsigned* bar, unsigned x, unsigned& nloc, unsigned& nx) {
    const unsigned G = gridDim.x * gridDim.y * gridDim.z;
    unsigned sum, cnt, mine, sp = 0u;
    for (;;) {
        sum = 0u; cnt = 0u; mine = 0u;
#pragma unroll
        for (unsigned j = 0; j < 16; ++j) { const unsigned c = xb_ld(&bar[XB_XCNT(j)]); sum += c; cnt += (c > 0u) ? 1u : 0u; mine = (j == x) ? c : mine; }
        if (sum == G) break;
        __builtin_amdgcn_s_sleep(1);
        if ((++sp & 255u) == 0u) { if (xb_ld(&bar[XB_TMO])) break; if (sp > XB_SPIN_CAP) { atomicAdd(&bar[XB_TMO], 1u); break; } }
    }
    nloc = mine > 0u ? mine : 1u; nx = cnt > 0u ? cnt : 1u;
}

__device__ __forceinline__ void xcd_barrier(const XcdBarrier& b) {
    asm volatile("s_waitcnt vmcnt(0)" ::: "memory");
    __syncthreads();
    if (threadIdx.x == 0) {
        unsigned* bar = b.bar;
        __builtin_amdgcn_s_waitcnt(0);
        unsigned nloc = b.st[0], nx = b.st[1];
        if (nloc == 0u) { xcd_barrier_complete(bar, b.x, nloc, nx); b.st[0] = nloc; b.st[1] = nx;
            const unsigned o_ = __hip_atomic_fetch_or(bar - CW_BAR + CW_GB + 64 * ((int)blockIdx.x & 63) + 1, 1u << b.x, __ATOMIC_RELAXED, __HIP_MEMORY_SCOPE_AGENT); asm volatile("" :: "v"(o_)); }
        const unsigned old = xb_add(&bar[XB_XSUB(b.x)], 1u);
        const unsigned gen = old / nloc;
        if (old + 1u == (gen + 1u) * nloc) {
            __builtin_amdgcn_fence(__ATOMIC_RELEASE, "agent");
            asm volatile("s_waitcnt vmcnt(0)" ::: "memory");
            const unsigned og = xb_add(&bar[XB_TOP], 1u);
            const unsigned tg = og / nx;
#if XB_EARLY_INV
            if (og + 1u == (tg + 1u) * nx) { xb_add(&bar[XB_TOPGEN], 1u);
                __builtin_amdgcn_fence(__ATOMIC_ACQUIRE, "agent"); }
            else { __builtin_amdgcn_fence(__ATOMIC_ACQUIRE, "agent");
                   XB_WAIT2(&bar[XB_TOPGEN], _v == tg, bar); }
#else
            if (og + 1u == (tg + 1u) * nx) xb_add(&bar[XB_TOPGEN], 1u);
            else XB_SPIN(xb_ld(&bar[XB_TOPGEN]) == tg, bar);
            __builtin_amdgcn_fence(__ATOMIC_ACQUIRE, "agent");
#endif
#if !(XB_EARLY_INV && XB_FLAT_RELEASE)
            xb_add(&bar[XB_XGEN(b.x)], 1u);
#endif
            asm volatile("s_waitcnt vmcnt(0)" ::: "memory");
        } else {
#if XB_EARLY_WB
            if (old == gen * nloc) { __builtin_amdgcn_fence(__ATOMIC_RELEASE, "agent"); asm volatile("s_waitcnt vmcnt(0)" ::: "memory"); }
#endif
#if XB_EARLY_INV
            __builtin_amdgcn_fence(__ATOMIC_ACQUIRE, "agent");
            asm volatile("s_waitcnt vmcnt(0)" ::: "memory");
#if XB_FLAT_RELEASE
            XB_WAIT2(&bar[XB_TOPGEN], _v == gen, bar);
#else
            XB_SPIN(xb_ld(&bar[XB_XGEN(b.x)]) == gen, bar);
#endif
#else
            XB_SPIN(xb_ld(&bar[XB_XGEN(b.x)]) == gen, bar);
            __builtin_amdgcn_fence(__ATOMIC_ACQUIRE, "agent");
            asm volatile("s_waitcnt vmcnt(0)" ::: "memory");
#endif
        }
    }
    __syncthreads();
}

__device__ __forceinline__ void xcd_barrier_arrive(const XcdBarrier& b) {
    asm volatile("s_waitcnt vmcnt(0)" ::: "memory");
    __syncthreads();
    if (threadIdx.x == 0) {
        unsigned* bar = b.bar;
        __builtin_amdgcn_s_waitcnt(0);
        const unsigned nloc = b.st[0], nx = b.st[1];
        const unsigned old = xb_add(&bar[XB_XSUB(b.x)], 1u);
        const unsigned gen = old / nloc;
        b.st[2] = gen;
        if (old + 1u == (gen + 1u) * nloc) {
            __builtin_amdgcn_fence(__ATOMIC_RELEASE, "agent");
            asm volatile("s_waitcnt vmcnt(0)" ::: "memory");
            const unsigned og = xb_add(&bar[XB_TOP], 1u);
            const unsigned tg = og / nx;
            if (og + 1u == (tg + 1u) * nx) xb_add(&bar[XB_TOPGEN], 1u);
        }
    }
    __syncthreads();
}
__device__ __forceinline__ void xcd_barrier_wait(const XcdBarrier& b) {
    asm volatile("s_waitcnt vmcnt(0)" ::: "memory");
    __syncthreads();
    if (threadIdx.x == 0) {
        const unsigned gen = b.st[2];
        __builtin_amdgcn_fence(__ATOMIC_ACQUIRE, "agent");
        asm volatile("s_waitcnt vmcnt(0)" ::: "memory");
        XB_SPIN(xb_ld(&b.bar[XB_TOPGEN]) == gen, b.bar);
    }
    __syncthreads();
}

typedef unsigned u32x2 __attribute__((ext_vector_type(2)));
#define CAS __attribute__((address_space(4)))
struct Args { const float* in[23]; float* out; unsigned char* ws; int ph_lo, ph_hi, li, pad; };
struct Frame {
    LAS unsigned char* lds;
    const CAS Args* a;
    int lane, wave;
    int vcu, G;
};
__device__ __forceinline__ float wave_sum(float v) {
#pragma unroll
    for (int o = 1; o < 64; o <<= 1) v += __shfl_xor(v, o);
    return v;
}
__device__ __forceinline__ float wave_sum_dpp(float v) {
#define WS_DPP(ctrl, rmask) v += __builtin_bit_cast(float, __builtin_amdgcn_update_dpp(0, __builtin_bit_cast(int, v), ctrl, rmask, 0xf, false))
    WS_DPP(0x111, 0xf); WS_DPP(0x112, 0xf); WS_DPP(0x114, 0xf); WS_DPP(0x118, 0xf); WS_DPP(0x142, 0xa); WS_DPP(0x143, 0xc);
#undef WS_DPP
    return __builtin_bit_cast(float, __builtin_amdgcn_readlane(__builtin_bit_cast(int, v), 63));
}
__device__ __forceinline__ float quad_sum(float v) { v += __shfl_xor(v, 16); v += __shfl_xor(v, 32); return v; }
__device__ __forceinline__ float bf2f(unsigned short h) { return __builtin_bit_cast(float, (unsigned)h << 16); }
__device__ __forceinline__ float bflo(unsigned w) { return __builtin_bit_cast(float, w << 16); }
__device__ __forceinline__ float bfhi(unsigned w) { return __builtin_bit_cast(float, w & 0xffff0000u); }
__device__ __forceinline__ f32x4 mfma16(bf16x8 a, bf16x8 b, f32x4 c) { return __builtin_amdgcn_mfma_f32_16x16x32_bf16(a, b, c, 0, 0, 0); }
__device__ __forceinline__ u32x2 pk4(f32x4 v) { u32x2 w; w.x = pk2(v[0], v[1]); w.y = pk2(v[2], v[3]); return w; }
__device__ __forceinline__ bf16x8 pk8(const float* v) { v4u w; w.x = pk2(v[0], v[1]); w.y = pk2(v[2], v[3]); w.z = pk2(v[4], v[5]); w.w = pk2(v[6], v[7]); return __builtin_bit_cast(bf16x8, w); }

#define IN_F(i) ((const float*)F.a->in[i])
__device__ __forceinline__ bf16* wsp(const Frame& F, size_t off) { return (bf16*)(F.a->ws + off); }
__device__ __forceinline__ float* ssq_mix(const Frame& F, int l) { return (float*)(F.a->ws + WS_SSQ) + (size_t)(2 * l) * M; }
__device__ __forceinline__ float* ssq_ffn(const Frame& F, int l) { return (float*)(F.a->ws + WS_SSQ) + (size_t)(2 * l + 1) * M; }

__device__ __forceinline__ void p0_tr_item64(const float* W, int ldw, int k0, int n0, int nv, const float* gain, bf16* WT, int ldt, int drow0, LAS float* scr, int lane) {
    const int c4 = 4 * (lane & 15), rr = lane >> 4;
    f32x4 v[16]; float gg[16];
#pragma unroll
    for (int i = 0; i < 16; ++i) gg[i] = gain ? gain[k0 + rr + 4 * i] : 1.0f;
#pragma unroll
    for (int i = 0; i < 16; ++i) { v[i] = (f32x4){0.f, 0.f, 0.f, 0.f}; if (c4 < nv) v[i] = __builtin_nontemporal_load((const GAS f32x4*)(W + (size_t)(k0 + rr + 4 * i) * ldw + n0 + c4)); }
#pragma unroll
    for (int i = 0; i < 16; ++i) { const int kk = rr + 4 * i; const float g = gg[i];
#pragma unroll
        for (int e = 0; e < 4; ++e) scr[kk * 65 + c4 + e] = v[i][e] * g; }
    LDS_WAIT(); asm volatile("" ::: "memory");
    const int c = lane & 7;
#pragma unroll
    for (int j = 0; j < 8; ++j) { const int n = (lane >> 3) + 8 * j; const LAS float* sp = scr + (8 * c) * 65 + n;
        if (n < nv) { v4u o; o.x = pk2(sp[0 * 65], sp[1 * 65]); o.y = pk2(sp[2 * 65], sp[3 * 65]); o.z = pk2(sp[4 * 65], sp[5 * 65]); o.w = pk2(sp[6 * 65], sp[7 * 65]);
            asm volatile("global_store_dwordx4 %0, %1, off sc1\n\ts_nop 1" :: "v"(WT + (size_t)(drow0 + n) * ldt + k0 + 8 * c), "v"(o) : "memory"); } }
    LDS_WAIT(); asm volatile("" ::: "memory");
}
constexpr int CI_IN = (DM / 64) * ((IN_W + 63) / 64), CI_Q = (Q_LORA / 64) * (384 / 64), CI_KV = (KV_LORA / 64) * (768 / 64), CI_SET0 = CI_IN + CI_Q + CI_KV;
constexpr int CI_OUT = (DM / 64) * (DM / 64), CI_G = (DM / 64) * (FF / 64), CI_DN = (FF / 64) * (DM / 64), CI_SET1 = CI_OUT + 2 * CI_G + CI_DN;
__device__ __forceinline__ void conv_item(Frame& F, int l, int set, int r, LAS float* scr, int lane) {
    unsigned char* wl = F.a->ws + WS_W + (size_t)l * LW;
    if (set == 0) {
        if (r < CI_IN) { const int nb = (IN_W + 63) / 64, kb = r / nb, n0 = 64 * (r % nb);
            p0_tr_item64(IN_F(3) + (size_t)l * DM * IN_W, IN_W, 64 * kb, n0, IN_W - n0 < 64 ? IN_W - n0 : 64, IN_F(2) + l * DM, (bf16*)(wl + OW_IN), DM, n0, scr, lane); return; } r -= CI_IN;
        if (r < CI_Q) { const int nb = 384 / 64, kb = r / nb, n0 = 64 * (r % nb);
            p0_tr_item64(IN_F(5) + (size_t)l * Q_LORA * 384, 384, 64 * kb, n0, 64, IN_F(4) + l * Q_LORA, (bf16*)(wl + OW_Q), Q_LORA, n0, scr, lane); return; } r -= CI_Q;
        { const int nb = 768 / 64, kb = r / nb, n0 = 64 * (r % nb);
            p0_tr_item64(IN_F(7) + (size_t)l * KV_LORA * 768, 768, 64 * kb, n0, 64, IN_F(6) + l * KV_LORA, (bf16*)(wl + OW_KV), KV_LORA, n0, scr, lane); return; }
    }
    if (r < CI_OUT) { const int nb = DM / 64, kb = r / nb, n0 = 64 * (r % nb), k0 = 64 * kb;
        const float* g = k0 < 512 ? IN_F(15) + l * 512 : k0 < 768 ? IN_F(16) + l * 256 - 512 : IN_F(17) + l * 256 - 768;
        p0_tr_item64(IN_F(18) + (size_t)l * DM * DM, DM, k0, n0, 64, g, (bf16*)(wl + OW_OUT), DM, n0, scr, lane); return; } r -= CI_OUT;
    if (r < 2 * CI_G) { const int up = r >= CI_G; if (up) r -= CI_G; const int nb = FF / 64, kb = r / nb, n0 = 64 * (r % nb);
        p0_tr_item64(IN_F(up ? 21 : 20) + (size_t)l * DM * FF, FF, 64 * kb, n0, 64, IN_F(19) + l * DM, (bf16*)(wl + OW_GU), DM, (n0 >> 7) * 256 + (n0 & 127) + (up ? 128 : 0), scr, lane); return; } r -= 2 * CI_G;
    { const int nb = DM / 64, kb = r / nb, n0 = 64 * (r % nb);
        p0_tr_item64(IN_F(22) + (size_t)l * FF * DM, DM, 64 * kb, n0, 64, nullptr, (bf16*)(wl + OW_DN), FF, n0, scr, lane); }
}
__device__ __forceinline__ void conv_set(Frame& F, int l, int set, int wk, int nwk, int first = 0, int last = 1 << 30) {
    LAS float* scr = (LAS float*)(F.lds + RING_OFF + F.wave * 16640);
    const int n = set == 0 ? CI_SET0 : CI_SET1, hi = last < n ? last : n;
    for (int it = first + wk; it < hi; it += nwk) conv_item(F, l, set, it, scr, F.lane);
}
#ifndef CI_SPLIT_N
#define CI_SPLIT_N 2368
#endif
constexpr int CI_SPLIT = CI_SPLIT_N;
#ifndef CONV_DEFER
#define CONV_DEFER 1
#endif
__device__ __forceinline__ void p0_prologue(Frame& F) {
    const int gw = F.vcu * NWAVES + F.wave, NGW = F.G * NWAVES, lane = F.lane;
    { const int wk0 = F.wave * F.G + F.vcu;
      for (int l = 0; l < DEPTH; ++l) { conv_set(F, l, 0, (wk0 + NGW - (l * CI_SET0) % NGW) % NGW, NGW); if (!CONV_DEFER) conv_set(F, l, 1, gw, NGW); } }
    { const int gt = gw * 64 + lane, NGT = NGW * 64;
        constexpr int NPAD = DEPTH * (ZLD - IN_W) * DM / 8, NPOOL = DEPTH * 4 * 64 * 64, NTRIL = DEPTH * 4 * CHUNK * CHUNK / 8, NROPE = M * 16;
        const int* pos = (const int*)IN_F(1);
        auto pad_body = [&](int i) { const int l = i / ((ZLD - IN_W) * DM / 8), e = i % ((ZLD - IN_W) * DM / 8);
            *(GAS v4u*)(F.a->ws + WS_W + (size_t)l * LW + OW_IN + (size_t)IN_W * DM * 2 + (size_t)e * 16) = (v4u){0u, 0u, 0u, 0u}; };
        auto pool_ld = [&](int i, float& w, float& sc) { const int l = i >> 14, g = (i >> 12) & 3, d = (i >> 6) & 63, c = i & 63; w = IN_F(13)[(size_t)l * 16384 + (g * 64 + c) * 64 + d]; sc = IN_F(14)[l * POOL_W + g * 64 + d]; };
        auto pool_body = [&](int i, float w, float sc) { const int l = i >> 14, g = (i >> 12) & 3, d = (i >> 6) & 63, c = i & 63;
            ((bf16*)(F.a->ws + WS_W + (size_t)l * LW + OW_POOL))[(g * 64 + d) * 64 + c] = (bf16)f2bf(w * sc); };
        auto tril_ld = [&](int i, f32x4& a, f32x4& b) { const int l = i >> 13, e = (i & 8191) * 8; const float* src = IN_F(11) + (size_t)l * 4 * CHUNK * CHUNK + e; a = *(const f32x4*)src; b = *(const f32x4*)(src + 4); };
        auto tril_body = [&](int i, f32x4 a, f32x4 b) { const int l = i >> 13, e = (i & 8191) * 8, t = (e >> 7) & 127, s0 = e & 127;
            float v[8] = {a[0], a[1], a[2], a[3], b[0], b[1], b[2], b[3]};
#pragma unroll
            for (int j = 0; j < 8; ++j) if (s0 + j > t) v[j] = 0.f;
            *(bf16x8*)(F.a->ws + WS_W + (size_t)l * LW + OW_SP + (size_t)e * 2) = pk8(v); };
        auto rope_body = [&](int i, int pv) { const int m = i >> 4, f = i & 15;
            const float inv = 1.0f / powf(10000.0f, (float)f * (1.0f / 16.0f));
            const float ang = (float)pv * inv;
            const double a = (double)ang, n = rint(a * 0.15915494309189535), y = a - n * 6.283185307179586;
            const float yf = (float)y; ((float*)(F.a->ws + WS_CS))[(size_t)m * 32 + f] = cosf(yf); ((float*)(F.a->ws + WS_CS))[(size_t)m * 32 + 16 + f] = sinf(yf); };
        { float pw = 0.f, psc = 0.f; f32x4 ta = {0.f, 0.f, 0.f, 0.f}, tb = ta; int pv0 = 0, pv1 = 0;
          if (gt < NPOOL) pool_ld(gt, pw, psc);
          if (gt < NTRIL) tril_ld(gt, ta, tb);
          if (gt < NROPE) pv0 = pos[gt >> 4];
          if (gt + NGT < NROPE) pv1 = pos[(gt + NGT) >> 4];
          if (gt < NPAD) pad_body(gt);
          if (gt < NPOOL) pool_body(gt, pw, psc);
          if (gt < NTRIL) tril_body(gt, ta, tb);
          if (gt < NROPE) rope_body(gt, pv0);
          if (gt + NGT < NROPE) rope_body(gt + NGT, pv1); }
        for (int i = gt + NGT; i < NPAD; i += NGT) pad_body(i);
        for (int i = gt + NGT; i < NPOOL; i += NGT) { float w, sc; pool_ld(i, w, sc); pool_body(i, w, sc); }
        for (int i = gt + NGT; i < NTRIL; i += NGT) { f32x4 a, b; tril_ld(i, a, b); tril_body(i, a, b); }
        for (int i = gt + 2 * NGT; i < NROPE; i += NGT) rope_body(i, pos[i >> 4]);
    }
    if (gw < DEPTH) { const int l = gw; float gqm = 0.f, gkm = 0.f; const float* gq = IN_F(8) + l * QK_HEAD; const float* gk = IN_F(9) + l * QK_HEAD;
        for (int i = lane; i < QK_HEAD; i += 64) { gqm = fmaxf(gqm, fabsf(gq[i])); gkm = fmaxf(gkm, fabsf(gk[i])); }
#pragma unroll
        for (int o = 1; o < 64; o <<= 1) { gqm = fmaxf(gqm, __shfl_xor(gqm, o)); gkm = fmaxf(gkm, __shfl_xor(gkm, o)); }
        if (lane == 0) *(float*)(F.a->ws + WS_W + (size_t)l * LW + OW_END) = fmaxf(0.f, 1.4426950408889634f * 9.797958971132712f * gqm * gkm - 64.0f); }
    float* ssq0 = ssq_mix(F, 0);
#ifdef PROBE_TWICE
    for (int i = gw * 64 + lane; i < 3 * M; i += NGW * 64) ssq0[M + i] = 0.f;
#endif
    static_assert(M % (64 * 256) == 0, "x pass: 64 rows per workgroup and round");
    for (int mb = F.vcu * 64; mb < M; mb += F.G * 64)
    for (int j = F.wave >= 3 ? F.wave - 3 : 13 + F.wave; j < (F.wave >= 3 ? 13 : 16); j += (F.wave >= 3 ? 5 : 16)) {
        const int m0 = mb + 4 * j;
        f32x4 v[4][4];
#pragma unroll
        for (int r = 0; r < 4; ++r) { const GAS f32x4* xr = (const GAS f32x4*)(IN_F(0) + (size_t)(m0 + r) * DM) + 2 * lane;
#pragma unroll
            for (int j = 0; j < 2; ++j) { v[r][2 * j] = __builtin_nontemporal_load(xr + 128 * j); v[r][2 * j + 1] = __builtin_nontemporal_load(xr + 128 * j + 1); } }
#pragma unroll
        for (int r = 0; r < 4; ++r) { float s = 0.f; GAS v4u* o16 = (GAS v4u*)(wsp(F, WS_XB) + (size_t)(m0 + r) * DM) + lane;
#pragma unroll
            for (int j = 0; j < 2; ++j) { const f32x4 x = v[r][2 * j], y = v[r][2 * j + 1];
                s += ((x.x * x.x + x.y * x.y) + (x.z * x.z + x.w * x.w)) + ((y.x * y.x + y.y * y.y) + (y.z * y.z + y.w * y.w));
                o16[64 * j] = (v4u){pk2(x.x, x.y), pk2(x.z, x.w), pk2(y.x, y.y), pk2(y.z, y.w)}; }
            s = wave_sum_dpp(s); if (lane == 0) ssq0[m0 + r] = s; }
    }
}

__device__ __forceinline__ void p2_upproj_unit(Frame& F, int l, int chunk, bool dry = false) {
    int lane_ = F.lane; asm volatile("" : "+v"(lane_));
    const int lane = lane_, tl = lane & 15, kq = lane >> 4;
    const int m0w = chunk * CHUNK + F.wave * 16, m = m0w + tl, b = m >> 13, s0w = m0w & (SEQ - 1);
    const bf16* zrow = wsp(F, WS_Z) + (size_t)m * ZLD;
    const unsigned char* wl = F.a->ws + WS_W + (size_t)l * LW;
    const bf16* Wq = (const bf16*)(wl + OW_Q); const bf16* Wkv = (const bf16*)(wl + OW_KV);
    LAS unsigned char* buf0 = F.lds + RING_OFF; LAS unsigned char* buf1 = F.lds + RING_OFF + 49152;
    LAS unsigned char* stg = F.lds + RING_OFF + 98304 + F.wave * 4352;
#define UP_DMAQ(h_) do { _Pragma("unroll") for (int i = 0; i < 6; ++i) { const int j = F.wave * 6 + i, row = 2 * j + (lane >> 5), slot = lane & 31; \
        __builtin_amdgcn_global_load_lds((const unsigned*)((const unsigned char*)Wq + (size_t)((h_) * QK_HEAD + row) * (Q_LORA * 2) + ((slot ^ (row & 15)) * 16)), (LAS unsigned*)(buf0 + j * 1024), 16, 0, 0); } } while (0)
#define UP_DMAKV(h_) do { _Pragma("unroll") for (int i = 0; i < 6; ++i) { const int j = F.wave * 6 + i, row = 4 * j + (lane >> 4), slot = lane & 15; \
        __builtin_amdgcn_global_load_lds((const unsigned*)((const unsigned char*)Wkv + (size_t)((h_) * 192 + row) * (KV_LORA * 2) + ((slot ^ (row & 15)) * 16)), (LAS unsigned*)(buf1 + j * 1024), 16, 0, 0); } } while (0)
    UP_DMAQ(0);
    bf16x8 zq[8], zkv[4];
#pragma unroll
    for (int ks = 0; ks < 8; ++ks) zq[ks] = *(const bf16x8*)(zrow + ks * 32 + kq * 8);
#pragma unroll
    for (int ks = 0; ks < 4; ++ks) zkv[ks] = *(const bf16x8*)(zrow + ZO_KV + ks * 32 + kq * 8);
    const u32x2 kw0 = *(const u32x2*)(zrow + ZO_ROPE + 4 * kq), kw1 = *(const u32x2*)(zrow + ZO_ROPE + 16 + 4 * kq);
    const float* csr = (const float*)(F.a->ws + WS_CS) + (size_t)m * 32;
    const f32x4 cs = *(const f32x4*)(csr + 4 * kq), sn = *(const f32x4*)(csr + 16 + 4 * kq);
    const float* gq = IN_F(8) + l * QK_HEAD; const float* gk = IN_F(9) + l * QK_HEAD;
    LAS float* gtab = (LAS float*)(F.lds + RING_OFF + 98304 + 8 * 4352);
    if (F.wave == 0) { for (int i = lane; i < 2 * QK_HEAD; i += 64) gtab[i] = i < QK_HEAD ? gq[i] : gk[i - QK_HEAD]; }
#define gqv(nb_) (*(const LAS f32x4*)(gtab + (nb_) * 16 + 4 * kq))
#define gkv(nb_) (*(const LAS f32x4*)(gtab + QK_HEAD + (nb_) * 16 + 4 * kq))
    float sq = 0.f, skv = 0.f;
#pragma unroll
    for (int ks = 0; ks < 8; ++ks)
#pragma unroll
        for (int j = 0; j < 8; ++j) { const float v = bf2f((unsigned short)zq[ks][j]); sq += v * v; }
#pragma unroll
    for (int ks = 0; ks < 4; ++ks)
#pragma unroll
        for (int j = 0; j < 8; ++j) { const float v = bf2f((unsigned short)zkv[ks][j]); skv += v * v; }
    const float r_q = __builtin_amdgcn_rsqf(quad_sum(sq) * (1.0f / Q_LORA) + EPS), r_kv = __builtin_amdgcn_rsqf(quad_sum(skv) * (1.0f / KV_LORA) + EPS);
    const f32x4 kr0 = {bflo(kw0.x), bfhi(kw0.x), bflo(kw0.y), bfhi(kw0.y)}, kr1 = {bflo(kw1.x), bfhi(kw1.x), bflo(kw1.y), bfhi(kw1.y)};
    float skr = (kr0[0] * kr0[0] + kr0[1] * kr0[1]) + (kr0[2] * kr0[2] + kr0[3] * kr0[3]) + (kr1[0] * kr1[0] + kr1[1] * kr1[1]) + (kr1[2] * kr1[2] + kr1[3] * kr1[3]);
    skr = quad_sum(skr);
#define UP_RD(dst_, ad_, OFF_) asm volatile("ds_read_b128 %0, %1 offset:%2" : "=v"(dst_) : "v"(ad_), "i"(OFF_) : "memory")
    const unsigned qbase = (unsigned)(uintptr_t)buf0 + tl * 512, kbase = (unsigned)(uintptr_t)buf1 + tl * 256;
#define UP_RDQ(d_, ks_) do { const unsigned ad_ = qbase + ((((ks_) * 4 + kq) ^ tl) << 4); UP_RD(d_[0], ad_, 0); UP_RD(d_[1], ad_, 8192); UP_RD(d_[2], ad_, 16384); UP_RD(d_[3], ad_, 24576); UP_RD(d_[4], ad_, 32768); UP_RD(d_[5], ad_, 40960); } while (0)
#define UP_RDKV(d_, ks_) do { const unsigned ad_ = kbase + ((((ks_) * 4 + kq) ^ tl) << 4); UP_RD(d_[0], ad_, 0); UP_RD(d_[1], ad_, 4096); UP_RD(d_[2], ad_, 8192); UP_RD(d_[3], ad_, 12288); UP_RD(d_[4], ad_, 16384); UP_RD(d_[5], ad_, 20480); \
        UP_RD(d_[6], ad_, 24576); UP_RD(d_[7], ad_, 28672); UP_RD(d_[8], ad_, 32768); UP_RD(d_[9], ad_, 36864); UP_RD(d_[10], ad_, 40960); UP_RD(d_[11], ad_, 45056); } while (0)
#define UP_PUT(nb_, v_) (*(LAS u32x2*)(stg + tl * 272 + (nb_) * 32 + kq * 8) = pk4(v_))
#ifdef PROBE_DRYSTORE
#define UP_DRY dry
#else
#define UP_DRY false
#endif
#define UP_FLUSH(dst_) do { if (!UP_DRY) { unsigned char* d_ = (unsigned char*)(dst_) + (size_t)(lane >> 4) * 256 + (lane & 15) * 16; _Pragma("unroll") for (int i = 0; i < 4; ++i) \
        *(GAS v4u*)(d_ + i * 1024) = *(const LAS v4u*)(stg + (4 * i + (lane >> 4)) * 272 + (lane & 15) * 16); } } while (0)
    __syncthreads();
#pragma unroll 1
    for (int h = 0; h < NHEAD; ++h) {
        const size_t orow0 = ((size_t)(b * NHEAD + h) * SEQ + s0w) * 128;
#ifdef PROBE_NODMA
        if (!dry)
#endif
        UP_DMAKV(h); asm volatile("" ::: "memory");
        {
            f32x4 acc[6];
#pragma unroll
            for (int nb = 0; nb < 6; ++nb) acc[nb] = (f32x4){0.f, 0.f, 0.f, 0.f};
            {
                bf16x8 fa[6], fb[6];
                UP_RDQ(fa, 0);
#define UP_QSTEP(cur_, nxt_, ks_) do { asm volatile("s_waitcnt lgkmcnt(0)" ::: "memory"); __builtin_amdgcn_sched_barrier(0); if ((ks_) + 1 < 8) UP_RDQ(nxt_, (ks_) + 1); \
                    _Pragma("unroll") for (int nb = 0; nb < 6; ++nb) acc[nb] = mfma16(cur_[nb], zq[ks_], acc[nb]); __builtin_amdgcn_sched_barrier(0); } while (0)
                UP_QSTEP(fa, fb, 0); UP_QSTEP(fb, fa, 1); UP_QSTEP(fa, fb, 2); UP_QSTEP(fb, fa, 3); UP_QSTEP(fa, fb, 4); UP_QSTEP(fb, fa, 5); UP_QSTEP(fa, fb, 6); UP_QSTEP(fb, fa, 7);
#undef UP_QSTEP
            }
            float ss = 0.f;
#pragma unroll
            for (int nb = 0; nb < 6; ++nb) { acc[nb] = acc[nb] * r_q; ss += (acc[nb][0] * acc[nb][0] + acc[nb][1] * acc[nb][1]) + (acc[nb][2] * acc[nb][2] + acc[nb][3] * acc[nb][3]); }
            const float rh = __builtin_amdgcn_rsqf(quad_sum(ss) * (1.0f / QK_HEAD) + EPS);
#pragma unroll
            for (int nb = 0; nb < 6; ++nb) acc[nb] = acc[nb] * (rh * QPRESCALE) * gqv(nb);
            const f32x4 x1 = acc[4], x2 = acc[5]; acc[4] = x1 * cs - x2 * sn; acc[5] = x2 * cs + x1 * sn;
#pragma unroll
            for (int nb = 0; nb < 6; ++nb) UP_PUT(nb, acc[nb]);
            UP_PUT(6, ((f32x4){0.f, 0.f, 0.f, 0.f})); UP_PUT(7, ((f32x4){0.f, 0.f, 0.f, 0.f}));
            UP_FLUSH(wsp(F, WS_Q) + orow0);
        }
        asm volatile("s_waitcnt vmcnt(4) lgkmcnt(0)" ::: "memory"); __builtin_amdgcn_s_barrier(); asm volatile("" ::: "memory");
#ifdef PROBE_NODMA
        if (!dry)
#endif
        if (h + 1 < NHEAD) UP_DMAQ(h + 1);
        asm volatile("" ::: "memory");
        {
            f32x4 acc[12];
#pragma unroll
            for (int nb = 0; nb < 12; ++nb) acc[nb] = (f32x4){0.f, 0.f, 0.f, 0.f};
            {
                bf16x8 fa[12], fb[12];
                UP_RDKV(fa, 0);
#define UP_KSTEP(cur_, nxt_, ks_) do { asm volatile("s_waitcnt lgkmcnt(0)" ::: "memory"); __builtin_amdgcn_sched_barrier(0); if ((ks_) + 1 < 4) UP_RDKV(nxt_, (ks_) + 1); \
                    _Pragma("unroll") for (int nb = 0; nb < 12; ++nb) acc[nb] = mfma16(cur_[nb], zkv[ks_], acc[nb]); __builtin_amdgcn_sched_barrier(0); } while (0)
                UP_KSTEP(fa, fb, 0); UP_KSTEP(fb, fa, 1); UP_KSTEP(fa, fb, 2); UP_KSTEP(fb, fa, 3);
#undef UP_KSTEP
            }
            float ss = 0.f;
#pragma unroll
            for (int nb = 0; nb < 4; ++nb) { acc[nb] = acc[nb] * r_kv; ss += (acc[nb][0] * acc[nb][0] + acc[nb][1] * acc[nb][1]) + (acc[nb][2] * acc[nb][2] + acc[nb][3] * acc[nb][3]); }
            const float rh = __builtin_amdgcn_rsqf((quad_sum(ss) + skr) * (1.0f / QK_HEAD) + EPS);
#pragma unroll
            for (int nb = 0; nb < 4; ++nb) UP_PUT(nb, acc[nb] * rh * gkv(nb));
            const f32x4 x1 = kr0 * rh * gkv(4), x2 = kr1 * rh * gkv(5);
            UP_PUT(4, x1 * cs - x2 * sn); UP_PUT(5, x2 * cs + x1 * sn);
            UP_PUT(6, ((f32x4){0.f, 0.f, 0.f, 0.f})); UP_PUT(7, ((f32x4){0.f, 0.f, 0.f, 0.f}));
            UP_FLUSH(wsp(F, WS_K) + orow0);
#pragma unroll
            for (int nb = 0; nb < 8; ++nb) UP_PUT(nb, acc[4 + nb] * r_kv);
            UP_FLUSH(wsp(F, WS_V) + orow0);
        }
        asm volatile("s_waitcnt vmcnt(8) lgkmcnt(0)" ::: "memory"); __builtin_amdgcn_s_barrier(); asm volatile("" ::: "memory");
    }
#undef gqv
#undef gkv
#undef UP_DMAQ
#undef UP_DMAKV
#undef UP_PUT
#undef UP_RD
#undef UP_RDQ
#undef UP_RDKV
#undef UP_FLUSH
}

constexpr int VS = 136;
__device__ __forceinline__ void p2_sgu_pool_unit(Frame& F, int l, int chunk, int cut = 0) {
    int lane_ = F.lane; asm volatile("" : "+v"(lane_));
    const int lane = lane_, tl = lane & 15, kq = lane >> 4, w = F.wave;
    LAS bf16* vnT = (LAS bf16*)(F.lds + RING_OFF);
    LAS unsigned char* pt = F.lds + RING_OFF + 69632;
    LAS unsigned char* stg = F.lds + RING_OFF + 145152 + w * 2304;
    const bf16* Z = wsp(F, WS_Z);
    const unsigned char* wl = F.a->ws + WS_W + (size_t)l * LW;
    const int t = w * 16 + tl, m = chunk * CHUNK + t, s = m & (SEQ - 1);
    const bf16* zrow = Z + (size_t)m * ZLD;
    v4u pv[9];
    { const int tid = w * 64 + lane, m0 = chunk * CHUNK, s0 = m0 & (SEQ - 1);
#pragma unroll
      for (int i = 0; i < 9; ++i) { const int c = tid + 512 * i, r = c >> 5, k = c & 31; pv[i] = (v4u){0u, 0u, 0u, 0u};
          if (c < 143 * 32 && s0 + r >= 15) pv[i] = *(const GAS v4u*)(Z + (size_t)(m0 - 15 + r) * ZLD + ZO_P + k * 8); } }
    u32x2 vws[16];
#pragma unroll
    for (int i = 0; i < 16; ++i) vws[i] = *(const u32x2*)(Z + (size_t)(chunk * CHUNK + w * 16 + i) * ZLD + ZO_V + 4 * lane);
    const f32x4 gv = *(const f32x4*)(IN_F(10) + l * SGU_W + 4 * lane);
    bf16x8 bfr[4][4];
#pragma unroll
    for (int ks = 0; ks < 4; ++ks)
#pragma unroll
        for (int h = 0; h < 4; ++h) bfr[ks][h] = *(const bf16x8*)(wl + OW_SP + ((size_t)(h * CHUNK + t) * CHUNK + ks * 32 + kq * 8) * 2);
    { float vv[4][16];
#pragma unroll
      for (int i = 0; i < 16; ++i) { const f32x4 v = {bflo(vws[i].x), bfhi(vws[i].x), bflo(vws[i].y), bfhi(vws[i].y)};
          const float r = __builtin_amdgcn_rsqf(wave_sum_dpp((v[0] * v[0] + v[1] * v[1]) + (v[2] * v[2] + v[3] * v[3])) * (1.0f / SGU_W) + EPS);
#pragma unroll
          for (int j = 0; j < 4; ++j) vv[j][i] = v[j] * r * gv[j]; }
#pragma unroll
      for (int j = 0; j < 4; ++j) { *(LAS bf16x8*)(vnT + (j * 64 + lane) * VS + w * 16) = pk8(&vv[j][0]); *(LAS bf16x8*)(vnT + (j * 64 + lane) * VS + w * 16 + 8) = pk8(&vv[j][8]); } }
    { const int tid = w * 64 + lane;
#pragma unroll
      for (int i = 0; i < 9; ++i) { const int c = tid + 512 * i, r = c >> 5, k = c & 31; if (c < 143 * 32) *(LAS v4u*)(pt + r * 528 + k * 16) = pv[i]; } }
    __syncthreads();
#ifdef PROBE_CUT
    if (cut == 1) { __syncthreads(); return; }
#endif
    unsigned char* mixw = (unsigned char*)(wsp(F, WS_MIX) + (size_t)(chunk * CHUNK + w * 16) * DM);
    {
        v4u uw[4][2]; float bsp[4];
#pragma unroll
        for (int h = 0; h < 4; ++h) { bsp[h] = IN_F(12)[(size_t)(l * 4 + h) * CHUNK + t];
#pragma unroll
            for (int e = 0; e < 2; ++e) uw[h][e] = *(const v4u*)(zrow + ZO_U + h * 64 + 16 * kq + 8 * e); }
        f32x4 acc[4][4];
#pragma unroll
        for (int h = 0; h < 4; ++h)
#pragma unroll
            for (int db = 0; db < 4; ++db) acc[h][db] = (f32x4){0.f, 0.f, 0.f, 0.f};
#pragma unroll
        for (int ks = 0; ks < 4; ++ks) {
#pragma unroll
            for (int h = 0; h < 4; ++h)
#pragma unroll
                for (int db = 0; db < 4; ++db) { const bf16x8 a = *(const LAS bf16x8*)(vnT + (db * 64 + h * 16 + tl) * VS + ks * 32 + kq * 8); acc[h][db] = mfma16(a, bfr[ks][h], acc[h][db]); }
            __builtin_amdgcn_sched_barrier(0);
        }
        float ss = 0.f;
#pragma unroll
        for (int h = 0; h < 4; ++h) { const unsigned uu[8] = {uw[h][0].x, uw[h][0].y, uw[h][0].z, uw[h][0].w, uw[h][1].x, uw[h][1].y, uw[h][1].z, uw[h][1].w};
#pragma unroll
            for (int r = 0; r < 4; ++r)
#pragma unroll
                for (int db = 0; db < 4; ++db) { const int c = 4 * r + db; const float u = (c & 1) ? bfhi(uu[c >> 1]) : bflo(uu[c >> 1]); const float g = u * (acc[h][db][r] + bsp[h]); acc[h][db][r] = g; ss += g * g; } }
        const float rB = __builtin_amdgcn_rsqf(quad_sum(ss) * (1.0f / SGU_W) + EPS);
#pragma unroll
        for (int h = 0; h < 4; ++h) { float o[16];
#pragma unroll
            for (int r = 0; r < 4; ++r)
#pragma unroll
                for (int db = 0; db < 4; ++db) o[4 * r + db] = acc[h][db][r] * rB;
            unsigned char* dst = mixw + (size_t)tl * (DM * 2) + (512 + h * 64 + 16 * kq) * 2;
            *(GAS bf16x8*)dst = pk8(&o[0]); *(GAS bf16x8*)(dst + 16) = pk8(&o[8]); }
    }
#ifdef PROBE_CUT
    if (cut == 2) { __syncthreads(); return; }
#endif
    {
        f32x4 acc[4][4];
#pragma unroll
        for (int g = 0; g < 4; ++g)
#pragma unroll
            for (int db = 0; db < 4; ++db) acc[g][db] = (f32x4){0.f, 0.f, 0.f, 0.f};
        const bf16* wp = (const bf16*)(wl + OW_POOL);
        const LAS unsigned char* pb = pt + (15 + t) * 528 + kq * 16;
        bf16x8 wa[2][4], wn[2][4];
#pragma unroll
        for (int ks = 0; ks < 2; ++ks)
#pragma unroll
            for (int db = 0; db < 4; ++db) wa[ks][db] = *(const bf16x8*)(wp + (size_t)(db * 16 + tl) * 64 + ks * 32 + kq * 8);
#pragma unroll
        for (int g = 0; g < 4; ++g) { const int win = 2 << g; const int cnt = (s + 1 < win) ? s + 1 : win; const float rc = 1.0f / (float)cnt;
            if (g < 3) {
#pragma unroll
                for (int ks = 0; ks < 2; ++ks)
#pragma unroll
                    for (int db = 0; db < 4; ++db) wn[ks][db] = *(const bf16x8*)(wp + (size_t)((g + 1) * 64 + db * 16 + tl) * 64 + ks * 32 + kq * 8); }
#pragma unroll
            for (int ks = 0; ks < 2; ++ks) {
                float sum[8], cur[8];
                { const v4u pw = *(const LAS v4u*)(pb + (g * 64 + ks * 32) * 2); const unsigned ww[4] = {pw.x, pw.y, pw.z, pw.w};
#pragma unroll
                  for (int j = 0; j < 4; ++j) { cur[2 * j] = bflo(ww[j]); cur[2 * j + 1] = bfhi(ww[j]); sum[2 * j] = cur[2 * j]; sum[2 * j + 1] = cur[2 * j + 1]; } }
#pragma unroll
                for (int jj = 1; jj < win; ++jj) { const v4u pw = *(const LAS v4u*)(pb - jj * 528 + (g * 64 + ks * 32) * 2); const unsigned ww[4] = {pw.x, pw.y, pw.z, pw.w};
#pragma unroll
                  for (int j = 0; j < 4; ++j) { sum[2 * j] += bflo(ww[j]); sum[2 * j + 1] += bfhi(ww[j]); } }
                float mv[8];
#pragma unroll
                for (int j = 0; j < 8; ++j) mv[j] = sum[j] * rc - cur[j];
                const bf16x8 bfrag = pk8(mv);
#pragma unroll
                for (int db = 0; db < 4; ++db) acc[g][db] = mfma16(wa[ks][db], bfrag, acc[g][db]);
            }
#pragma unroll
            for (int ks = 0; ks < 2; ++ks)
#pragma unroll
                for (int db = 0; db < 4; ++db) wa[ks][db] = wn[ks][db];
            __builtin_amdgcn_sched_barrier(0);
        }
        float ss = 0.f;
#pragma unroll
        for (int g = 0; g < 4; ++g)
#pragma unroll
            for (int db = 0; db < 4; ++db) { const f32x4 y = acc[g][db];
                ss += (y[0] * y[0] + y[1] * y[1]) + (y[2] * y[2] + y[3] * y[3]); }
        const float rC = __builtin_amdgcn_rsqf(quad_sum(ss) * (1.0f / POOL_W) + EPS);
#pragma unroll
        for (int g = 0; g < 4; ++g) {
#pragma unroll
            for (int db = 0; db < 4; ++db) *(LAS u32x2*)(stg + tl * 144 + db * 32 + kq * 8) = pk4(acc[g][db] * rC);
#pragma unroll
            for (int i = 0; i < 2; ++i) *(GAS v4u*)(mixw + (size_t)(8 * i + (lane >> 3)) * (DM * 2) + (768 + g * 64) * 2 + (lane & 7) * 16) = *(const LAS v4u*)(stg + (8 * i + (lane >> 3)) * 144 + (lane & 7) * 16);
        }
    }
    __syncthreads();
}

#ifndef ATT_SPLIT
#define ATT_SPLIT 1
#endif
constexpr int ATT_MAXI = 2;
__device__ const unsigned char att_nsp_tab[32] = {1,1,1,1,1,1,1,1,1,1,1,1,1,1,1,1,1,2,2,2,2,2,2,2,2,2,2,2,2,2,2,2};
__device__ const unsigned char att_tab[32 * ATT_MAXI * 4] = {
    31,1,68,128, 17,1,68,72,
    30,1,68,124, 18,1,68,76,
    29,1,68,120, 19,1,68,80,
    28,1,68,116, 20,1,68,84,
    27,1,68,112, 21,1,68,88,
    26,1,68,108, 22,1,68,92,
    25,1,68,104, 23,1,68,96,
    24,1,68,100, 7,0,0,32,
    16,0,0,68, 255,0,0,0,
    14,0,0,60, 0,0,0,4,
    13,0,0,56, 1,0,0,8,
    12,0,0,52, 2,0,0,12,
    11,0,0,48, 3,0,0,16,
    10,0,0,44, 4,0,0,20,
    9,0,0,40, 5,0,0,24,
    8,0,0,36, 6,0,0,28,
    17,0,0,68, 255,0,0,0,
    18,0,0,68, 255,0,0,0,
    19,0,0,68, 255,0,0,0,
    20,0,0,68, 255,0,0,0,
    21,0,0,68, 255,0,0,0,
    22,0,0,68, 255,0,0,0,
    23,0,0,68, 255,0,0,0,
    24,0,0,68, 255,0,0,0,
    25,0,0,68, 255,0,0,0,
    26,0,0,68, 255,0,0,0,
    27,0,0,68, 255,0,0,0,
    28,0,0,68, 255,0,0,0,
    29,0,0,68, 255,0,0,0,
    30,0,0,68, 255,0,0,0,
    31,0,0,68, 255,0,0,0,
    15,0,0,64, 255,0,0,0,
};
__constant__ const unsigned att_tab32[32 * ATT_MAXI] = {0x8044011fu, 0x48440111u, 0x7c44011eu, 0x4c440112u, 0x7844011du, 0x50440113u, 0x7444011cu, 0x54440114u, 0x7044011bu, 0x58440115u, 0x6c44011au, 0x5c440116u, 0x68440119u, 0x60440117u, 0x64440118u, 0x20000007u, 0x44000010u, 0x000000ffu, 0x3c00000eu, 0x04000000u, 0x3800000du, 0x08000001u, 0x3400000cu, 0x0c000002u, 0x3000000bu, 0x10000003u, 0x2c00000au, 0x14000004u, 0x28000009u, 0x18000005u, 0x24000008u, 0x1c000006u, 0x44000011u, 0x000000ffu, 0x44000012u, 0x000000ffu, 0x44000013u, 0x000000ffu, 0x44000014u, 0x000000ffu, 0x44000015u, 0x000000ffu, 0x44000016u, 0x000000ffu, 0x44000017u, 0x000000ffu, 0x44000018u, 0x000000ffu, 0x44000019u, 0x000000ffu, 0x4400001au, 0x000000ffu, 0x4400001bu, 0x000000ffu, 0x4400001cu, 0x000000ffu, 0x4400001du, 0x000000ffu, 0x4400001eu, 0x000000ffu, 0x4400001fu, 0x000000ffu, 0x4000000fu, 0x000000ffu};
__constant__ const unsigned att_nsp32[32] = {1,1,1,1,1,1,1,1,1,1,1,1,1,1,1,1,1,2,2,2,2,2,2,2,2,2,2,2,2,2,2,2};
__device__ __forceinline__ int att_nsplit(int qb) { return ATT_SPLIT ? (int)att_nsp32[__builtin_amdgcn_readfirstlane(qb)] : 1; }
static_assert(2 * OPART_BYTES + (size_t)2 * 8 * SEQ * 8 <= (size_t)M * DM * 4 && 2 * OPART_BYTES + (size_t)2 * 8 * SEQ * 8 <= (size_t)M * ZLD * 2, "attention partials");
__device__ __forceinline__ unsigned char* att_part(const Frame& F, int l) { return l + 1 < DEPTH ? (unsigned char*)F.a->out : F.a->ws + WS_Z; }
constexpr size_t AP_ML = 2 * OPART_BYTES;
__device__ __forceinline__ void p4_combine(Frame& F, int cl) {
    const int gw = F.vcu * NWAVES + F.wave, NGW = F.G * NWAVES, lane = F.lane, h = lane >> 4, d0 = (lane & 15) * 8;
    const unsigned char* ap = att_part(F, cl);
    const float2* ML = (const float2*)(ap + AP_ML);
    const bool grp = GROUP_BAR && F.G == 256;
    const int pm_ = ((int)blockIdx.x & 7) * 8 + (((int)blockIdx.x & 63) >> 3);
    const int m8lo = grp ? pm_ * 256 + ((int)blockIdx.x >> 6) * 64 + F.wave * 8 : gw * 8, m8st = grp ? M : NGW * 8;
    for (int m8 = m8lo; m8 < M; m8 += m8st)
    for (int m0 = m8; m0 < m8 + 8; m0 += 4) {
        const int b = m0 >> 13, s0 = m0 & (SEQ - 1), bh = b * NHEAD + h, nsp = att_nsplit(s0 >> 8);
        const size_t row0 = (size_t)bh * SEQ + s0;
        float li[4][2]; v4u ow[4][2];
#pragma unroll
        for (int r = 0; r < 4; ++r)
#pragma unroll
            for (int i = 0; i < 2; ++i) if (i < nsp) { li[r][i] = ML[(size_t)i * 8 * SEQ + row0 + r].y; ow[r][i] = *(const v4u*)(ap + (size_t)i * OPART_BYTES + ((row0 + r) * 128 + d0) * 2); }
#pragma unroll
        for (int r = 0; r < 4; ++r) {
            float a[8] = {0.f, 0.f, 0.f, 0.f, 0.f, 0.f, 0.f, 0.f}, wsum = 0.f;
#pragma unroll
            for (int i = 0; i < 2; ++i) if (i < nsp) { const float wgt = li[r][i]; wsum += wgt; const unsigned ww[4] = {ow[r][i].x, ow[r][i].y, ow[r][i].z, ow[r][i].w};
#pragma unroll
                for (int j = 0; j < 4; ++j) { a[2 * j] += wgt * bflo(ww[j]); a[2 * j + 1] += wgt * bfhi(ww[j]); } }
            const float rw = 1.0f / wsum; float ss = 0.f;
#pragma unroll
            for (int j = 0; j < 8; ++j) { a[j] *= rw; ss += a[j] * a[j]; }
            const float rA = __builtin_amdgcn_rsqf(wave_sum_dpp(ss) * (1.0f / 512.0f) + EPS);
#pragma unroll
            for (int j = 0; j < 8; ++j) a[j] *= rA;
            *(bf16x8*)(wsp(F, WS_MIX) + (size_t)(m0 + r) * DM + h * 128 + d0) = pk8(a);
        }
    }
}

struct AttnSchedPaired {
    int bh, idx;
    __device__ __forceinline__ bool get(int i, attn::Item& it) const {
        if (idx >= 16 || i >= 2) return false;
        it.bh = bh; it.qb = (i == 0) ? idx : 31 - idx; it.jlo = 0; it.jhi = 4 * (it.qb + 1); it.chunk = 0; return true;
    }
};
struct AttnSchedSplit {
    int bid, G;
    __device__ __forceinline__ bool get(int i, attn::Item& it) const {
        int cnt = 0;
        for (int slot = bid; slot < 256; slot += G)
#pragma unroll
            for (int j = 0; j < ATT_MAXI; ++j) {
#ifdef PROBE_SPREAD
                const unsigned e = att_tab32[(slot & 31) * ATT_MAXI + j]; const int bh = slot >> 5;
#else
#ifdef PROBE_BHSWAP
                const unsigned e = att_tab32[(slot >> 3) * ATT_MAXI + j]; const int bh = (slot & 7) ^ 4;
#else
                const unsigned e = att_tab32[(slot >> 3) * ATT_MAXI + j]; const int bh = slot & 7;
#endif
#endif
                if ((e & 255u) != 255u) { if (cnt == i) { it.bh = bh; it.qb = (int)(e & 255u); it.chunk = (int)((e >> 8) & 255u); it.jlo = (int)((e >> 16) & 255u); it.jhi = (int)(e >> 24); return true; } ++cnt; } }
        return false;
    }
};

__device__ __forceinline__ XcdBarrier mk_bar(const Frame& F) {
    XcdBarrier b; b.bar = (unsigned*)(F.a->ws + WS_CTL) + CW_BAR; b.x = xb_xcc_id(); b.st = (volatile LAS unsigned*)(F.lds + MISC_OFF) + 8; return b;
}
__device__ __forceinline__ void grid_bar(const Frame& F) { xcd_barrier(mk_bar(F)); }
__device__ __forceinline__ void group_bar(const Frame& F, const bool acq = true) {
    asm volatile("s_waitcnt vmcnt(0)" ::: "memory");
    __syncthreads();
    if (threadIdx.x == 0) {
        __builtin_amdgcn_s_waitcnt(0);
        unsigned* w = (unsigned*)(F.a->ws + WS_CTL) + CW_GB + 64 * ((int)blockIdx.x & 63);
        volatile LAS unsigned* st = (volatile LAS unsigned*)(F.lds + MISC_OFF) + 8;
        unsigned same = st[3];
        if (same == 0u) { const unsigned m = xb_ld(w + 1); same = (m != 0u && (m & (m - 1u)) == 0u) ? 1u : 2u; st[3] = same; }
        if (same != 1u) { __builtin_amdgcn_fence(__ATOMIC_RELEASE, "agent"); asm volatile("s_waitcnt vmcnt(0)" ::: "memory"); }
        const unsigned old = xb_add(w, 1u), tgt = (old / 4u + 1u) * 4u;
        if (acq || same != 1u) { __builtin_amdgcn_fence(__ATOMIC_ACQUIRE, "agent");
            asm volatile("s_waitcnt vmcnt(0)" ::: "memory"); }
        XB_WAIT2(w, _v < tgt, (unsigned*)(F.a->ws + WS_CTL) + CW_BAR);
    }
    __syncthreads();
}
#ifndef GB_SKIP_INV
#define GB_SKIP_INV 1
#endif
#ifndef P2_XLOCAL
#define P2_XLOCAL 1
#endif
__global__ void __launch_bounds__(NWAVES * 64, 2) hybrid_fwd(Args args_) {
    extern __shared__ __attribute__((aligned(16))) unsigned char lds[];
    (void)args_;
    const CAS Args* ap0 = (const CAS Args*)__builtin_amdgcn_kernarg_segment_ptr();
    { const int tid = threadIdx.x;
      for (int u = tid; u < (LDS_BYTES - LDSCTL_OFF) / 4; u += NWAVES * 64) ((LAS unsigned*)((LAS unsigned char*)lds + LDSCTL_OFF))[u] = 0u;
      __syncthreads();
      if (N_LAUNCHES == 1) (void)xcd_barrier_post((unsigned*)(ap0->ws + WS_CTL) + CW_BAR, (volatile LAS unsigned*)((LAS unsigned char*)lds + MISC_OFF) + 8); }
    const int p_lo = ap0->ph_lo;
#ifdef PROBE_TWICE
    int twice_ = 0;
#endif
#ifdef PROBE_Q
    int rep_ = 0;
#endif
#pragma unroll 1
    for (int p = p_lo;; ++p) {
        const CAS Args* ap = ap0; asm volatile("" : "+s"(ap));
        if (p >= ap->ph_hi) break;
        Frame F; F.lds = (LAS unsigned char*)lds; F.a = ap;
        { int tid = threadIdx.x; asm volatile("" : "+v"(tid)); F.lane = tid & 63; F.wave = __builtin_amdgcn_readfirstlane(tid >> 6); }
        F.G = gridDim.x; { const int bx = blockIdx.x; F.vcu = (F.G % 8 == 0) ? (bx % 8) * (F.G / 8) + bx / 8 : bx; }
        const int l = (p - 1) / PH_PER_LAYER, q = (p == 0) ? -1 : (p - 1) % PH_PER_LAYER;
        bool split_done = false;
        unsigned char* wl = F.a->ws + WS_W + (size_t)l * LW;
        if (q == -1) p0_prologue(F);
        else if (q == 0) {
            pg8::Gemm g{wsp(F, WS_XB), (const bf16*)(wl + OW_IN), M, ZLD, DM}; pg8::StaticOrder S; S.init(M, ZLD, F.G, (int)blockIdx.x);
            pg8::EpiScaleBf16 E{wsp(F, WS_Z), ZLD, ssq_mix(F, l), 1.0f / DM, EPS};
            pg8::gemm_phase<pg8::EpiScaleBf16, pg8::StaticOrder, GEMM_ALIGN, GEMM_SP2>(F.lds + RING_OFF, g, S, E);
            if (SPLIT_BAR && N_LAUNCHES == 1 && p + 1 < F.a->ph_hi) { xcd_barrier_arrive(mk_bar(F)); split_done = true; }
            if (CONV_DEFER) {
                const int nwg = (M / 256) * (ZLD / 256), rem = nwg % F.G, c = (int)blockIdx.x;
                const int first = (l > 0 && CONV_TAIL) ? CI_SPLIT : 0, last = CONV_DOWN_LATE ? CI_OUT + 2 * CI_G : CI_SET1;
                if (rem == 0) conv_set(F, l, 1, c * NWAVES + F.wave, F.G * NWAVES, first, last); else if (c >= rem) conv_set(F, l, 1, (c - rem) * NWAVES + F.wave, (F.G - rem) * NWAVES, first, last);
            }
        } else if (q == 1) {
            const int pv = (P2_XLOCAL && F.G == 256) ? (((int)blockIdx.x >> 7) << 7) + 16 * ((int)blockIdx.x & 7) + (((int)blockIdx.x >> 3) & 15) : F.vcu;
#if defined(PROBE_SUB) && PROBE_SUB == 2
            if (rep_ == 0)
#endif
#ifdef PROBE_Q
            for (int u = pv; u < M / CHUNK; u += F.G) p2_upproj_unit(F, l, u, rep_ == 1);
#elif defined(P2_INTERLEAVE)
            for (int v = F.vcu; v < 2 * (M / CHUNK); v += F.G) if (!(v & 1)) p2_upproj_unit(F, l, v >> 1);
#else
            for (int u = pv; u < M / CHUNK; u += F.G) p2_upproj_unit(F, l, u);
#endif
#if defined(PROBE_SUB) && PROBE_SUB == 1
            if (rep_ == 0)
#endif
#ifdef P2_INTERLEAVE
            for (int v = F.vcu; v < 2 * (M / CHUNK); v += F.G) if (v & 1) p2_sgu_pool_unit(F, l, v >> 1);
#else
            for (int u = pv + ((M / CHUNK - pv + F.G - 1) / F.G) * F.G; u < 2 * (M / CHUNK); u += F.G)
#ifdef PROBE_CUT
                p2_sgu_pool_unit(F, l, u - M / CHUNK, rep_ == 1 ? PROBE_CUT : 0);
#else
                p2_sgu_pool_unit(F, l, u - M / CHUNK);
#endif
#endif
        } else if (q == 2) {
            const float cshift = *(const float*)(wl + OW_END);
            const attn::Tensors AT{(const attn::bf16*)wsp(F, WS_Q), (const attn::bf16*)wsp(F, WS_K), (const attn::bf16*)wsp(F, WS_V), (attn::bf16*)att_part(F, l), (attn::bf16*)att_part(F, l), (float2*)(att_part(F, l) + AP_ML), cshift
#if defined(PROBE_RACY) || defined(PROBE_HALF)
                , rep_ == 0 ? 1 : 0
#endif
            };
#if ATT_SPLIT
            const AttnSchedSplit S{(int)blockIdx.x, F.G};
            attn::attn_phase<AttnSchedSplit>((char*)lds + RING_OFF, AT, S);
#else
            const AttnSchedPaired S{(int)(blockIdx.x & 7), (int)(blockIdx.x >> 3)};
            attn::attn_phase<AttnSchedPaired>((char*)lds + RING_OFF, AT, S);
#endif
        } else if (q == 3) p4_combine(F, l);
        else if (q == 5) {
            pg8::Gemm g{wsp(F, WS_XB), (const bf16*)(wl + OW_GU), M, FF2, DM}; pg8::StaticOrder S; S.init(M, FF2, F.G, (int)blockIdx.x);
            pg8::EpiSwiglu E{wsp(F, WS_H), FF, ssq_ffn(F, l), 1.0f / DM, EPS};
#ifdef PROBE_DRYEPI
            if (rep_ == 1) E.H = nullptr;
#endif
#ifdef PROBE_SAMETILE
            if (rep_ == 1) { E.H = nullptr; g.N = 0; }
#endif
#ifdef PROBE_NOMMA
            if (rep_ == 1) { E.H = nullptr; g.M = 0; }
#endif
            pg8::gemm_phase<pg8::EpiSwiglu, pg8::StaticOrder, GEMM_ALIGN, GEMM_SP2>(F.lds + RING_OFF, g, S, E);
            if (CONV_DEFER && CONV_DOWN_LATE) {
                const int nwg = (M / 256) * (FF2 / 256), rem = nwg % F.G, c = (int)blockIdx.x;
                if (rem != 0 && c >= rem) conv_set(F, l, 1, (c - rem) * NWAVES + F.wave, (F.G - rem) * NWAVES, CI_OUT + 2 * CI_G, CI_SET1);
                else if (rem == 0) conv_set(F, l, 1, c * NWAVES + F.wave, F.G * NWAVES, CI_OUT + 2 * CI_G, CI_SET1);
            }
            if (CONV_DEFER && CONV_TAIL && l + 1 < DEPTH) {
                const int nwg = (M / 256) * (FF2 / 256), rem = nwg % F.G, c = (int)blockIdx.x;
                if (rem != 0 && c >= rem) conv_set(F, l + 1, 1, (c - rem) * NWAVES + F.wave, (F.G - rem) * NWAVES, 0, CI_SPLIT);
                else if (rem == 0) conv_set(F, l + 1, 1, c * NWAVES + F.wave, F.G * NWAVES, 0, CI_SPLIT);
            }
        } else {
            const bool dn = q == 6, nx = l + 1 < DEPTH;
            pg8::Gemm g{dn ? wsp(F, WS_H) : wsp(F, WS_MIX), (const bf16*)(wl + (dn ? OW_DN : OW_OUT)), M, DM, dn ? FF : DM}; pg8::StaticOrder S; S.init(M, DM, F.G, (int)blockIdx.x);
            pg8::EpiResid E{wsp(F, WS_XB), (dn && !nx) ? F.a->out : nullptr, (dn && !nx) ? nullptr : wsp(F, WS_XB), dn ? (nx ? ssq_mix(F, l + 1) : nullptr) : ssq_ffn(F, l), DM};
#ifdef PROBE_Q
            if (q == PROBE_Q && rep_ == 0) { E.out = nullptr; E.xb = nullptr; if (E.ssq) E.ssq = (float*)(F.a->ws + 204 * MiB); }
#endif
            pg8::gemm_phase<pg8::EpiResid, pg8::StaticOrder, GEMM_ALIGN, GEMM_SP2>(F.lds + RING_OFF, g, S, E);
        }
        if (split_done) xcd_barrier_wait(mk_bar(F));
        else if (N_LAUNCHES == 1 && p + 1 < F.a->ph_hi) {
            if (GROUP_BAR && F.G == 256 && q >= 3) group_bar(F, !GB_SKIP_INV || q == 6); else grid_bar(F);
        }
#ifdef PROBE_GBAR
        if (N_LAUNCHES == 1 && p + 1 < F.a->ph_hi && GROUP_BAR && F.G == 256 && q >= 4) { for (int xb_ = 0; xb_ < PROBE_GBAR; ++xb_) group_bar(F); }
#endif
#ifdef PROBE_XBAR
        if (N_LAUNCHES == 1 && p + 1 < F.a->ph_hi) { for (int xb_ = 0; xb_ < PROBE_XBAR; ++xb_) grid_bar(F); }
#endif
#ifdef PROBE_TWICE
        if (p + 1 == F.a->ph_hi && twice_ < PROBE_TWICE) { ++twice_; grid_bar(F); p = -1; }
#endif
#ifdef PROBE_Q
        if (q == PROBE_Q && rep_ == 0) { rep_ = 1; --p; } else rep_ = 0;
#endif
    }
}

extern "C" void kernel_launch(void* const* d_in, const int* in_sizes, int n_in, void* d_out, int out_size, void* d_ws, size_t ws_size, hipStream_t stream) {
    static int grid = 0;
    if (grid == 0) {
        if (n_in != 23 || in_sizes[0] != M * DM || out_size != M * DM || ws_size < WS_END) { fprintf(stderr, "kernel_launch: shape mismatch (n_in %d, in0 %d, out %d, ws %zu)\n", n_in, n_in > 0 ? in_sizes[0] : -1, out_size, ws_size); grid = -1; return; }
        int dev = 0, cus = 0, per_cu = 0;
        if (hipGetDevice(&dev) != hipSuccess || hipDeviceGetAttribute(&cus, hipDeviceAttributeMultiprocessorCount, dev) != hipSuccess) { fprintf(stderr, "kernel_launch: device query failed\n"); grid = -1; return; }
        if (hipFuncSetAttribute((const void*)hybrid_fwd, hipFuncAttributeMaxDynamicSharedMemorySize, LDS_BYTES) != hipSuccess) { fprintf(stderr, "kernel_launch: hipFuncSetAttribute failed\n"); grid = -1; return; }
        if (hipOccupancyMaxActiveBlocksPerMultiprocessor(&per_cu, (const void*)hybrid_fwd, NWAVES * 64, LDS_BYTES) != hipSuccess || per_cu < 1)
            fprintf(stderr, "kernel_launch: note: occupancy query reports %d workgroups per CU\n", per_cu);
        (void)hipGetLastError();
        grid = cus;
        if (grid != 256) fprintf(stderr, "kernel_launch: note: %d CUs (tuned for 256)\n", grid);
    }
    if (grid < 0) return;
    if (hipMemsetAsync((char*)d_ws + WS_CTL, 0, CTL_ZERO_BYTES, stream) != hipSuccess) { fprintf(stderr, "kernel_launch: hipMemsetAsync failed\n"); return; }
#ifdef PROBE_MEMSET2
    for (int i = 0; i < PROBE_MEMSET2; ++i) (void)hipMemsetAsync((char*)d_ws + WS_CTL, 0, CTL_ZERO_BYTES, stream);
#endif
    Args a{};
    for (int i = 0; i < 23; ++i) a.in[i] = (const float*)d_in[i];
    a.out = (float*)d_out; a.ws = (unsigned char*)d_ws;
#ifdef PROBE_PRO
    a.ph_lo = 0; a.ph_hi = 1; a.li = 0;
    hipLaunchKernelGGL(hybrid_fwd, dim3(grid), dim3(NWAVES * 64), LDS_BYTES, stream, a);
    (void)hipMemsetAsync((char*)d_ws + WS_CTL, 0, CTL_ZERO_BYTES, stream);
#endif
    for (int li = 0; li < N_LAUNCHES; ++li) {
        a.ph_lo = (N_LAUNCHES == 1) ? 0 : li; a.ph_hi = (N_LAUNCHES == 1) ? NPH : li + 1; a.li = li;
        hipLaunchKernelGGL(hybrid_fwd, dim3(grid), dim3(NWAVES * 64), LDS_BYTES, stream, a);
        const hipError_t le = hipPeekAtLastError();
        if (le != hipSuccess) { fprintf(stderr, "kernel_launch: launch %d failed: %s\n", li, hipGetErrorName(le)); break; }
    }
}
```
